# Optimizing an MI355X kernel written in HIP

```python
import jax, jax.numpy as jnp
from jax import lax
import numpy as np

D_MODEL = 1024
BATCH = 32
SEQ = 2048
DEPTH = 1
DEC_BATCH = 8
DEC_SEQ = 2048
PAST_LEN = 128

MLA_HEADS = 8
MLA_Q_LORA = 256
MLA_KV_LORA = 128
MLA_NOPE = 64
MLA_ROPE = 32
MLA_V = 64
ROPE_THETA = 10000.0
Q_BLOCK = 128
GLA_HEADS = 4
GLA_DK = 64
GLA_DV = 128
GLA_GATE_RANK = 16
GLA_GATE_NORM = 16.0
GLA_CHUNK = 64
MIX_WIDTH = MLA_HEADS * MLA_V + GLA_HEADS * GLA_DV
IN_SIZES = (MLA_Q_LORA, MLA_KV_LORA, MLA_ROPE,
            GLA_HEADS * GLA_DK, GLA_HEADS * GLA_DK, GLA_HEADS * GLA_DV,
            GLA_GATE_RANK, GLA_GATE_RANK, GLA_HEADS * GLA_DV)
IN_WIDTH = sum(IN_SIZES)
IN_SPLITS = tuple(int(s) for s in np.cumsum(IN_SIZES)[:-1])
PEER_HEADS = 8
PEER_NKEYS = 128
PEER_NEXP = PEER_NKEYS * PEER_NKEYS
PEER_QDIM = 256
PEER_TOPK = 16
PEER_TOKEN_BLOCK = 128
EPS = 1e-6

kernel_name = "hymba_mla_gla_peer_encoder"


def rms_norm(x, g):
    xf = x.astype(jnp.float32)
    y = xf * lax.rsqrt(jnp.mean(xf * xf, axis=-1, keepdims=True) + EPS)
    return (y * g.astype(jnp.float32)).astype(x.dtype)


def rope_tables(seq_len):
    half = MLA_ROPE // 2
    freqs = ROPE_THETA ** (-jnp.arange(half, dtype=jnp.float32) * 2.0 / MLA_ROPE)
    ang = jnp.arange(seq_len, dtype=jnp.float32)[:, None] * freqs[None, :]
    return jnp.cos(ang), jnp.sin(ang)


def apply_rope(x, cos, sin):
    xf = x.astype(jnp.float32)
    x1, x2 = jnp.split(xf, 2, axis=-1)
    return jnp.concatenate([x1 * cos - x2 * sin, x2 * cos + x1 * sin], axis=-1).astype(x.dtype)


def mla_attention(q_nope, q_rope, k_nope, k_rope, v):
    B, S, H, _ = q_nope.shape
    nq = S // Q_BLOCK
    scale = (MLA_NOPE + MLA_ROPE) ** -0.5
    qn = q_nope.reshape(B, nq, Q_BLOCK, H, MLA_NOPE).transpose(1, 0, 2, 3, 4)
    qr = q_rope.reshape(B, nq, Q_BLOCK, H, MLA_ROPE).transpose(1, 0, 2, 3, 4)

    def block(args):
        qn_b, qr_b = args
        s = (jnp.einsum("bqhd,bkhd->bhqk", qn_b, k_nope)
             + jnp.einsum("bqhd,bkd->bhqk", qr_b, k_rope))
        p = jax.nn.softmax(s.astype(jnp.float32) * scale, axis=-1).astype(v.dtype)
        return jnp.einsum("bhqk,bkhd->bqhd", p, v)

    o = lax.map(block, (qn, qr))
    return o.transpose(1, 0, 2, 3, 4).reshape(B, S, H * MLA_V)


def gla_scan(q, k, v, g):
    B, S, H, DK = q.shape
    DV = v.shape[-1]
    n = S // GLA_CHUNK
    out_dtype = v.dtype

    def to_chunks(a):
        return a.astype(jnp.float32).reshape(B, n, GLA_CHUNK, H, a.shape[-1]).transpose(1, 0, 3, 2, 4)

    qc, kc, vc, gc = to_chunks(q), to_chunks(k), to_chunks(v), to_chunks(g)
    mask = jnp.tril(jnp.ones((GLA_CHUNK, GLA_CHUNK), dtype=bool))

    def step(state, inp):
        qi, ki, vi, gi = inp
        b = jnp.cumsum(gi, axis=-2)
        q_dec = qi * jnp.exp(b)
        att = jnp.einsum("bhid,bhjd->bhij", q_dec, ki * jnp.exp(-b))
        att = jnp.where(mask, att, 0.0)
        o = jnp.einsum("bhij,bhjv->bhiv", att, vi) + jnp.einsum("bhid,bhdv->bhiv", q_dec, state)
        b_last = b[..., -1:, :]
        state = (state * jnp.exp(b_last)[..., 0, :, None]
                 + jnp.einsum("bhjd,bhjv->bhdv", ki * jnp.exp(b_last - b), vi))
        return state, o

    state0 = jnp.zeros((B, H, DK, DV), jnp.float32)
    _, o = lax.scan(step, state0, (qc, kc, vc, gc))
    return o.transpose(1, 0, 3, 2, 4).reshape(B, S, H, DV).astype(out_dtype)


def peer(xn, w_q, sub_keys, u_tab, v_tab):
    B, S, D = xn.shape
    xt = xn.reshape(-1, PEER_TOKEN_BLOCK, D)

    def block(xb):
        T = xb.shape[0]
        q = (xb @ w_q).reshape(T, PEER_HEADS, 2, PEER_QDIM // 2)
        s = jnp.einsum("thpd,hpkd->thpk", q, sub_keys).astype(jnp.float32)
        s1, i1 = lax.top_k(s[:, :, 0], PEER_TOPK)
        s2, i2 = lax.top_k(s[:, :, 1], PEER_TOPK)
        cand = (s1[..., :, None] + s2[..., None, :]).reshape(T, PEER_HEADS, PEER_TOPK * PEER_TOPK)
        cidx = (i1[..., :, None] * PEER_NKEYS + i2[..., None, :]).reshape(T, PEER_HEADS, PEER_TOPK * PEER_TOPK)
        top_s, pos = lax.top_k(cand, PEER_TOPK)
        idx = jnp.take_along_axis(cidx, pos, axis=-1)
        gate = jax.nn.softmax(top_s, axis=-1)
        u = u_tab[idx]
        vv = v_tab[idx]
        act = jax.nn.gelu(jnp.einsum("thkd,td->thk", u, xb).astype(jnp.float32))
        w = (gate * act).astype(xb.dtype)
        return jnp.einsum("thk,thkd->td", w, vv)

    return lax.map(block, xt).reshape(B, S, D)


def encoder_layer(x, norm1_g, w_in, q_norm_g, w_uq, kv_norm_g, w_ukv,
                  gate_fwd_w, gate_fwd_b, gate_bwd_w, gate_bwd_b, gla_norm_g, w_o,
                  norm2_g, peer_wq, peer_subkeys, peer_u, peer_v):
    B, S, D = x.shape
    n1 = rms_norm(x, norm1_g)
    proj = n1 @ w_in
    c_q, c_kv, k_r, gq, gk, gv, glr_f, glr_b, gout = jnp.split(proj, IN_SPLITS, axis=-1)

    qf = (rms_norm(c_q, q_norm_g) @ w_uq).reshape(B, S, MLA_HEADS, MLA_NOPE + MLA_ROPE)
    q_nope, q_rope = qf[..., :MLA_NOPE], qf[..., MLA_NOPE:]
    kvf = (rms_norm(c_kv, kv_norm_g) @ w_ukv).reshape(B, S, MLA_HEADS, MLA_NOPE + MLA_V)
    k_nope, v_mla = kvf[..., :MLA_NOPE], kvf[..., MLA_NOPE:]
    cos, sin = rope_tables(S)
    q_rope = apply_rope(q_rope, cos[:, None, :], sin[:, None, :])
    k_rope = apply_rope(k_r, cos, sin)
    attn = mla_attention(q_nope, q_rope, k_nope, k_rope, v_mla)

    qg = gq.reshape(B, S, GLA_HEADS, GLA_DK) * (GLA_DK ** -0.5)
    kg = gk.reshape(B, S, GLA_HEADS, GLA_DK)
    vg = gv.reshape(B, S, GLA_HEADS, GLA_DV)
    g_f = (jax.nn.log_sigmoid((glr_f @ gate_fwd_w + gate_fwd_b).astype(jnp.float32))
           / GLA_GATE_NORM).reshape(B, S, GLA_HEADS, GLA_DK)
    g_b = (jax.nn.log_sigmoid((glr_b @ gate_bwd_w + gate_bwd_b).astype(jnp.float32))
           / GLA_GATE_NORM).reshape(B, S, GLA_HEADS, GLA_DK)
    o_f = gla_scan(qg, kg, vg, g_f)
    o_b = jnp.flip(gla_scan(jnp.flip(qg, 1), jnp.flip(kg, 1), jnp.flip(vg, 1), jnp.flip(g_b, 1)), 1)
    o_gla = rms_norm(o_f + o_b, gla_norm_g) * jax.nn.silu(gout.reshape(B, S, GLA_HEADS, GLA_DV))

    mix = jnp.concatenate([attn, o_gla.reshape(B, S, GLA_HEADS * GLA_DV)], axis=-1) @ w_o
    h = x + mix
    return h + peer(rms_norm(h, norm2_g), peer_wq, peer_subkeys, peer_u, peer_v)


def setup_inputs(seed: int = 0) -> dict:
    key = jax.random.key(seed)
    ks = jax.random.split(key, 24)
    f32 = jnp.float32

    def nrm(k, shape, scale):
        return jax.random.normal(k, shape, f32) * scale

    def gain(k, shape):
        return 1.0 + 0.02 * jax.random.normal(k, shape, f32)

    L = DEPTH
    return {
        "x_prompt": jax.random.normal(ks[0], (BATCH, SEQ, D_MODEL), f32),
        "x_sample": jax.random.normal(ks[1], (DEC_BATCH, DEC_SEQ, D_MODEL), f32),
        "norm1_g": gain(ks[2], (L, D_MODEL)),
        "w_in": nrm(ks[3], (L, D_MODEL, IN_WIDTH), D_MODEL ** -0.5),
        "q_norm_g": gain(ks[4], (L, MLA_Q_LORA)),
        "w_uq": nrm(ks[5], (L, MLA_Q_LORA, MLA_HEADS * (MLA_NOPE + MLA_ROPE)), MLA_Q_LORA ** -0.5),
        "kv_norm_g": gain(ks[6], (L, MLA_KV_LORA)),
        "w_ukv": nrm(ks[7], (L, MLA_KV_LORA, MLA_HEADS * (MLA_NOPE + MLA_V)), MLA_KV_LORA ** -0.5),
        "gate_fwd_w": nrm(ks[8], (L, GLA_GATE_RANK, GLA_HEADS * GLA_DK), GLA_GATE_RANK ** -0.5),
        "gate_fwd_b": nrm(ks[9], (L, GLA_HEADS * GLA_DK), 0.1),
        "gate_bwd_w": nrm(ks[10], (L, GLA_GATE_RANK, GLA_HEADS * GLA_DK), GLA_GATE_RANK ** -0.5),
        "gate_bwd_b": nrm(ks[11], (L, GLA_HEADS * GLA_DK), 0.1),
        "gla_norm_g": gain(ks[12], (L, GLA_DV)),
        "w_o": nrm(ks[13], (L, MIX_WIDTH, D_MODEL), MIX_WIDTH ** -0.5),
        "norm2_g": gain(ks[14], (L, D_MODEL)),
        "peer_wq": nrm(ks[15], (L, D_MODEL, PEER_HEADS * PEER_QDIM), D_MODEL ** -0.5),
        "peer_subkeys": nrm(ks[16], (L, PEER_HEADS, 2, PEER_NKEYS, PEER_QDIM // 2), (PEER_QDIM // 2) ** -0.5),
        "peer_u": nrm(ks[17], (L, PEER_NEXP, D_MODEL), D_MODEL ** -0.5),
        "peer_v": nrm(ks[18], (L, PEER_NEXP, D_MODEL), (PEER_HEADS * PEER_TOPK) ** -0.5),
        "final_norm_g": gain(ks[19], (D_MODEL,)),
    }


def reference(x_prompt, x_sample, norm1_g, w_in, q_norm_g, w_uq, kv_norm_g, w_ukv,
              gate_fwd_w, gate_fwd_b, gate_bwd_w, gate_bwd_b, gla_norm_g, w_o,
              norm2_g, peer_wq, peer_subkeys, peer_u, peer_v, final_norm_g):
    def trunk(x):
        for l in range(DEPTH):
            x = encoder_layer(x, norm1_g[l], w_in[l], q_norm_g[l], w_uq[l], kv_norm_g[l], w_ukv[l],
                              gate_fwd_w[l], gate_fwd_b[l], gate_bwd_w[l], gate_bwd_b[l],
                              gla_norm_g[l], w_o[l], norm2_g[l], peer_wq[l], peer_subkeys[l],
                              peer_u[l], peer_v[l])
        return rms_norm(x, final_norm_g)

    y_prompt = trunk(x_prompt)
    y_sample = trunk(x_sample)
    return (y_prompt, y_sample)
```

```cpp
#include <hip/hip_runtime.h>
#include <hip/hip_bf16.h>
#include <hip/hip_fp16.h>
#include <hip/hip_cooperative_groups.h>
namespace cg = cooperative_groups;
#include <cstdio>
#include <cmath>

constexpr int T = 81920, TP = 65536, DM = 1024, SEQ = 2048, NSEQ = 40;
constexpr int INW = 1984;
constexpr float EPS = 1e-6f;

typedef unsigned short bfu;
using bf16x8 = __attribute__((ext_vector_type(8))) short;
using f32x4 = __attribute__((ext_vector_type(4))) float;
using f32x16 = __attribute__((ext_vector_type(16))) float;
__device__ __forceinline__ bfu f2bf(float f) { unsigned u = __float_as_uint(f); u += 0x7fffu + ((u >> 16) & 1u); return (bfu)(u >> 16); }
__device__ __forceinline__ float bf2f(bfu h) { return __uint_as_float(((unsigned)h) << 16); }
__device__ __forceinline__ unsigned cvtpk(float lo, float hi) {
  unsigned r; asm volatile("v_cvt_pk_bf16_f32 %0, %1, %2" : "=v"(r) : "v"(lo), "v"(hi)); return r;
}

constexpr size_t al256(size_t x) { return (x + 255) / 256 * 256; }
constexpr size_t OFF_ROPE  = 0;
constexpr size_t OFF_WIN   = al256(OFF_ROPE + (size_t)2048 * 16 * 8);
constexpr size_t OFF_WUQ   = al256(OFF_WIN + (size_t)2048 * 1024 * 2);
constexpr size_t OFF_WUKV  = al256(OFF_WUQ + (size_t)768 * 256 * 2);
constexpr size_t OFF_WO    = al256(OFF_WUKV + (size_t)1024 * 128 * 2);
constexpr size_t OFF_WPQ   = al256(OFF_WO + (size_t)1024 * 1024 * 2);
constexpr size_t OFF_SK    = al256(OFF_WPQ + (size_t)2048 * 1024 * 2);
constexpr size_t OFF_UT    = al256(OFF_SK + (size_t)2048 * 128 * 2);
constexpr size_t OFF_VT    = al256(OFF_UT + (size_t)16384 * 1024 * 2);
constexpr size_t OFF_RSTD1 = al256(OFF_VT + (size_t)16384 * 1024 * 2);
constexpr size_t OFF_SSQ   = al256(OFF_RSTD1 + (size_t)T * 4);
constexpr size_t OFF_SSKV  = al256(OFF_SSQ + (size_t)T * 4 * 4);
constexpr size_t OFF_SS2   = al256(OFF_SSKV + (size_t)T * 2 * 4);
constexpr size_t OFF_XB    = al256(OFF_SS2 + (size_t)T * 16 * 4);
constexpr size_t OFF_CQ    = al256(OFF_XB + (size_t)T * 1024 * 2);
constexpr size_t OFF_CKV   = al256(OFF_CQ + (size_t)T * 256 * 2);
constexpr size_t OFF_KR    = al256(OFF_CKV + (size_t)T * 128 * 2);
constexpr size_t OFF_GQ    = al256(OFF_KR + (size_t)T * 32 * 2);
constexpr size_t OFF_GK    = al256(OFF_GQ + (size_t)T * 256 * 2);
constexpr size_t OFF_GV    = al256(OFF_GK + (size_t)T * 256 * 2);
constexpr size_t OFF_GLR   = al256(OFF_GV + (size_t)T * 512 * 2);
constexpr size_t OFF_GOUT  = al256(OFF_GLR + (size_t)T * 32 * 4);
constexpr size_t OFF_QF    = al256(OFF_GOUT + (size_t)T * 512 * 2);
constexpr size_t OFF_KV    = al256(OFF_QF + (size_t)T * 768 * 2);
constexpr size_t OFF_MIX   = al256(OFF_KV + (size_t)T * 1024 * 2);
constexpr size_t WS_NEED   = al256(OFF_MIX + (size_t)T * 1024 * 2);
constexpr size_t OFF_HB    = OFF_XB;
constexpr size_t OFF_PQ    = OFF_KR;
constexpr size_t OFF_OF    = OFF_XB;
constexpr size_t OFF_OB    = OFF_XB + (size_t)T * 512 * 2;
static_assert(OFF_PQ + (size_t)T * 2048 * 2 <= OFF_MIX, "PQ alias overlaps live data");
static_assert(OFF_OB + (size_t)T * 512 * 2 <= OFF_CQ, "OF/OB alias");
static_assert(WS_NEED <= (size_t)1073741824, "workspace budget");

struct P {
  const float *xp, *xs, *norm1_g, *w_in, *q_norm_g, *w_uq, *kv_norm_g, *w_ukv, *gfw, *gfb, *gbw, *gbb, *gla_g, *w_o, *norm2_g, *wq,
      *subk, *ut, *vt, *fin_g;
  float* out;
  char* ws;
  float freq[16];
};
__device__ __forceinline__ const float* xrow(const P& p, int t) { return t < TP ? p.xp + (size_t)t * DM : p.xs + (size_t)(t - TP) * DM; }

__device__ __forceinline__ float wave_sum(float v) {
  for (int o = 32; o > 0; o >>= 1) v += __shfl_xor(v, o);
  return v;
}
__device__ __forceinline__ float wave_max(float v) {
  for (int o = 32; o > 0; o >>= 1) v = fmaxf(v, __shfl_xor(v, o));
  return v;
}
template <int CTRL> __device__ __forceinline__ float dpp_f(float v) {
  return __builtin_bit_cast(float, __builtin_amdgcn_update_dpp(0, __builtin_bit_cast(int, v), CTRL, 0xf, 0xf, true));
}
__device__ __forceinline__ float row16_sum(float v) {
  v += dpp_f<0xB1>(v);
  v += dpp_f<0x4E>(v);
  v += dpp_f<0x141>(v);
  v += dpp_f<0x140>(v);
  return v;
}

__device__ __forceinline__ int win_src_col(int n) {
  if (n < 384) return n;
  if (n < 640) return 416 + (n - 384);
  if (n < 896) return 672 + (n - 640);
  if (n < 1408) return 928 + (n - 896);
  if (n < 1920) return 1472 + (n - 1408);
  if (n < 1952) return 384 + (n - 1920);
  if (n < 1984) return 1440 + (n - 1952);
  return -1;
}
__device__ __forceinline__ void cvt_t8(bfu* dst, const float* src, int K, int ldsrc, int n, int srccol, int k0, const float* gain, float scale) {
  unsigned w[4];
  float v[8];
#pragma unroll
  for (int i = 0; i < 8; ++i) {
    float g = gain ? gain[k0 + i] : 1.f;
    v[i] = (srccol >= 0) ? src[(size_t)(k0 + i) * ldsrc + srccol] * g * scale : 0.f;
  }
#pragma unroll
  for (int i = 0; i < 4; ++i) w[i] = cvtpk(v[2 * i], v[2 * i + 1]);
  *(uint4*)(dst + (size_t)n * K + k0) = make_uint4(w[0], w[1], w[2], w[3]);
}
__device__ void prep_phase(const P& p, long gtid, long gthreads) {
  for (long i = gtid; i < 2048 * 16; i += gthreads) {
    int pos = (int)(i >> 4), f = (int)(i & 15);
    float ang = (float)pos * p.freq[f];
    double rev = (double)ang * 0.15915494309189535;
    rev -= rint(rev);
    float r = (float)rev;
    float2 cs; cs.x = __builtin_amdgcn_cosf(r); cs.y = __builtin_amdgcn_sinf(r);
    ((float2*)(p.ws + OFF_ROPE))[i] = cs;
  }
  for (long i = gtid; i < 2048L * 128; i += gthreads) {
    int n = (int)(i & 2047), kc = (int)(i >> 11);
    cvt_t8((bfu*)(p.ws + OFF_WIN), p.w_in, 1024, INW, n, win_src_col(n), kc * 8, p.norm1_g, (n >= 384 && n < 640) ? 0.125f : 1.f);
  }
  for (long i = gtid; i < 768L * 32; i += gthreads) {
    int n = (int)(i % 768), kc = (int)(i / 768);
    cvt_t8((bfu*)(p.ws + OFF_WUQ), p.w_uq, 256, 768, n, n, kc * 8, p.q_norm_g, 1.f);
  }
  for (long i = gtid; i < 1024L * 16; i += gthreads) {
    int n = (int)(i & 1023), kc = (int)(i >> 10);
    cvt_t8((bfu*)(p.ws + OFF_WUKV), p.w_ukv, 128, 1024, n, n, kc * 8, p.kv_norm_g, 1.f);
  }
  for (long i = gtid; i < 1024L * 128; i += gthreads) {
    int n = (int)(i & 1023), kc = (int)(i >> 10);
    cvt_t8((bfu*)(p.ws + OFF_WO), p.w_o, 1024, 1024, n, n, kc * 8, nullptr, 1.f);
  }
  for (long i = gtid; i < 2048L * 128; i += gthreads) {
    int n = (int)(i & 2047), kc = (int)(i >> 11);
    cvt_t8((bfu*)(p.ws + OFF_WPQ), p.wq, 1024, 2048, n, n, kc * 8, p.norm2_g, 1.f);
  }
  for (long i = gtid; i < 2048L * 128 / 8; i += gthreads) {
    const float4* s = (const float4*)(p.subk + i * 8);
    float4 a = s[0], b = s[1];
    *(uint4*)((bfu*)(p.ws + OFF_SK) + i * 8) = make_uint4(cvtpk(a.x, a.y), cvtpk(a.z, a.w), cvtpk(b.x, b.y), cvtpk(b.z, b.w));
  }
  for (long i = gtid; i < 2L * 16384 * 1024 / 8; i += gthreads) {
    const long half = 16384L * 1024 / 8;
    const bool isv = i >= half; const long j = isv ? i - half : i;
    const float4* s = (const float4*)((isv ? p.vt : p.ut) + j * 8);
    float4 a = s[0], b = s[1];
    __half2 h0 = __floats2half2_rn(a.x, a.y), h1 = __floats2half2_rn(a.z, a.w), h2 = __floats2half2_rn(b.x, b.y), h3 = __floats2half2_rn(b.z, b.w);
    uint4 o; o.x = *(unsigned*)&h0; o.y = *(unsigned*)&h1; o.z = *(unsigned*)&h2; o.w = *(unsigned*)&h3;
    *(uint4*)((__half*)(p.ws + (isv ? OFF_VT : OFF_UT)) + j * 8) = o;
  }
  const long gw = gtid >> 6, nw = gthreads >> 6; const int lane = (int)(gtid & 63);
  for (long t = gw; t < T; t += nw) {
    const float4* x = (const float4*)xrow(p, (int)t);
    float4 v[4]; float ss = 0;
#pragma unroll
    for (int i = 0; i < 4; ++i) { v[i] = x[lane + 64 * i]; ss += v[i].x * v[i].x + v[i].y * v[i].y + v[i].z * v[i].z + v[i].w * v[i].w; }
    ss = wave_sum(ss);
    if (lane == 0) ((float*)(p.ws + OFF_RSTD1))[t] = rsqrtf(ss * (1.f / 1024.f) + EPS);
    bfu* xb = (bfu*)(p.ws + OFF_XB) + t * 1024;
#pragma unroll
    for (int i = 0; i < 4; ++i) *(uint2*)(xb + (lane + 64 * i) * 4) = make_uint2(cvtpk(v[i].x, v[i].y), cvtpk(v[i].z, v[i].w));
  }
}

constexpr int G_A_BYTES = 256 * 64 * 2, G_B_BYTES = 128 * 64 * 2, G_STAGE = G_A_BYTES + G_B_BYTES, G_LDS = 2 * G_STAGE;
__device__ __forceinline__ int gswz(int row, int slot) { return row * 128 + ((slot ^ (row & 7)) << 4); }
template <int K>
__device__ __forceinline__ void gemm_mainloop(const bfu* __restrict__ A, int lda, const bfu* __restrict__ Bt, int ldb, char* lds, f32x4 (&acc)[4][4]) {
  const int tid = threadIdx.x, lane = tid & 63, wid = tid >> 6, wm = wid >> 1, wn = wid & 1, fr = lane & 15, fq = lane >> 4;
  constexpr int KT = K / 64;
#pragma unroll
  for (int m = 0; m < 4; ++m)
#pragma unroll
    for (int n = 0; n < 4; ++n) acc[m][n] = f32x4{0.f, 0.f, 0.f, 0.f};
  auto stage = [&](int kt, int buf) {
    char* la = lds + buf * G_STAGE; char* lb = la + G_A_BYTES;
#pragma unroll
    for (int i = 0; i < 4; ++i) {
      int c = tid + 512 * i, row = c >> 3, sl = c & 7;
      __builtin_amdgcn_global_load_lds((const unsigned*)(A + (size_t)row * lda + kt * 64 + ((sl ^ (row & 7)) << 3)), (unsigned*)(la + c * 16), 16, 0, 0);
    }
#pragma unroll
    for (int i = 0; i < 2; ++i) {
      int c = tid + 512 * i, row = c >> 3, sl = c & 7;
      __builtin_amdgcn_global_load_lds((const unsigned*)(Bt + (size_t)row * ldb + kt * 64 + ((sl ^ (row & 7)) << 3)), (unsigned*)(lb + c * 16), 16, 0, 0);
    }
  };
  stage(0, 0);
  asm volatile("s_waitcnt vmcnt(0)" ::: "memory");
  __syncthreads();
  for (int t = 0; t < KT; ++t) {
    if (t + 1 < KT) stage(t + 1, (t + 1) & 1);
    const char* la = lds + (t & 1) * G_STAGE; const char* lb = la + G_A_BYTES;
#pragma unroll
    for (int kk = 0; kk < 2; ++kk) {
      bf16x8 a[4], b[4];
#pragma unroll
      for (int m = 0; m < 4; ++m) a[m] = *(const bf16x8*)(la + gswz(wm * 64 + m * 16 + fr, kk * 4 + fq));
#pragma unroll
      for (int n = 0; n < 4; ++n) b[n] = *(const bf16x8*)(lb + gswz(wn * 64 + n * 16 + fr, kk * 4 + fq));
#pragma unroll
      for (int m = 0; m < 4; ++m)
#pragma unroll
        for (int n = 0; n < 4; ++n) acc[m][n] = __builtin_amdgcn_mfma_f32_16x16x32_bf16(a[m], b[n], acc[m][n], 0, 0, 0);
    }
    asm volatile("s_waitcnt vmcnt(0)" ::: "memory");
    __syncthreads();
  }
}

struct TileCtx { int row0, col0, wm, wn, fr, fq; };

__device__ __forceinline__ void epi_g1(const P& p, const TileCtx& c, f32x4 (&acc)[4][4]) {
  const float* rstd1 = (const float*)(p.ws + OFF_RSTD1);
  const int tn = c.col0 >> 7;
  const float2* rope = (const float2*)(p.ws + OFF_ROPE);
#pragma unroll
  for (int m = 0; m < 4; ++m) {
    const int rb = c.row0 + c.wm * 64 + m * 16 + c.fq * 4;
    float rs[4];
#pragma unroll
    for (int j = 0; j < 4; ++j) rs[j] = rstd1[rb + j];
#pragma unroll
    for (int n = 0; n < 4; ++n)
#pragma unroll
      for (int j = 0; j < 4; ++j) acc[m][n][j] *= rs[j];
    if (tn <= 2) {
      bfu* dst; int ld, cb; float* ssd; int ssld, ssi;
      if (tn < 2) { dst = (bfu*)(p.ws + OFF_CQ); ld = 256; cb = c.col0; ssd = (float*)(p.ws + OFF_SSQ); ssld = 4; ssi = tn * 2 + c.wn; }
      else { dst = (bfu*)(p.ws + OFF_CKV); ld = 128; cb = c.col0 - 256; ssd = (float*)(p.ws + OFF_SSKV); ssld = 2; ssi = c.wn; }
#pragma unroll
      for (int j = 0; j < 4; ++j) {
        float ss = 0;
#pragma unroll
        for (int n = 0; n < 4; ++n) { float v = acc[m][n][j]; ss += v * v; dst[(size_t)(rb + j) * ld + cb + c.wn * 64 + n * 16 + c.fr] = f2bf(v); }
        ss = row16_sum(ss);
        if (c.fr == 0) ssd[(size_t)(rb + j) * ssld + ssi] = ss;
      }
    } else if (tn < 15) {
      bfu* dst; int ld, cb;
      if (tn < 5) { dst = (bfu*)(p.ws + OFF_GQ); ld = 256; cb = c.col0 - 384; }
      else if (tn < 7) { dst = (bfu*)(p.ws + OFF_GK); ld = 256; cb = c.col0 - 640; }
      else if (tn < 11) { dst = (bfu*)(p.ws + OFF_GV); ld = 512; cb = c.col0 - 896; }
      else { dst = (bfu*)(p.ws + OFF_GOUT); ld = 512; cb = c.col0 - 1408; }
#pragma unroll
      for (int j = 0; j < 4; ++j)
#pragma unroll
        for (int n = 0; n < 4; ++n) dst[(size_t)(rb + j) * ld + cb + c.wn * 64 + n * 16 + c.fr] = f2bf(acc[m][n][j]);
    } else if (c.wn == 0) {
      bfu* KR = (bfu*)(p.ws + OFF_KR); float* GLR = (float*)(p.ws + OFF_GLR);
#pragma unroll
      for (int j = 0; j < 4; ++j) {
        const int t = rb + j, pos = t & (SEQ - 1);
        const float2 cs = rope[pos * 16 + c.fr];
        const float x1 = acc[m][0][j], x2 = acc[m][1][j];
        KR[(size_t)t * 32 + c.fr] = f2bf(x1 * cs.x - x2 * cs.y);
        KR[(size_t)t * 32 + 16 + c.fr] = f2bf(x2 * cs.x + x1 * cs.y);
        GLR[(size_t)t * 32 + c.fr] = acc[m][2][j];
        GLR[(size_t)t * 32 + 16 + c.fr] = acc[m][3][j];
      }
    }
  }
}
__device__ __forceinline__ void epi_g2q(const P& p, const TileCtx& c, f32x4 (&acc)[4][4]) {
  const float4* ssq = (const float4*)(p.ws + OFF_SSQ);
  const float2* rope = (const float2*)(p.ws + OFF_ROPE);
  bfu* QF = (bfu*)(p.ws + OFF_QF);
#pragma unroll
  for (int m = 0; m < 4; ++m) {
    const int rb = c.row0 + c.wm * 64 + m * 16 + c.fq * 4;
#pragma unroll
    for (int j = 0; j < 4; ++j) {
      const int t = rb + j, pos = t & (SEQ - 1);
      const float4 s4 = ssq[t];
      const float rs = rsqrtf((s4.x + s4.y + s4.z + s4.w) * (1.f / 256.f) + EPS);
#pragma unroll
      for (int n = 0; n < 4; ++n) {
        const int cb = c.col0 + c.wn * 64 + n * 16, jb = cb % 96;
        float o = acc[m][n][j];
        if (jb == 64) { const float2 cs = rope[pos * 16 + c.fr]; o = acc[m][n][j] * cs.x - acc[m][(n + 1) & 3][j] * cs.y; }
        else if (jb == 80) { const float2 cs = rope[pos * 16 + c.fr]; o = acc[m][n][j] * cs.x + acc[m][(n + 3) & 3][j] * cs.y; }
        QF[(size_t)t * 768 + cb + c.fr] = f2bf(o * rs);
      }
    }
  }
}
__device__ __forceinline__ void epi_g2kv(const P& p, const TileCtx& c, f32x4 (&acc)[4][4]) {
  const float2* sskv = (const float2*)(p.ws + OFF_SSKV);
  bfu* KV = (bfu*)(p.ws + OFF_KV);
#pragma unroll
  for (int m = 0; m < 4; ++m) {
    const int rb = c.row0 + c.wm * 64 + m * 16 + c.fq * 4;
#pragma unroll
    for (int j = 0; j < 4; ++j) {
      const int t = rb + j;
      const float2 s2 = sskv[t];
      const float rs = rsqrtf((s2.x + s2.y) * (1.f / 128.f) + EPS);
#pragma unroll
      for (int n = 0; n < 4; ++n) KV[(size_t)t * 1024 + c.col0 + c.wn * 64 + n * 16 + c.fr] = f2bf(acc[m][n][j] * rs);
    }
  }
}
__device__ __forceinline__ void epi_g4(const P& p, const TileCtx& c, f32x4 (&acc)[4][4]) {
  bfu* HB = (bfu*)(p.ws + OFF_HB); float* SS2 = (float*)(p.ws + OFF_SS2);
  const int tn = c.col0 >> 7;
#pragma unroll
  for (int m = 0; m < 4; ++m) {
    const int rb = c.row0 + c.wm * 64 + m * 16 + c.fq * 4;
#pragma unroll
    for (int j = 0; j < 4; ++j) {
      const int t = rb + j; const float* x = xrow(p, t);
      float ss = 0;
#pragma unroll
      for (int n = 0; n < 4; ++n) {
        const int col = c.col0 + c.wn * 64 + n * 16 + c.fr;
        const float h = x[col] + acc[m][n][j];
        p.out[(size_t)t * 1024 + col] = h; HB[(size_t)t * 1024 + col] = f2bf(h); ss += h * h;
      }
      ss = row16_sum(ss);
      if (c.fr == 0) SS2[(size_t)t * 16 + tn * 2 + c.wn] = ss;
    }
  }
}
__device__ __forceinline__ void epi_g5(const P& p, const TileCtx& c, f32x4 (&acc)[4][4]) {
  const float4* ss2 = (const float4*)(p.ws + OFF_SS2);
  bfu* PQ = (bfu*)(p.ws + OFF_PQ);
#pragma unroll
  for (int m = 0; m < 4; ++m) {
    const int rb = c.row0 + c.wm * 64 + m * 16 + c.fq * 4;
#pragma unroll
    for (int j = 0; j < 4; ++j) {
      const int t = rb + j;
      float s = 0;
#pragma unroll
      for (int q = 0; q < 4; ++q) { const float4 v = ss2[(size_t)t * 4 + q]; s += v.x + v.y + v.z + v.w; }
      const float rs = rsqrtf(s * (1.f / 1024.f) + EPS);
#pragma unroll
      for (int n = 0; n < 4; ++n) PQ[(size_t)t * 2048 + c.col0 + c.wn * 64 + n * 16 + c.fr] = f2bf(acc[m][n][j] * rs);
    }
  }
}

template <int WHICH>
__device__ __forceinline__ void gemm_phase(const P& p, char* lds, int bid, int nb) {
  const int tid = threadIdx.x, lane = tid & 63, wid = tid >> 6;
  TileCtx c; c.wm = wid >> 1; c.wn = wid & 1; c.fr = lane & 15; c.fq = lane >> 4;
  f32x4 acc[4][4];
  constexpr int MT = T / 256;
  if constexpr (WHICH == 1) {
    constexpr int NT = 16;
    for (int tile = bid; tile < MT * NT; tile += nb) {
      c.row0 = (tile / NT) * 256; c.col0 = (tile % NT) * 128;
      gemm_mainloop<1024>((const bfu*)(p.ws + OFF_XB) + (size_t)c.row0 * 1024, 1024, (const bfu*)(p.ws + OFF_WIN) + (size_t)c.col0 * 1024, 1024, lds, acc);
      epi_g1(p, c, acc);
    }
  } else if constexpr (WHICH == 2) {
    constexpr int NT = 6 + 8;
    for (int tile = bid; tile < MT * NT; tile += nb) {
      c.row0 = (tile / NT) * 256; const int tn = tile % NT;
      if (tn < 6) {
        c.col0 = tn * 128;
        gemm_mainloop<256>((const bfu*)(p.ws + OFF_CQ) + (size_t)c.row0 * 256, 256, (const bfu*)(p.ws + OFF_WUQ) + (size_t)c.col0 * 256, 256, lds, acc);
        epi_g2q(p, c, acc);
      } else {
        c.col0 = (tn - 6) * 128;
        gemm_mainloop<128>((const bfu*)(p.ws + OFF_CKV) + (size_t)c.row0 * 128, 128, (const bfu*)(p.ws + OFF_WUKV) + (size_t)c.col0 * 128, 128, lds, acc);
        epi_g2kv(p, c, acc);
      }
    }
  } else if constexpr (WHICH == 4) {
    constexpr int NT = 8;
    for (int tile = bid; tile < MT * NT; tile += nb) {
      c.row0 = (tile / NT) * 256; c.col0 = (tile % NT) * 128;
      gemm_mainloop<1024>((const bfu*)(p.ws + OFF_MIX) + (size_t)c.row0 * 1024, 1024, (const bfu*)(p.ws + OFF_WO) + (size_t)c.col0 * 1024, 1024, lds, acc);
      epi_g4(p, c, acc);
    }
  } else {
    constexpr int NT = 16;
    for (int tile = bid; tile < MT * NT; tile += nb) {
      c.row0 = (tile / NT) * 256; c.col0 = (tile % NT) * 128;
      gemm_mainloop<1024>((const bfu*)(p.ws + OFF_HB) + (size_t)c.row0 * 1024, 1024, (const bfu*)(p.ws + OFF_WPQ) + (size_t)c.col0 * 1024, 1024, lds, acc);
      epi_g5(p, c, acc);
    }
  }
}

using s16x4  = __attribute__((ext_vector_type(4))) short;
using u32x4  = __attribute__((ext_vector_type(4))) unsigned;
constexpr float ATT_SCALE = 0.10206207261596577f;
constexpr float ATT_THR = 8.f;
constexpr int ATT_SHM_V = 64 * 64 * 2, ATT_SHM_K = 64 * 256, ATT_LDS = 2 * ATT_SHM_V + 2 * ATT_SHM_K + 8 * 64 * 4;
#define KSWZ(row, colB) ((row) * 256 + ((colB) ^ (((row) & 7) << 4)))
#define SBAR() __builtin_amdgcn_sched_barrier(0)
__device__ __forceinline__ int crow(int r, int hi) { return (r & 3) + 8 * (r >> 2) + 4 * hi; }
__device__ __forceinline__ void att_partialSM(f32x16& p0, f32x16& p1, float& m_reg, float& mn, float& alpha) {
  constexpr float C = ATT_SCALE * 1.4426950408889634f;
  float pmax = p0[0];
#pragma unroll
  for (int r = 1; r < 16; ++r) pmax = fmaxf(pmax, p0[r]);
#pragma unroll
  for (int r = 0; r < 16; ++r) pmax = fmaxf(pmax, p1[r]);
  { auto rr = __builtin_amdgcn_permlane32_swap(__float_as_uint(pmax), __float_as_uint(pmax), false, false);
    pmax = fmaxf(__uint_as_float(rr[0]), __uint_as_float(rr[1])); }
  if (__builtin_expect(__all(pmax - m_reg <= ATT_THR / ATT_SCALE), 1)) { mn = m_reg; alpha = 1.f; }
  else { mn = fmaxf(m_reg, pmax); alpha = __builtin_amdgcn_exp2f((m_reg - mn) * C); m_reg = mn; }
  float mnC = -mn * C;
#pragma unroll
  for (int r = 0; r < 16; ++r) p0[r] = fmaf(p0[r], C, mnC);
#pragma unroll
  for (int r = 0; r < 16; ++r) p1[r] = fmaf(p1[r], C, mnC);
#pragma unroll
  for (int r = 0; r < 16; ++r) p0[r] = __builtin_amdgcn_exp2f(p0[r]);
}
__device__ __forceinline__ void att_finishSM(f32x16& p0, f32x16& p1, float alpha, float& l_reg, bf16x8& pa0, bf16x8& pa1, bf16x8& pa2, bf16x8& pa3) {
#pragma unroll
  for (int r = 0; r < 16; ++r) p1[r] = __builtin_amdgcn_exp2f(p1[r]);
  float ps = 0;
#pragma unroll
  for (int r = 0; r < 16; ++r) ps += p0[r];
#pragma unroll
  for (int r = 0; r < 16; ++r) ps += p1[r];
  { auto rr = __builtin_amdgcn_permlane32_swap(__float_as_uint(ps), __float_as_uint(ps), false, false);
    ps = __uint_as_float(rr[0]) + __uint_as_float(rr[1]); }
  l_reg = l_reg * alpha + ps;
#define PK4(PP, BASE, OUT) do { unsigned a0 = cvtpk(PP[BASE + 0], PP[BASE + 1]), a1 = cvtpk(PP[BASE + 2], PP[BASE + 3]);   \
    unsigned b0 = cvtpk(PP[BASE + 4], PP[BASE + 5]), b1 = cvtpk(PP[BASE + 6], PP[BASE + 7]);                              \
    auto r0 = __builtin_amdgcn_permlane32_swap(a0, b0, false, false); auto r1 = __builtin_amdgcn_permlane32_swap(a1, b1, false, false); \
    u32x4 w = {r0[0], r1[0], r0[1], r1[1]}; OUT = *reinterpret_cast<bf16x8*>(&w); } while (0)
  PK4(p0, 0, pa0); PK4(p0, 8, pa1); PK4(p1, 0, pa2); PK4(p1, 8, pa3);
#undef PK4
}
__device__ __forceinline__ void att_qkt(f32x16& p0, f32x16& p1, const char* Ks, const bf16x8* qr, int r32, int hi) {
  p0 = f32x16{}; p1 = f32x16{};
#pragma unroll
  for (int d0 = 0; d0 < 6; ++d0) { int cb = (d0 * 16 + hi * 8) * 2;
    bf16x8 b0 = *reinterpret_cast<const bf16x8*>(Ks + KSWZ(r32, cb));
    bf16x8 b1 = *reinterpret_cast<const bf16x8*>(Ks + KSWZ(32 + r32, cb));
    p0 = __builtin_amdgcn_mfma_f32_32x32x16_bf16(b0, qr[d0], p0, 0, 0, 0);
    p1 = __builtin_amdgcn_mfma_f32_32x32x16_bf16(b1, qr[d0], p1, 0, 0, 0); }
}
__device__ __forceinline__ int att_v_st(int k, int c) { const int kk = (k & ~0xC) | ((k & 4) << 1) | ((k & 8) >> 1); return ((kk >> 3) * 2 + (c >> 5)) * 512 + ((kk & 7) * 32 + (c & 31)) * 2; }
__device__ __forceinline__ int att_v_rd_base(int lane) { return ((lane & 3) << 3) | (((lane >> 2) & 3) << 6) | (((lane >> 4) & 1) << 5) | (((lane >> 5) & 1) << 8); }
constexpr int att_v_rd_off(int d0, int ks, int half) { return d0 * 512 + ks * 2048 + half * 1024; }
template <int OFF> __device__ __forceinline__ s16x4 att_tr_read(int vb) {
  s16x4 r; asm volatile("ds_read_b64_tr_b16 %0, %1 offset:%2" : "=&v"(r) : "v"(vb), "i"(OFF) : "memory"); return r;
}
template <int D0> __device__ __forceinline__ void att_pv_one(f32x16& od, int vb, bf16x8 pa0, bf16x8 pa1, bf16x8 pa2, bf16x8 pa3) {
  const s16x4 l0 = att_tr_read<att_v_rd_off(D0, 0, 0)>(vb), h0 = att_tr_read<att_v_rd_off(D0, 0, 1)>(vb), l1 = att_tr_read<att_v_rd_off(D0, 1, 0)>(vb), h1 = att_tr_read<att_v_rd_off(D0, 1, 1)>(vb);
  const s16x4 l2 = att_tr_read<att_v_rd_off(D0, 2, 0)>(vb), h2 = att_tr_read<att_v_rd_off(D0, 2, 1)>(vb), l3 = att_tr_read<att_v_rd_off(D0, 3, 0)>(vb), h3 = att_tr_read<att_v_rd_off(D0, 3, 1)>(vb);
  asm volatile("s_waitcnt lgkmcnt(0)" ::: "memory"); SBAR();
#define PK(L, H) (bf16x8){L[0], L[1], L[2], L[3], H[0], H[1], H[2], H[3]}
  od = __builtin_amdgcn_mfma_f32_32x32x16_bf16(pa0, PK(l0, h0), od, 0, 0, 0);
  od = __builtin_amdgcn_mfma_f32_32x32x16_bf16(pa1, PK(l1, h1), od, 0, 0, 0);
  od = __builtin_amdgcn_mfma_f32_32x32x16_bf16(pa2, PK(l2, h2), od, 0, 0, 0);
  od = __builtin_amdgcn_mfma_f32_32x32x16_bf16(pa3, PK(l3, h3), od, 0, 0, 0);
#undef PK
}
__device__ __forceinline__ void attn_item(const P& p, char* lds, int seq, int h, int qb) {
  const int tid = threadIdx.x, wid = tid >> 6, lane = tid & 63, r32 = lane & 31, hi = lane >> 5;
  char* V_lds = lds; char* K_lds = lds + 2 * ATT_SHM_V;
  float* wsl = (float*)(lds + 2 * ATT_SHM_V + 2 * ATT_SHM_K) + wid * 64; float* li_l = wsl; float* al_l = wsl + 32;
  const size_t tb = (size_t)seq * SEQ;
  const bfu* QF = (const bfu*)(p.ws + OFF_QF); const bfu* KVg = (const bfu*)(p.ws + OFF_KV) + tb * 1024 + h * 128; const bfu* KRg = (const bfu*)(p.ws + OFF_KR) + tb * 32;
  float m_reg = -1e30f, l_reg = 0; f32x16 o[2] = {}; bf16x8 qr[6];
  const bfu* Qw = QF + (tb + qb * 256 + wid * 32 + r32) * 768 + h * 96 + hi * 8;
#pragma unroll
  for (int d0 = 0; d0 < 6; ++d0) qr[d0] = *reinterpret_cast<const bf16x8*>(Qw + d0 * 16);
  const int sk = tid >> 3, sch = tid & 7, rk = (tid >> 2) & 63, rch = tid & 3;
  const int vst = att_v_st(sk, sch * 8), kst = KSWZ(sk, sch * 16), rst = KSWZ(rk, 128 + rch * 16);
  const int vb0 = (int)(uintptr_t)V_lds + att_v_rd_base(lane);
  struct { bf16x8 v, k, r; } sr_[2];
#define SLOAD(i, k0) do { sr_[i].v = *reinterpret_cast<const bf16x8*>(KVg + (size_t)((k0) + sk) * 1024 + 64 + sch * 8); \
    sr_[i].k = *reinterpret_cast<const bf16x8*>(KVg + (size_t)((k0) + sk) * 1024 + sch * 8);                              \
    if (tid < 256) sr_[i].r = *reinterpret_cast<const bf16x8*>(KRg + (size_t)((k0) + rk) * 32 + rch * 8); } while (0)
#define SWRITE(b, i) do { *(bf16x8*)(V_lds + (b) * ATT_SHM_V + vst) = sr_[i].v; *(bf16x8*)(K_lds + (b) * ATT_SHM_K + kst) = sr_[i].k; \
    if (tid < 256) *(bf16x8*)(K_lds + (b) * ATT_SHM_K + rst) = sr_[i].r; } while (0)
#define RESC(a) do { if (__any((a) < 1.f)) { if (hi == 0) al_l[r32] = (a); asm volatile("s_waitcnt lgkmcnt(0)" ::: "memory"); \
    for (int d = 0; d < 2; ++d) for (int r = 0; r < 16; ++r) o[d][r] *= al_l[crow(r, hi)]; } } while (0)
  f32x16 pA0, pA1, pB0, pB1; float mnA, mnB, alA, alB; bf16x8 pa0, pa1, pa2, pa3; constexpr int NT = SEQ / 64;
  constexpr int SE = 0, SO = 1;
  __syncthreads();
  SLOAD(SE, 0); asm volatile("s_waitcnt vmcnt(0)" ::: "memory"); SWRITE(0, SE); __syncthreads();
  att_qkt(pA0, pA1, K_lds, qr, r32, hi); att_partialSM(pA0, pA1, m_reg, mnA, alA);
  SLOAD(SO, 64); SLOAD(SE, 128);
  asm volatile("s_waitcnt vmcnt(3)" ::: "memory"); SWRITE(1, SO); __syncthreads();
  for (int j = 1; j + 1 < NT; j += 2) {
    SBAR(); att_qkt(pB0, pB1, K_lds + ATT_SHM_K, qr, r32, hi);
    att_finishSM(pA0, pA1, alA, l_reg, pa0, pa1, pa2, pa3); SBAR();
    SLOAD(SO, (j + 2) * 64); SBAR();
    att_pv_one<0>(o[0], vb0, pa0, pa1, pa2, pa3); att_pv_one<1>(o[1], vb0, pa0, pa1, pa2, pa3); att_partialSM(pB0, pB1, m_reg, mnB, alB);
    __syncthreads(); asm volatile("s_waitcnt vmcnt(3)" ::: "memory"); SWRITE(0, SE);
    RESC(alB); __syncthreads();
    SBAR(); att_qkt(pA0, pA1, K_lds, qr, r32, hi);
    att_finishSM(pB0, pB1, alB, l_reg, pa0, pa1, pa2, pa3); SBAR();
    if (j + 3 < NT) SLOAD(SE, (j + 3) * 64); SBAR();
    att_pv_one<0>(o[0], vb0 + ATT_SHM_V, pa0, pa1, pa2, pa3); att_pv_one<1>(o[1], vb0 + ATT_SHM_V, pa0, pa1, pa2, pa3); att_partialSM(pA0, pA1, m_reg, mnA, alA);
    __syncthreads(); asm volatile("s_waitcnt vmcnt(3)" ::: "memory"); SWRITE(1, SO);
    RESC(alA); __syncthreads();
  }
  SBAR(); att_qkt(pB0, pB1, K_lds + ATT_SHM_K, qr, r32, hi);
  att_finishSM(pA0, pA1, alA, l_reg, pa0, pa1, pa2, pa3); SBAR();
  att_pv_one<0>(o[0], vb0, pa0, pa1, pa2, pa3); att_pv_one<1>(o[1], vb0, pa0, pa1, pa2, pa3); att_partialSM(pB0, pB1, m_reg, mnB, alB);
  __syncthreads(); RESC(alB);
  att_finishSM(pB0, pB1, alB, l_reg, pa0, pa1, pa2, pa3); SBAR();
  att_pv_one<0>(o[0], vb0 + ATT_SHM_V, pa0, pa1, pa2, pa3); att_pv_one<1>(o[1], vb0 + ATT_SHM_V, pa0, pa1, pa2, pa3);
  if (hi == 0) li_l[r32] = l_reg; asm volatile("s_waitcnt lgkmcnt(0)" ::: "memory");
  float rli[16];
#pragma unroll
  for (int r = 0; r < 16; ++r) rli[r] = __builtin_amdgcn_rcpf(li_l[crow(r, hi)]);
  bfu* Ow = (bfu*)(p.ws + OFF_MIX) + (tb + qb * 256 + wid * 32) * 1024 + h * 64;
#pragma unroll
  for (int r = 0; r < 16; ++r) { int orow = crow(r, hi);
#pragma unroll
    for (int d0 = 0; d0 < 2; ++d0) Ow[(size_t)orow * 1024 + d0 * 32 + r32] = f2bf(o[d0][r] * rli[r]); }
#undef SLOAD
#undef SWRITE
#undef RESC
}
__device__ __forceinline__ void attn_phase(const P& p, char* lds, int bid, int nb) {
  const int x = bid & 7, i = bid >> 3, per = nb >> 3;
  for (int j = i; j < 320; j += per) {
    const int pair = (j >> 3) * 8 + x, qb = j & 7;
    attn_item(p, lds, pair >> 3, pair & 7, qb);
  }
}

constexpr int GLN_LDS = 4 * 16 * (64 * 3 + 128) * 4;
__device__ __forceinline__ void gla_naive_phase(const P& p, char* lds, int bid, int nb) {
  const int tid = threadIdx.x, grp = tid >> 7, j = tid & 127;
  float* base = (float*)lds + grp * 16 * (64 * 3 + 128);
  float (*qs)[64] = (float (*)[64])base; float (*ks)[64] = (float (*)[64])(base + 16 * 64); float (*egs)[64] = (float (*)[64])(base + 2 * 16 * 64);
  float (*vs)[128] = (float (*)[128])(base + 3 * 16 * 64);
  const bfu* GQ = (const bfu*)(p.ws + OFF_GQ); const bfu* GK = (const bfu*)(p.ws + OFF_GK); const bfu* GV = (const bfu*)(p.ws + OFF_GV);
  const float* GLR = (const float*)(p.ws + OFF_GLR);
  for (int it = bid; it < 80; it += nb) {
    const int scan = it * 4 + grp;
    const int dir = scan & 1, h = (scan >> 1) & 3, seq = scan >> 3;
    const size_t tb = (size_t)seq * SEQ;
    const float* gw = dir ? p.gbw : p.gfw; const float* gb = dir ? p.gbb : p.gfb;
    bfu* O = (bfu*)(p.ws + (dir ? OFF_OB : OFF_OF));
    float S[64];
#pragma unroll
    for (int d = 0; d < 64; ++d) S[d] = 0.f;
    for (int c = 0; c < 128; ++c) {
      const int cc = dir ? 127 - c : c;
      const size_t t0 = tb + cc * 16;
      __syncthreads();
      for (int e = j; e < 16 * 64; e += 128) {
        int s = e >> 6, d = e & 63; size_t t = t0 + s;
        qs[s][d] = bf2f(GQ[t * 256 + h * 64 + d]);
        ks[s][d] = bf2f(GK[t * 256 + h * 64 + d]);
        float z = gb[h * 64 + d];
        for (int r = 0; r < 16; ++r) z += GLR[t * 32 + dir * 16 + r] * gw[r * 256 + h * 64 + d];
        float ls = fminf(z, 0.f) - log1pf(__expf(-fabsf(z)));
        egs[s][d] = __expf(ls * (1.f / 16.f));
      }
      for (int e = j; e < 16 * 128; e += 128) { int s = e >> 7, jj = e & 127; vs[s][jj] = bf2f(GV[(t0 + s) * 512 + h * 128 + jj]); }
      __syncthreads();
      for (int si = 0; si < 16; ++si) {
        const int s = dir ? 15 - si : si;
        const float v = vs[s][j]; float o = 0.f;
#pragma unroll
        for (int d = 0; d < 64; ++d) { S[d] = egs[s][d] * S[d] + ks[s][d] * v; o += qs[s][d] * S[d]; }
        O[(t0 + s) * 512 + h * 128 + j] = f2bf(o);
      }
    }
  }
}
__device__ __forceinline__ void gla_fin_phase(const P& p, int bid, int nb) {
  const int lane = threadIdx.x & 63;
  const bfu* OF = (const bfu*)(p.ws + OFF_OF); const bfu* OB = (const bfu*)(p.ws + OFF_OB);
  const bfu* GOUT = (const bfu*)(p.ws + OFF_GOUT); bfu* MIX = (bfu*)(p.ws + OFF_MIX);
  for (long gw = (long)bid * 8 + (threadIdx.x >> 6); gw < (long)T * 4; gw += (long)nb * 8) {
    const size_t t = gw >> 2; const int h = (int)(gw & 3);
    float a = bf2f(OF[t * 512 + h * 128 + lane]) + bf2f(OB[t * 512 + h * 128 + lane]);
    float b = bf2f(OF[t * 512 + h * 128 + 64 + lane]) + bf2f(OB[t * 512 + h * 128 + 64 + lane]);
    float ss = wave_sum(a * a + b * b);
    float rstd = rsqrtf(ss * (1.f / 128.f) + EPS);
    float ga = bf2f(GOUT[t * 512 + h * 128 + lane]), gb2 = bf2f(GOUT[t * 512 + h * 128 + 64 + lane]);
    float oa = a * rstd * p.gla_g[lane] * (ga / (1.f + __expf(-ga)));
    float ob = b * rstd * p.gla_g[64 + lane] * (gb2 / (1.f + __expf(-gb2)));
    MIX[t * 1024 + 512 + h * 128 + lane] = f2bf(oa);
    MIX[t * 1024 + 512 + h * 128 + 64 + lane] = f2bf(ob);
  }
}

typedef _Float16 h2_t __attribute__((ext_vector_type(2)));
__device__ __forceinline__ unsigned enc_key(float f, unsigned idx, unsigned lowmask) {
  unsigned u = __float_as_uint(f);
  unsigned k = u ^ ((unsigned)((int)u >> 31) | 0x80000000u);
  return (k & ~lowmask) | idx;
}
__device__ __forceinline__ float dec_key(unsigned k, unsigned lowmask) {
  k &= ~lowmask;
  unsigned u = (k & 0x80000000u) ? (k & 0x7fffffffu) : ~k;
  return __uint_as_float(u);
}
__device__ __forceinline__ void ce_desc(unsigned& a, unsigned& b) { unsigned mx = a > b ? a : b, mn = a > b ? b : a; a = mx; b = mn; }
__device__ __forceinline__ void sort16_desc(unsigned (&k)[16]) {
#pragma unroll
  for (int size = 2; size <= 16; size <<= 1)
#pragma unroll
    for (int stride = size >> 1; stride > 0; stride >>= 1)
#pragma unroll
      for (int i = 0; i < 16; ++i) {
        const int l = i ^ stride;
        if (l > i) { if ((i & size) == 0) ce_desc(k[i], k[l]); else ce_desc(k[l], k[i]); }
      }
}
__device__ __forceinline__ void bmerge16_desc(unsigned (&k)[16]) {
#pragma unroll
  for (int stride = 8; stride > 0; stride >>= 1)
#pragma unroll
    for (int i = 0; i < 16; ++i) { const int l = i ^ stride; if (l > i) ce_desc(k[i], k[l]); }
}
__device__ __forceinline__ void merge_top16(unsigned (&top)[16], const unsigned (&nw)[16]) {
#pragma unroll
  for (int i = 0; i < 16; ++i) top[i] = top[i] > nw[15 - i] ? top[i] : nw[15 - i];
  bmerge16_desc(top);
}
constexpr int cand_a(int c) { return c < 16 ? 0 : c < 24 ? 1 : c < 29 ? 2 : c < 33 ? 3 : c < 36 ? 4 : c < 38 ? 5 : c < 40 ? 6 : c < 42 ? 7 : c < 50 ? c - 34 : -1; }
constexpr int cand_b(int c) { return c < 16 ? c : c < 24 ? c - 16 : c < 29 ? c - 24 : c < 33 ? c - 29 : c < 36 ? c - 33 : c < 38 ? c - 36 : c < 40 ? c - 38 : c < 42 ? c - 40 : 0; }

constexpr int PE_TOK = 64;
constexpr int PE_T1_STRIDE = 260;
constexpr int PE_LDS_TOP1 = PE_TOK * PE_T1_STRIDE * 4;
constexpr int PE_LDS = PE_LDS_TOP1 + PE_TOK * 128 * 8;

__device__ __forceinline__ void peer_topk1(const P& p, int tok0, int tl0, int g, unsigned* top1) {
  const int lane = threadIdx.x & 63, r32 = lane & 31, hi = lane >> 5;
  const bfu* SK = (const bfu*)(p.ws + OFF_SK) + (size_t)g * 128 * 128 + (size_t)r32 * 128 + hi * 8;
  const bfu* PQ = (const bfu*)(p.ws + OFF_PQ) + (size_t)(tok0 + r32) * 2048 + g * 128 + hi * 8;
  bf16x8 bq[8];
#pragma unroll
  for (int ks = 0; ks < 8; ++ks) bq[ks] = *reinterpret_cast<const bf16x8*>(PQ + ks * 16);
  unsigned top[16];
#pragma unroll
  for (int kt = 0; kt < 4; ++kt) {
    f32x16 acc = {};
#pragma unroll
    for (int ks = 0; ks < 8; ++ks) {
      bf16x8 a = *reinterpret_cast<const bf16x8*>(SK + (size_t)kt * 32 * 128 + ks * 16);
      acc = __builtin_amdgcn_mfma_f32_32x32x16_bf16(a, bq[ks], acc, 0, 0, 0);
    }
    unsigned key[16];
#pragma unroll
    for (int r = 0; r < 16; ++r) key[r] = enc_key(acc[r], (unsigned)(kt * 32 + (r & 3) + 8 * (r >> 2) + 4 * hi), 127u);
    sort16_desc(key);
    if (kt == 0) {
#pragma unroll
      for (int r = 0; r < 16; ++r) top[r] = key[r];
    } else merge_top16(top, key);
  }
  unsigned m[16];
#pragma unroll
  for (int i = 0; i < 16; ++i) {
    const unsigned mine = hi ? top[15 - i] : top[i];
    auto rr = __builtin_amdgcn_permlane32_swap(mine, mine, false, false);
    m[i] = rr[0] > rr[1] ? rr[0] : rr[1];
  }
  bmerge16_desc(m);
  if (hi == 0) {
    uint4* dst = (uint4*)(top1 + (tl0 + r32) * PE_T1_STRIDE + g * 16);
#pragma unroll
    for (int q = 0; q < 4; ++q) dst[q] = make_uint4(m[4 * q], m[4 * q + 1], m[4 * q + 2], m[4 * q + 3]);
  }
}
__device__ __forceinline__ void peer_topk2(const unsigned* top1, int* pidx, float* pgate) {
  const int tid = threadIdx.x, tl = tid >> 3, hh = tid & 7;
  const unsigned* l1 = top1 + tl * PE_T1_STRIDE + hh * 32;
  unsigned k1[16], k2[16];
#pragma unroll
  for (int q = 0; q < 4; ++q) {
    uint4 a = ((const uint4*)l1)[q], b = ((const uint4*)l1)[4 + q];
    k1[4 * q] = a.x; k1[4 * q + 1] = a.y; k1[4 * q + 2] = a.z; k1[4 * q + 3] = a.w;
    k2[4 * q] = b.x; k2[4 * q + 1] = b.y; k2[4 * q + 2] = b.z; k2[4 * q + 3] = b.w;
  }
  float f1[16], f2[16];
#pragma unroll
  for (int i = 0; i < 16; ++i) { f1[i] = dec_key(k1[i], 127u); f2[i] = dec_key(k2[i], 127u); }
  unsigned top[16];
#pragma unroll
  for (int bt = 0; bt < 4; ++bt) {
    unsigned key[16];
#pragma unroll
    for (int c = 0; c < 16; ++c) {
      const int cc = bt * 16 + c;
      const int a = cand_a(cc), b = cand_b(cc);
      key[c] = (a >= 0) ? enc_key(f1[a >= 0 ? a : 0] + f2[b], (unsigned)((a >= 0 ? a : 0) * 16 + b), 255u) : 0u;
    }
    sort16_desc(key);
    if (bt == 0) {
#pragma unroll
      for (int r = 0; r < 16; ++r) top[r] = key[r];
    } else merge_top16(top, key);
  }
  float s[16]; float sum = 0;
  const float m0 = dec_key(top[0], 255u);
#pragma unroll
  for (int r = 0; r < 16; ++r) { s[r] = __expf(dec_key(top[r], 255u) - m0); sum += s[r]; }
  const float inv = 1.f / sum;
#pragma unroll
  for (int r = 0; r < 16; ++r) {
    const unsigned ab = top[r] & 255u;
    const int i1 = (int)(l1[ab >> 4] & 127u), i2 = (int)(l1[16 + (ab & 15u)] & 127u);
    pidx[tl * 128 + hh * 16 + r] = i1 * 128 + i2;
    pgate[tl * 128 + hh * 16 + r] = s[r] * inv;
  }
}
__device__ __forceinline__ float gelu_tanh_f(float x) {
  float u = 0.7978845608028654f * (x + 0.044715f * x * x * x);
  float th = 1.f - 2.f / (1.f + __expf(2.f * u));
  return 0.5f * x * (1.f + th);
}
__device__ __forceinline__ unsigned pk_h2(float a, float b) { h2_t h = {(_Float16)a, (_Float16)b}; return __builtin_bit_cast(unsigned, h); }
__device__ __forceinline__ void peer_gather_token(const P& p, int t, const int* pidx_t, const float* pgate_t) {
  const int lane = threadIdx.x & 63;
  float* orow = p.out + (size_t)t * 1024;
  float hv[16];
  {
    const float4* hr = (const float4*)orow;
    float4 a = hr[lane * 2], b = hr[lane * 2 + 1], c = hr[128 + lane * 2], d = hr[128 + lane * 2 + 1];
    hv[0] = a.x; hv[1] = a.y; hv[2] = a.z; hv[3] = a.w; hv[4] = b.x; hv[5] = b.y; hv[6] = b.z; hv[7] = b.w;
    hv[8] = c.x; hv[9] = c.y; hv[10] = c.z; hv[11] = c.w; hv[12] = d.x; hv[13] = d.y; hv[14] = d.z; hv[15] = d.w;
  }
  float ss = 0;
#pragma unroll
  for (int i = 0; i < 16; ++i) ss += hv[i] * hv[i];
  ss = wave_sum(ss);
  const float rstd = rsqrtf(ss * (1.f / 1024.f) + EPS);
  unsigned xh[8];
  {
    const float4* gr = (const float4*)p.norm2_g;
    float4 a = gr[lane * 2], b = gr[lane * 2 + 1], c = gr[128 + lane * 2], d = gr[128 + lane * 2 + 1];
    float gg[16] = {a.x, a.y, a.z, a.w, b.x, b.y, b.z, b.w, c.x, c.y, c.z, c.w, d.x, d.y, d.z, d.w};
#pragma unroll
    for (int i = 0; i < 8; ++i) xh[i] = pk_h2(hv[2 * i] * rstd * gg[2 * i], hv[2 * i + 1] * rstd * gg[2 * i + 1]);
  }
  const int myi0 = pidx_t[lane], myi1 = pidx_t[64 + lane];
  const float myg0 = pgate_t[lane], myg1 = pgate_t[64 + lane];
  const __half* UT = (const __half*)(p.ws + OFF_UT) + lane * 8;
  const __half* VT = (const __half*)(p.ws + OFF_VT) + lane * 8;
  float acc32[16];
#pragma unroll
  for (int i = 0; i < 16; ++i) acc32[i] = 0.f;
  h2_t acc16[8];
#pragma unroll
  for (int i = 0; i < 8; ++i) acc16[i] = h2_t{(_Float16)0.f, (_Float16)0.f};
  for (int c = 0; c < 32; ++c) {
    const int isrc = (c < 16) ? myi0 : myi1; const float gsrc = (c < 16) ? myg0 : myg1;
    const int kb = (c & 15) * 4;
    uint4 U[4][2], V[4][2];
#pragma unroll
    for (int q = 0; q < 4; ++q) {
      const int e = __builtin_amdgcn_readlane(isrc, kb + q);
      const uint4* up = (const uint4*)(UT + (size_t)e * 1024); const uint4* vp = (const uint4*)(VT + (size_t)e * 1024);
      U[q][0] = up[0]; U[q][1] = up[64]; V[q][0] = vp[0]; V[q][1] = vp[64];
    }
    float d[4];
#pragma unroll
    for (int q = 0; q < 4; ++q) {
      float s = 0.f;
      const unsigned* u0 = (const unsigned*)&U[q][0]; const unsigned* u1 = (const unsigned*)&U[q][1];
#pragma unroll
      for (int j = 0; j < 4; ++j) s = __builtin_amdgcn_fdot2(__builtin_bit_cast(h2_t, u0[j]), __builtin_bit_cast(h2_t, xh[j]), s, false);
#pragma unroll
      for (int j = 0; j < 4; ++j) s = __builtin_amdgcn_fdot2(__builtin_bit_cast(h2_t, u1[j]), __builtin_bit_cast(h2_t, xh[4 + j]), s, false);
      d[q] = s;
    }
    float s2[2];
#pragma unroll
    for (int q = 0; q < 2; ++q) { auto rr = __builtin_amdgcn_permlane32_swap(__float_as_uint(d[q]), __float_as_uint(d[q + 2]), false, false); s2[q] = __uint_as_float(rr[0]) + __uint_as_float(rr[1]); }
    float act;
    { auto rr = __builtin_amdgcn_permlane16_swap(__float_as_uint(s2[0]), __float_as_uint(s2[1]), false, false); act = __uint_as_float(rr[0]) + __uint_as_float(rr[1]); }
    act = row16_sum(act);
    const float gl = __shfl(gsrc, kb + (lane >> 4));
    const float wl = gl * gelu_tanh_f(act);
    const unsigned whl = pk_h2(wl, wl);
#pragma unroll
    for (int q = 0; q < 4; ++q) {
      const h2_t wq = __builtin_bit_cast(h2_t, (unsigned)__builtin_amdgcn_readlane((int)whl, q * 16));
      const unsigned* v0 = (const unsigned*)&V[q][0]; const unsigned* v1 = (const unsigned*)&V[q][1];
#pragma unroll
      for (int j = 0; j < 4; ++j) acc16[j] = __builtin_bit_cast(h2_t, v0[j]) * wq + acc16[j];
#pragma unroll
      for (int j = 0; j < 4; ++j) acc16[4 + j] = __builtin_bit_cast(h2_t, v1[j]) * wq + acc16[4 + j];
    }
    if ((c & 3) == 3) {
#pragma unroll
      for (int i = 0; i < 8; ++i) { acc32[2 * i] += (float)acc16[i][0]; acc32[2 * i + 1] += (float)acc16[i][1]; acc16[i] = h2_t{(_Float16)0.f, (_Float16)0.f}; }
    }
  }
  float y[16]; ss = 0;
#pragma unroll
  for (int i = 0; i < 16; ++i) { y[i] = hv[i] + acc32[i]; ss += y[i] * y[i]; }
  ss = wave_sum(ss);
  const float rf = rsqrtf(ss * (1.f / 1024.f) + EPS);
  {
    const float4* gr = (const float4*)p.fin_g;
    float4 a = gr[lane * 2], b = gr[lane * 2 + 1], c = gr[128 + lane * 2], d = gr[128 + lane * 2 + 1];
    float4* o4 = (float4*)orow;
    o4[lane * 2] = make_float4(y[0] * rf * a.x, y[1] * rf * a.y, y[2] * rf * a.z, y[3] * rf * a.w);
    o4[lane * 2 + 1] = make_float4(y[4] * rf * b.x, y[5] * rf * b.y, y[6] * rf * b.z, y[7] * rf * b.w);
    o4[128 + lane * 2] = make_float4(y[8] * rf * c.x, y[9] * rf * c.y, y[10] * rf * c.z, y[11] * rf * c.w);
    o4[128 + lane * 2 + 1] = make_float4(y[12] * rf * d.x, y[13] * rf * d.y, y[14] * rf * d.z, y[15] * rf * d.w);
  }
}
__device__ __forceinline__ void peer_phase(const P& p, char* lds, int bid, int nb) {
  unsigned* top1 = (unsigned*)lds; int* pidx = (int*)(lds + PE_LDS_TOP1); float* pgate = (float*)(lds + PE_LDS_TOP1 + PE_TOK * 128 * 4);
  const int wid = threadIdx.x >> 6;
  for (int tile = bid; tile < T / PE_TOK; tile += nb) {
    const int tok0 = tile * PE_TOK;
    __syncthreads();
    for (int task = wid; task < 32; task += 8) peer_topk1(p, tok0 + (task & 1) * 32, (task & 1) * 32, task >> 1, top1);
    __syncthreads();
    peer_topk2(top1, pidx, pgate);
    __syncthreads();
    for (int i = 0; i < 8; ++i) { const int tl = wid * 8 + i; peer_gather_token(p, tok0 + tl, pidx + tl * 128, pgate + tl * 128); }
  }
}

constexpr int cmax(int a, int b) { return a > b ? a : b; }
constexpr int MEGA_LDS = cmax(cmax(G_LDS, ATT_LDS), cmax(PE_LDS, GLN_LDS));
__global__ __launch_bounds__(512) void mega(P p) {
  extern __shared__ __attribute__((aligned(16))) char lds[];
  cg::grid_group grid = cg::this_grid();
  const int bid = blockIdx.x, nb = gridDim.x;
  prep_phase(p, (long)bid * 512 + threadIdx.x, (long)nb * 512);
  grid.sync();
  gemm_phase<1>(p, lds, bid, nb);
  grid.sync();
  gemm_phase<2>(p, lds, bid, nb);
  grid.sync();
  gla_naive_phase(p, lds, bid, nb);
  attn_phase(p, lds, bid, nb);
  grid.sync();
  gla_fin_phase(p, bid, nb);
  grid.sync();
  gemm_phase<4>(p, lds, bid, nb);
  grid.sync();
  gemm_phase<5>(p, lds, bid, nb);
  grid.sync();
  peer_phase(p, lds, bid, nb);
}

extern "C" void kernel_launch(void* const* d_in, const int* in_sizes, int n_in, void* d_out, int out_size, void* d_ws, size_t ws_size,
                              hipStream_t stream) {
  if (ws_size < WS_NEED) { fprintf(stderr, "kernel_launch: ws too small: %zu < %zu\n", ws_size, WS_NEED); return; }
  P p{};
  p.xp = (const float*)d_in[0]; p.xs = (const float*)d_in[1]; p.norm1_g = (const float*)d_in[2]; p.w_in = (const float*)d_in[3];
  p.q_norm_g = (const float*)d_in[4]; p.w_uq = (const float*)d_in[5]; p.kv_norm_g = (const float*)d_in[6]; p.w_ukv = (const float*)d_in[7];
  p.gfw = (const float*)d_in[8]; p.gfb = (const float*)d_in[9]; p.gbw = (const float*)d_in[10]; p.gbb = (const float*)d_in[11];
  p.gla_g = (const float*)d_in[12]; p.w_o = (const float*)d_in[13]; p.norm2_g = (const float*)d_in[14]; p.wq = (const float*)d_in[15];
  p.subk = (const float*)d_in[16]; p.ut = (const float*)d_in[17]; p.vt = (const float*)d_in[18]; p.fin_g = (const float*)d_in[19];
  p.out = (float*)d_out; p.ws = (char*)d_ws;
  for (int i = 0; i < 16; ++i) p.freq[i] = (float)pow(10000.0, -(double)i * 2.0 / 32.0);
  static int grid_blocks = 0;
  if (!grid_blocks) {
    (void)hipFuncSetAttribute((const void*)mega, hipFuncAttributeMaxDynamicSharedMemorySize, MEGA_LDS);
    int dev = 0, cus = 0, per_cu = 0;
    (void)hipGetDevice(&dev);
    (void)hipDeviceGetAttribute(&cus, hipDeviceAttributeMultiprocessorCount, dev);
    (void)hipOccupancyMaxActiveBlocksPerMultiprocessor(&per_cu, mega, 512, MEGA_LDS);
    if (per_cu > 1) per_cu = 1;
    grid_blocks = cus * per_cu;
    if (grid_blocks <= 0) { fprintf(stderr, "kernel_launch: occupancy query gave %d x %d\n", cus, per_cu); grid_blocks = 0; return; }
  }
  void* args[] = {&p};
  hipError_t e = hipLaunchCooperativeKernel((void*)mega, dim3(grid_blocks), dim3(512), args, MEGA_LDS, stream);
  if (e != hipSuccess) fprintf(stderr, "cooperative launch failed: %s (grid %d)\n", hipGetErrorString(e), grid_blocks);
}
```

```cpp
#include <hip/hip_runtime.h>
#include <hip/hip_bf16.h>
#include <hip/hip_fp16.h>
#include <hip/hip_cooperative_groups.h>
namespace cg = cooperative_groups;
#include <cstdio>
#include <cmath>

constexpr int T = 81920, TP = 65536, DM = 1024, SEQ = 2048, NSEQ = 40;
constexpr int INW = 1984;
constexpr float EPS = 1e-6f;

typedef unsigned short bfu;
using bf16x8 = __attribute__((ext_vector_type(8))) short;
using f32x4 = __attribute__((ext_vector_type(4))) float;
using f32x16 = __attribute__((ext_vector_type(16))) float;
__device__ __forceinline__ bfu f2bf(float f) { unsigned u = __float_as_uint(f); u += 0x7fffu + ((u >> 16) & 1u); return (bfu)(u >> 16); }
__device__ __forceinline__ float bf2f(bfu h) { return __uint_as_float(((unsigned)h) << 16); }
__device__ __forceinline__ unsigned cvtpk(float lo, float hi) {
  unsigned r; asm volatile("v_cvt_pk_bf16_f32 %0, %1, %2" : "=v"(r) : "v"(lo), "v"(hi)); return r;
}

constexpr size_t al256(size_t x) { return (x + 255) / 256 * 256; }
constexpr size_t OFF_ROPE  = 0;
constexpr size_t OFF_WIN   = al256(OFF_ROPE + (size_t)2048 * 16 * 8);
constexpr size_t OFF_WUQ   = al256(OFF_WIN + (size_t)2048 * 1024 * 2);
constexpr size_t OFF_WUKV  = al256(OFF_WUQ + (size_t)768 * 256 * 2);
constexpr size_t OFF_WO    = al256(OFF_WUKV + (size_t)1024 * 128 * 2);
constexpr size_t OFF_WPQ   = al256(OFF_WO + (size_t)1024 * 1024 * 2);
constexpr size_t OFF_SK    = al256(OFF_WPQ + (size_t)2048 * 1024 * 2);
constexpr size_t OFF_UT    = al256(OFF_SK + (size_t)2048 * 128 * 2);
constexpr size_t OFF_VT    = al256(OFF_UT + (size_t)16384 * 1024 * 2);
constexpr size_t OFF_RSTD1 = al256(OFF_VT + (size_t)16384 * 1024 * 2);
constexpr size_t OFF_SSQ   = al256(OFF_RSTD1 + (size_t)T * 4);
constexpr size_t OFF_SSKV  = al256(OFF_SSQ + (size_t)T * 4 * 4);
constexpr size_t OFF_SS2   = al256(OFF_SSKV + (size_t)T * 2 * 4);
constexpr size_t OFF_XB    = al256(OFF_SS2 + (size_t)T * 16 * 4);
constexpr size_t OFF_CQ    = al256(OFF_XB + (size_t)T * 1024 * 2);
constexpr size_t OFF_CKV   = al256(OFF_CQ + (size_t)T * 256 * 2);
constexpr size_t OFF_KR    = al256(OFF_CKV + (size_t)T * 128 * 2);
constexpr size_t OFF_GQ    = al256(OFF_KR + (size_t)T * 32 * 2);
constexpr size_t OFF_GK    = al256(OFF_GQ + (size_t)T * 256 * 2);
constexpr size_t OFF_GV    = al256(OFF_GK + (size_t)T * 256 * 2);
constexpr size_t OFF_GLR   = al256(OFF_GV + (size_t)T * 512 * 2);
constexpr size_t OFF_GOUT  = al256(OFF_GLR + (size_t)T * 32 * 4);
constexpr size_t OFF_QF    = al256(OFF_GOUT + (size_t)T * 512 * 2);
constexpr size_t OFF_KV    = al256(OFF_QF + (size_t)T * 768 * 2);
constexpr size_t OFF_MIX   = al256(OFF_KV + (size_t)T * 1024 * 2);
constexpr size_t WS_NEED   = al256(OFF_MIX + (size_t)T * 1024 * 2);
constexpr size_t OFF_HB    = OFF_XB;
constexpr size_t OFF_PQ    = OFF_KR;
constexpr size_t OFF_OTMP  = OFF_XB;
static_assert(OFF_PQ + (size_t)T * 2048 * 2 <= OFF_MIX, "PQ alias overlaps live data");
static_assert(OFF_OTMP + (size_t)T * 512 * 4 <= OFF_CQ, "OTMP alias");
static_assert(WS_NEED <= (size_t)1073741824, "workspace budget");

struct P {
  const float *xp, *xs, *norm1_g, *w_in, *q_norm_g, *w_uq, *kv_norm_g, *w_ukv, *gfw, *gfb, *gbw, *gbb, *gla_g, *w_o, *norm2_g, *wq,
      *subk, *ut, *vt, *fin_g;
  float* out;
  char* ws;
  float freq[16];
};
__device__ __forceinline__ const float* xrow(const P& p, int t) { return t < TP ? p.xp + (size_t)t * DM : p.xs + (size_t)(t - TP) * DM; }

__device__ __forceinline__ float wave_sum(float v) {
  for (int o = 32; o > 0; o >>= 1) v += __shfl_xor(v, o);
  return v;
}
__device__ __forceinline__ float wave_max(float v) {
  for (int o = 32; o > 0; o >>= 1) v = fmaxf(v, __shfl_xor(v, o));
  return v;
}
template <int CTRL> __device__ __forceinline__ float dpp_f(float v) {
  return __builtin_bit_cast(float, __builtin_amdgcn_update_dpp(0, __builtin_bit_cast(int, v), CTRL, 0xf, 0xf, true));
}
__device__ __forceinline__ float row16_sum(float v) {
  v += dpp_f<0xB1>(v);
  v += dpp_f<0x4E>(v);
  v += dpp_f<0x141>(v);
  v += dpp_f<0x140>(v);
  return v;
}

__device__ __forceinline__ int win_src_col(int n) {
  if (n < 384) return n;
  if (n < 640) return 416 + (n - 384);
  if (n < 896) return 672 + (n - 640);
  if (n < 1408) return 928 + (n - 896);
  if (n < 1920) return 1472 + (n - 1408);
  if (n < 1952) return 384 + (n - 1920);
  if (n < 1984) return 1440 + (n - 1952);
  return -1;
}
__device__ __forceinline__ void cvt_t8(bfu* dst, const float* src, int K, int ldsrc, int n, int srccol, int k0, const float* gain, float scale) {
  unsigned w[4];
  float v[8];
#pragma unroll
  for (int i = 0; i < 8; ++i) {
    float g = gain ? gain[k0 + i] : 1.f;
    v[i] = (srccol >= 0) ? src[(size_t)(k0 + i) * ldsrc + srccol] * g * scale : 0.f;
  }
#pragma unroll
  for (int i = 0; i < 4; ++i) w[i] = cvtpk(v[2 * i], v[2 * i + 1]);
  *(uint4*)(dst + (size_t)n * K + k0) = make_uint4(w[0], w[1], w[2], w[3]);
}
__device__ void prep_phase(const P& p, long gtid, long gthreads) {
  for (long i = gtid; i < 2048 * 16; i += gthreads) {
    int pos = (int)(i >> 4), f = (int)(i & 15);
    float ang = (float)pos * p.freq[f];
    double rev = (double)ang * 0.15915494309189535;
    rev -= rint(rev);
    float r = (float)rev;
    float2 cs; cs.x = __builtin_amdgcn_cosf(r); cs.y = __builtin_amdgcn_sinf(r);
    ((float2*)(p.ws + OFF_ROPE))[i] = cs;
  }
  for (long i = gtid; i < 2048L * 128; i += gthreads) {
    int n = (int)(i & 2047), kc = (int)(i >> 11);
    cvt_t8((bfu*)(p.ws + OFF_WIN), p.w_in, 1024, INW, n, win_src_col(n), kc * 8, p.norm1_g, (n >= 384 && n < 640) ? 0.125f : 1.f);
  }
  for (long i = gtid; i < 768L * 32; i += gthreads) {
    int n = (int)(i % 768), kc = (int)(i / 768);
    cvt_t8((bfu*)(p.ws + OFF_WUQ), p.w_uq, 256, 768, n, n, kc * 8, p.q_norm_g, 1.f);
  }
  for (long i = gtid; i < 1024L * 16; i += gthreads) {
    int n = (int)(i & 1023), kc = (int)(i >> 10);
    cvt_t8((bfu*)(p.ws + OFF_WUKV), p.w_ukv, 128, 1024, n, n, kc * 8, p.kv_norm_g, 1.f);
  }
  for (long i = gtid; i < 1024L * 128; i += gthreads) {
    int n = (int)(i & 1023), kc = (int)(i >> 10);
    cvt_t8((bfu*)(p.ws + OFF_WO), p.w_o, 1024, 1024, n, n, kc * 8, nullptr, 1.f);
  }
  for (long i = gtid; i < 2048L * 128; i += gthreads) {
    int n = (int)(i & 2047), kc = (int)(i >> 11);
    cvt_t8((bfu*)(p.ws + OFF_WPQ), p.wq, 1024, 2048, n, n, kc * 8, p.norm2_g, 1.f);
  }
  for (long i = gtid; i < 2048L * 128 / 8; i += gthreads) {
    const float4* s = (const float4*)(p.subk + i * 8);
    float4 a = s[0], b = s[1];
    *(uint4*)((bfu*)(p.ws + OFF_SK) + i * 8) = make_uint4(cvtpk(a.x, a.y), cvtpk(a.z, a.w), cvtpk(b.x, b.y), cvtpk(b.z, b.w));
  }
  for (long i = gtid; i < 2L * 16384 * 1024 / 8; i += gthreads) {
    const long half = 16384L * 1024 / 8;
    const bool isv = i >= half; const long j = isv ? i - half : i;
    const float4* s = (const float4*)((isv ? p.vt : p.ut) + j * 8);
    float4 a = s[0], b = s[1];
    __half2 h0 = __floats2half2_rn(a.x, a.y), h1 = __floats2half2_rn(a.z, a.w), h2 = __floats2half2_rn(b.x, b.y), h3 = __floats2half2_rn(b.z, b.w);
    uint4 o; o.x = *(unsigned*)&h0; o.y = *(unsigned*)&h1; o.z = *(unsigned*)&h2; o.w = *(unsigned*)&h3;
    *(uint4*)((__half*)(p.ws + (isv ? OFF_VT : OFF_UT)) + j * 8) = o;
  }
  const long gw = gtid >> 6, nw = gthreads >> 6; const int lane = (int)(gtid & 63);
  for (long t = gw; t < T; t += nw) {
    const float4* x = (const float4*)xrow(p, (int)t);
    float4 v[4]; float ss = 0;
#pragma unroll
    for (int i = 0; i < 4; ++i) { v[i] = x[lane + 64 * i]; ss += v[i].x * v[i].x + v[i].y * v[i].y + v[i].z * v[i].z + v[i].w * v[i].w; }
    ss = wave_sum(ss);
    if (lane == 0) ((float*)(p.ws + OFF_RSTD1))[t] = rsqrtf(ss * (1.f / 1024.f) + EPS);
    bfu* xb = (bfu*)(p.ws + OFF_XB) + t * 1024;
#pragma unroll
    for (int i = 0; i < 4; ++i) *(uint2*)(xb + (lane + 64 * i) * 4) = make_uint2(cvtpk(v[i].x, v[i].y), cvtpk(v[i].z, v[i].w));
  }
}

constexpr int G_A_BYTES = 256 * 64 * 2, G_B_BYTES = 128 * 64 * 2, G_STAGE = G_A_BYTES + G_B_BYTES, G_LDS = 2 * G_STAGE;
__device__ __forceinline__ int gswz(int row, int slot) { return row * 128 + ((slot ^ (row & 7)) << 4); }
template <int K>
__device__ __forceinline__ void gemm_mainloop(const bfu* __restrict__ A, int lda, const bfu* __restrict__ Bt, int ldb, char* lds, f32x4 (&acc)[4][4]) {
  const int tid = threadIdx.x, lane = tid & 63, wid = tid >> 6, wm = wid >> 1, wn = wid & 1, fr = lane & 15, fq = lane >> 4;
  constexpr int KT = K / 64;
#pragma unroll
  for (int m = 0; m < 4; ++m)
#pragma unroll
    for (int n = 0; n < 4; ++n) acc[m][n] = f32x4{0.f, 0.f, 0.f, 0.f};
  auto stage = [&](int kt, int buf) {
    char* la = lds + buf * G_STAGE; char* lb = la + G_A_BYTES;
#pragma unroll
    for (int i = 0; i < 4; ++i) {
      int c = tid + 512 * i, row = c >> 3, sl = c & 7;
      __builtin_amdgcn_global_load_lds((const unsigned*)(A + (size_t)row * lda + kt * 64 + ((sl ^ (row & 7)) << 3)), (unsigned*)(la + c * 16), 16, 0, 0);
    }
#pragma unroll
    for (int i = 0; i < 2; ++i) {
      int c = tid + 512 * i, row = c >> 3, sl = c & 7;
      __builtin_amdgcn_global_load_lds((const unsigned*)(Bt + (size_t)row * ldb + kt * 64 + ((sl ^ (row & 7)) << 3)), (unsigned*)(lb + c * 16), 16, 0, 0);
    }
  };
  stage(0, 0);
  asm volatile("s_waitcnt vmcnt(0)" ::: "memory");
  __syncthreads();
  for (int t = 0; t < KT; ++t) {
    if (t + 1 < KT) stage(t + 1, (t + 1) & 1);
    const char* la = lds + (t & 1) * G_STAGE; const char* lb = la + G_A_BYTES;
#pragma unroll
    for (int kk = 0; kk < 2; ++kk) {
      bf16x8 a[4], b[4];
#pragma unroll
      for (int m = 0; m < 4; ++m) a[m] = *(const bf16x8*)(la + gswz(wm * 64 + m * 16 + fr, kk * 4 + fq));
#pragma unroll
      for (int n = 0; n < 4; ++n) b[n] = *(const bf16x8*)(lb + gswz(wn * 64 + n * 16 + fr, kk * 4 + fq));
#pragma unroll
      for (int m = 0; m < 4; ++m)
#pragma unroll
        for (int n = 0; n < 4; ++n) acc[m][n] = __builtin_amdgcn_mfma_f32_16x16x32_bf16(a[m], b[n], acc[m][n], 0, 0, 0);
    }
    asm volatile("s_waitcnt vmcnt(0)" ::: "memory");
    __syncthreads();
  }
}

struct TileCtx { int row0, col0, wm, wn, fr, fq; };

__device__ __forceinline__ void epi_g1(const P& p, const TileCtx& c, f32x4 (&acc)[4][4]) {
  const float* rstd1 = (const float*)(p.ws + OFF_RSTD1);
  const int tn = c.col0 >> 7;
  const float2* rope = (const float2*)(p.ws + OFF_ROPE);
#pragma unroll
  for (int m = 0; m < 4; ++m) {
    const int rb = c.row0 + c.wm * 64 + m * 16 + c.fq * 4;
    float rs[4];
#pragma unroll
    for (int j = 0; j < 4; ++j) rs[j] = rstd1[rb + j];
#pragma unroll
    for (int n = 0; n < 4; ++n)
#pragma unroll
      for (int j = 0; j < 4; ++j) acc[m][n][j] *= rs[j];
    if (tn <= 2) {
      bfu* dst; int ld, cb; float* ssd; int ssld, ssi;
      if (tn < 2) { dst = (bfu*)(p.ws + OFF_CQ); ld = 256; cb = c.col0; ssd = (float*)(p.ws + OFF_SSQ); ssld = 4; ssi = tn * 2 + c.wn; }
      else { dst = (bfu*)(p.ws + OFF_CKV); ld = 128; cb = c.col0 - 256; ssd = (float*)(p.ws + OFF_SSKV); ssld = 2; ssi = c.wn; }
#pragma unroll
      for (int j = 0; j < 4; ++j) {
        float ss = 0;
#pragma unroll
        for (int n = 0; n < 4; ++n) { float v = acc[m][n][j]; ss += v * v; dst[(size_t)(rb + j) * ld + cb + c.wn * 64 + n * 16 + c.fr] = f2bf(v); }
        ss = row16_sum(ss);
        if (c.fr == 0) ssd[(size_t)(rb + j) * ssld + ssi] = ss;
      }
    } else if (tn < 15) {
      bfu* dst; int ld, cb;
      if (tn < 5) { dst = (bfu*)(p.ws + OFF_GQ); ld = 256; cb = c.col0 - 384; }
      else if (tn < 7) { dst = (bfu*)(p.ws + OFF_GK); ld = 256; cb = c.col0 - 640; }
      else if (tn < 11) { dst = (bfu*)(p.ws + OFF_GV); ld = 512; cb = c.col0 - 896; }
      else { dst = (bfu*)(p.ws + OFF_GOUT); ld = 512; cb = c.col0 - 1408; }
#pragma unroll
      for (int j = 0; j < 4; ++j)
#pragma unroll
        for (int n = 0; n < 4; ++n) dst[(size_t)(rb + j) * ld + cb + c.wn * 64 + n * 16 + c.fr] = f2bf(acc[m][n][j]);
    } else if (c.wn == 0) {
      bfu* KR = (bfu*)(p.ws + OFF_KR); float* GLR = (float*)(p.ws + OFF_GLR);
#pragma unroll
      for (int j = 0; j < 4; ++j) {
        const int t = rb + j, pos = t & (SEQ - 1);
        const float2 cs = rope[pos * 16 + c.fr];
        const float x1 = acc[m][0][j], x2 = acc[m][1][j];
        KR[(size_t)t * 32 + c.fr] = f2bf(x1 * cs.x - x2 * cs.y);
        KR[(size_t)t * 32 + 16 + c.fr] = f2bf(x2 * cs.x + x1 * cs.y);
        GLR[(size_t)t * 32 + c.fr] = acc[m][2][j];
        GLR[(size_t)t * 32 + 16 + c.fr] = acc[m][3][j];
      }
    }
  }
}
__device__ __forceinline__ void epi_g2q(const P& p, const TileCtx& c, f32x4 (&acc)[4][4]) {
  const float4* ssq = (const float4*)(p.ws + OFF_SSQ);
  const float2* rope = (const float2*)(p.ws + OFF_ROPE);
  bfu* QF = (bfu*)(p.ws + OFF_QF);
#pragma unroll
  for (int m = 0; m < 4; ++m) {
    const int rb = c.row0 + c.wm * 64 + m * 16 + c.fq * 4;
#pragma unroll
    for (int j = 0; j < 4; ++j) {
      const int t = rb + j, pos = t & (SEQ - 1);
      const float4 s4 = ssq[t];
      const float rs = rsqrtf((s4.x + s4.y + s4.z + s4.w) * (1.f / 256.f) + EPS);
#pragma unroll
      for (int n = 0; n < 4; ++n) {
        const int cb = c.col0 + c.wn * 64 + n * 16, jb = cb % 96;
        float o = acc[m][n][j];
        if (jb == 64) { const float2 cs = rope[pos * 16 + c.fr]; o = acc[m][n][j] * cs.x - acc[m][(n + 1) & 3][j] * cs.y; }
        else if (jb == 80) { const float2 cs = rope[pos * 16 + c.fr]; o = acc[m][n][j] * cs.x + acc[m][(n + 3) & 3][j] * cs.y; }
        QF[(size_t)t * 768 + cb + c.fr] = f2bf(o * rs);
      }
    }
  }
}
__device__ __forceinline__ void epi_g2kv(const P& p, const TileCtx& c, f32x4 (&acc)[4][4]) {
  const float2* sskv = (const float2*)(p.ws + OFF_SSKV);
  bfu* KV = (bfu*)(p.ws + OFF_KV);
#pragma unroll
  for (int m = 0; m < 4; ++m) {
    const int rb = c.row0 + c.wm * 64 + m * 16 + c.fq * 4;
#pragma unroll
    for (int j = 0; j < 4; ++j) {
      const int t = rb + j;
      const float2 s2 = sskv[t];
      const float rs = rsqrtf((s2.x + s2.y) * (1.f / 128.f) + EPS);
#pragma unroll
      for (int n = 0; n < 4; ++n) KV[(size_t)t * 1024 + c.col0 + c.wn * 64 + n * 16 + c.fr] = f2bf(acc[m][n][j] * rs);
    }
  }
}
__device__ __forceinline__ void epi_g4(const P& p, const TileCtx& c, f32x4 (&acc)[4][4]) {
  bfu* HB = (bfu*)(p.ws + OFF_HB); float* SS2 = (float*)(p.ws + OFF_SS2);
  const int tn = c.col0 >> 7;
#pragma unroll
  for (int m = 0; m < 4; ++m) {
    const int rb = c.row0 + c.wm * 64 + m * 16 + c.fq * 4;
#pragma unroll
    for (int j = 0; j < 4; ++j) {
      const int t = rb + j; const float* x = xrow(p, t);
      float ss = 0;
#pragma unroll
      for (int n = 0; n < 4; ++n) {
        const int col = c.col0 + c.wn * 64 + n * 16 + c.fr;
        const float h = x[col] + acc[m][n][j];
        p.out[(size_t)t * 1024 + col] = h; HB[(size_t)t * 1024 + col] = f2bf(h); ss += h * h;
      }
      ss = row16_sum(ss);
      if (c.fr == 0) SS2[(size_t)t * 16 + tn * 2 + c.wn] = ss;
    }
  }
}
__device__ __forceinline__ void epi_g5(const P& p, const TileCtx& c, f32x4 (&acc)[4][4]) {
  const float4* ss2 = (const float4*)(p.ws + OFF_SS2);
  bfu* PQ = (bfu*)(p.ws + OFF_PQ);
#pragma unroll
  for (int m = 0; m < 4; ++m) {
    const int rb = c.row0 + c.wm * 64 + m * 16 + c.fq * 4;
#pragma unroll
    for (int j = 0; j < 4; ++j) {
      const int t = rb + j;
      float s = 0;
#pragma unroll
      for (int q = 0; q < 4; ++q) { const float4 v = ss2[(size_t)t * 4 + q]; s += v.x + v.y + v.z + v.w; }
      const float rs = rsqrtf(s * (1.f / 1024.f) + EPS);
#pragma unroll
      for (int n = 0; n < 4; ++n) PQ[(size_t)t * 2048 + c.col0 + c.wn * 64 + n * 16 + c.fr] = f2bf(acc[m][n][j] * rs);
    }
  }
}

template <int WHICH>
__device__ __forceinline__ void gemm_phase(const P& p, char* lds, int bid, int nb) {
  const int tid = threadIdx.x, lane = tid & 63, wid = tid >> 6;
  TileCtx c; c.wm = wid >> 1; c.wn = wid & 1; c.fr = lane & 15; c.fq = lane >> 4;
  f32x4 acc[4][4];
  constexpr int MT = T / 256;
  if constexpr (WHICH == 1) {
    constexpr int NT = 16;
    for (int tile = bid; tile < MT * NT; tile += nb) {
      c.row0 = (tile / NT) * 256; c.col0 = (tile % NT) * 128;
      gemm_mainloop<1024>((const bfu*)(p.ws + OFF_XB) + (size_t)c.row0 * 1024, 1024, (const bfu*)(p.ws + OFF_WIN) + (size_t)c.col0 * 1024, 1024, lds, acc);
      epi_g1(p, c, acc);
    }
  } else if constexpr (WHICH == 2) {
    constexpr int NT = 6 + 8;
    for (int tile = bid; tile < MT * NT; tile += nb) {
      c.row0 = (tile / NT) * 256; const int tn = tile % NT;
      if (tn < 6) {
        c.col0 = tn * 128;
        gemm_mainloop<256>((const bfu*)(p.ws + OFF_CQ) + (size_t)c.row0 * 256, 256, (const bfu*)(p.ws + OFF_WUQ) + (size_t)c.col0 * 256, 256, lds, acc);
        epi_g2q(p, c, acc);
      } else {
        c.col0 = (tn - 6) * 128;
        gemm_mainloop<128>((const bfu*)(p.ws + OFF_CKV) + (size_t)c.row0 * 128, 128, (const bfu*)(p.ws + OFF_WUKV) + (size_t)c.col0 * 128, 128, lds, acc);
        epi_g2kv(p, c, acc);
      }
    }
  } else if constexpr (WHICH == 4) {
    constexpr int NT = 8;
    for (int tile = bid; tile < MT * NT; tile += nb) {
      c.row0 = (tile / NT) * 256; c.col0 = (tile % NT) * 128;
      gemm_mainloop<1024>((const bfu*)(p.ws + OFF_MIX) + (size_t)c.row0 * 1024, 1024, (const bfu*)(p.ws + OFF_WO) + (size_t)c.col0 * 1024, 1024, lds, acc);
      epi_g4(p, c, acc);
    }
  } else {
    constexpr int NT = 16;
    for (int tile = bid; tile < MT * NT; tile += nb) {
      c.row0 = (tile / NT) * 256; c.col0 = (tile % NT) * 128;
      gemm_mainloop<1024>((const bfu*)(p.ws + OFF_HB) + (size_t)c.row0 * 1024, 1024, (const bfu*)(p.ws + OFF_WPQ) + (size_t)c.col0 * 1024, 1024, lds, acc);
      epi_g5(p, c, acc);
    }
  }
}

using s16x4  = __attribute__((ext_vector_type(4))) short;
using u32x4  = __attribute__((ext_vector_type(4))) unsigned;
constexpr float ATT_SCALE = 0.10206207261596577f;
constexpr float ATT_THR = 8.f;
constexpr int ATT_SHM_V = 64 * 64 * 2, ATT_SHM_K = 64 * 256, ATT_LDS = 2 * ATT_SHM_V + 2 * ATT_SHM_K + 8 * 64 * 4;
#define KSWZ(row, colB) ((row) * 256 + ((colB) ^ (((row) & 7) << 4)))
#define SBAR() __builtin_amdgcn_sched_barrier(0)
__device__ __forceinline__ int crow(int r, int hi) { return (r & 3) + 8 * (r >> 2) + 4 * hi; }
__device__ __forceinline__ void att_partialSM(f32x16& p0, f32x16& p1, float& m_reg, float& mn, float& alpha) {
  constexpr float C = ATT_SCALE * 1.4426950408889634f;
  float pmax = p0[0];
#pragma unroll
  for (int r = 1; r < 16; ++r) pmax = fmaxf(pmax, p0[r]);
#pragma unroll
  for (int r = 0; r < 16; ++r) pmax = fmaxf(pmax, p1[r]);
  { auto rr = __builtin_amdgcn_permlane32_swap(__float_as_uint(pmax), __float_as_uint(pmax), false, false);
    pmax = fmaxf(__uint_as_float(rr[0]), __uint_as_float(rr[1])); }
  if (__builtin_expect(__all(pmax - m_reg <= ATT_THR / ATT_SCALE), 1)) { mn = m_reg; alpha = 1.f; }
  else { mn = fmaxf(m_reg, pmax); alpha = __builtin_amdgcn_exp2f((m_reg - mn) * C); m_reg = mn; }
  float mnC = -mn * C;
#pragma unroll
  for (int r = 0; r < 16; ++r) p0[r] = fmaf(p0[r], C, mnC);
#pragma unroll
  for (int r = 0; r < 16; ++r) p1[r] = fmaf(p1[r], C, mnC);
#pragma unroll
  for (int r = 0; r < 16; ++r) p0[r] = __builtin_amdgcn_exp2f(p0[r]);
}
__device__ __forceinline__ void att_finishSM(f32x16& p0, f32x16& p1, float alpha, float& l_reg, bf16x8& pa0, bf16x8& pa1, bf16x8& pa2, bf16x8& pa3) {
#pragma unroll
  for (int r = 0; r < 16; ++r) p1[r] = __builtin_amdgcn_exp2f(p1[r]);
  float ps = 0;
#pragma unroll
  for (int r = 0; r < 16; ++r) ps += p0[r];
#pragma unroll
  for (int r = 0; r < 16; ++r) ps += p1[r];
  { auto rr = __builtin_amdgcn_permlane32_swap(__float_as_uint(ps), __float_as_uint(ps), false, false);
    ps = __uint_as_float(rr[0]) + __uint_as_float(rr[1]); }
  l_reg = l_reg * alpha + ps;
#define PK4(PP, BASE, OUT) do { unsigned a0 = cvtpk(PP[BASE + 0], PP[BASE + 1]), a1 = cvtpk(PP[BASE + 2], PP[BASE + 3]);   \
    unsigned b0 = cvtpk(PP[BASE + 4], PP[BASE + 5]), b1 = cvtpk(PP[BASE + 6], PP[BASE + 7]);                              \
    auto r0 = __builtin_amdgcn_permlane32_swap(a0, b0, false, false); auto r1 = __builtin_amdgcn_permlane32_swap(a1, b1, false, false); \
    u32x4 w = {r0[0], r1[0], r0[1], r1[1]}; OUT = *reinterpret_cast<bf16x8*>(&w); } while (0)
  PK4(p0, 0, pa0); PK4(p0, 8, pa1); PK4(p1, 0, pa2); PK4(p1, 8, pa3);
#undef PK4
}
__device__ __forceinline__ void att_qkt(f32x16& p0, f32x16& p1, const char* Ks, const bf16x8* qr, int r32, int hi) {
  p0 = f32x16{}; p1 = f32x16{};
#pragma unroll
  for (int d0 = 0; d0 < 6; ++d0) { int cb = (d0 * 16 + hi * 8) * 2;
    bf16x8 b0 = *reinterpret_cast<const bf16x8*>(Ks + KSWZ(r32, cb));
    bf16x8 b1 = *reinterpret_cast<const bf16x8*>(Ks + KSWZ(32 + r32, cb));
    p0 = __builtin_amdgcn_mfma_f32_32x32x16_bf16(b0, qr[d0], p0, 0, 0, 0);
    p1 = __builtin_amdgcn_mfma_f32_32x32x16_bf16(b1, qr[d0], p1, 0, 0, 0); }
}
__device__ __forceinline__ int att_v_st(int k, int c) { const int kk = (k & ~0xC) | ((k & 4) << 1) | ((k & 8) >> 1); return ((kk >> 3) * 2 + (c >> 5)) * 512 + ((kk & 7) * 32 + (c & 31)) * 2; }
__device__ __forceinline__ int att_v_rd_base(int lane) { return ((lane & 3) << 3) | (((lane >> 2) & 3) << 6) | (((lane >> 4) & 1) << 5) | (((lane >> 5) & 1) << 8); }
constexpr int att_v_rd_off(int d0, int ks, int half) { return d0 * 512 + ks * 2048 + half * 1024; }
template <int OFF> __device__ __forceinline__ s16x4 att_tr_read(int vb) {
  s16x4 r; asm volatile("ds_read_b64_tr_b16 %0, %1 offset:%2" : "=&v"(r) : "v"(vb), "i"(OFF) : "memory"); return r;
}
template <int D0> __device__ __forceinline__ void att_pv_one(f32x16& od, int vb, bf16x8 pa0, bf16x8 pa1, bf16x8 pa2, bf16x8 pa3) {
  const s16x4 l0 = att_tr_read<att_v_rd_off(D0, 0, 0)>(vb), h0 = att_tr_read<att_v_rd_off(D0, 0, 1)>(vb), l1 = att_tr_read<att_v_rd_off(D0, 1, 0)>(vb), h1 = att_tr_read<att_v_rd_off(D0, 1, 1)>(vb);
  const s16x4 l2 = att_tr_read<att_v_rd_off(D0, 2, 0)>(vb), h2 = att_tr_read<att_v_rd_off(D0, 2, 1)>(vb), l3 = att_tr_read<att_v_rd_off(D0, 3, 0)>(vb), h3 = att_tr_read<att_v_rd_off(D0, 3, 1)>(vb);
  asm volatile("s_waitcnt lgkmcnt(0)" ::: "memory"); SBAR();
#define PK(L, H) (bf16x8){L[0], L[1], L[2], L[3], H[0], H[1], H[2], H[3]}
  od = __builtin_amdgcn_mfma_f32_32x32x16_bf16(pa0, PK(l0, h0), od, 0, 0, 0);
  od = __builtin_amdgcn_mfma_f32_32x32x16_bf16(pa1, PK(l1, h1), od, 0, 0, 0);
  od = __builtin_amdgcn_mfma_f32_32x32x16_bf16(pa2, PK(l2, h2), od, 0, 0, 0);
  od = __builtin_amdgcn_mfma_f32_32x32x16_bf16(pa3, PK(l3, h3), od, 0, 0, 0);
#undef PK
}
__device__ __forceinline__ void attn_item(const P& p, char* lds, int seq, int h, int qb) {
  const int tid = threadIdx.x, wid = tid >> 6, lane = tid & 63, r32 = lane & 31, hi = lane >> 5;
  char* V_lds = lds; char* K_lds = lds + 2 * ATT_SHM_V;
  float* wsl = (float*)(lds + 2 * ATT_SHM_V + 2 * ATT_SHM_K) + wid * 64; float* li_l = wsl; float* al_l = wsl + 32;
  const size_t tb = (size_t)seq * SEQ;
  const bfu* QF = (const bfu*)(p.ws + OFF_QF); const bfu* KVg = (const bfu*)(p.ws + OFF_KV) + tb * 1024 + h * 128; const bfu* KRg = (const bfu*)(p.ws + OFF_KR) + tb * 32;
  float m_reg = -1e30f, l_reg = 0; f32x16 o[2] = {}; bf16x8 qr[6];
  const bfu* Qw = QF + (tb + qb * 256 + wid * 32 + r32) * 768 + h * 96 + hi * 8;
#pragma unroll
  for (int d0 = 0; d0 < 6; ++d0) qr[d0] = *reinterpret_cast<const bf16x8*>(Qw + d0 * 16);
  const int sk = tid >> 3, sch = tid & 7, rk = (tid >> 2) & 63, rch = tid & 3;
  const int vst = att_v_st(sk, sch * 8), kst = KSWZ(sk, sch * 16), rst = KSWZ(rk, 128 + rch * 16);
  const int vb0 = (int)(uintptr_t)V_lds + att_v_rd_base(lane);
  struct { bf16x8 v, k, r; } sr_[2];
#define SLOAD(i, k0) do { sr_[i].v = *reinterpret_cast<const bf16x8*>(KVg + (size_t)((k0) + sk) * 1024 + 64 + sch * 8); \
    sr_[i].k = *reinterpret_cast<const bf16x8*>(KVg + (size_t)((k0) + sk) * 1024 + sch * 8);                              \
    if (tid < 256) sr_[i].r = *reinterpret_cast<const bf16x8*>(KRg + (size_t)((k0) + rk) * 32 + rch * 8); } while (0)
#define SWRITE(b, i) do { *(bf16x8*)(V_lds + (b) * ATT_SHM_V + vst) = sr_[i].v; *(bf16x8*)(K_lds + (b) * ATT_SHM_K + kst) = sr_[i].k; \
    if (tid < 256) *(bf16x8*)(K_lds + (b) * ATT_SHM_K + rst) = sr_[i].r; } while (0)
#define RESC(a) do { if (__any((a) < 1.f)) { if (hi == 0) al_l[r32] = (a); asm volatile("s_waitcnt lgkmcnt(0)" ::: "memory"); \
    for (int d = 0; d < 2; ++d) for (int r = 0; r < 16; ++r) o[d][r] *= al_l[crow(r, hi)]; } } while (0)
  f32x16 pA0, pA1, pB0, pB1; float mnA, mnB, alA, alB; bf16x8 pa0, pa1, pa2, pa3; constexpr int NT = SEQ / 64;
  constexpr int SE = 0, SO = 1;
  __syncthreads();
  SLOAD(SE, 0); asm volatile("s_waitcnt vmcnt(0)" ::: "memory"); SWRITE(0, SE); __syncthreads();
  att_qkt(pA0, pA1, K_lds, qr, r32, hi); att_partialSM(pA0, pA1, m_reg, mnA, alA);
  SLOAD(SO, 64); SLOAD(SE, 128);
  asm volatile("s_waitcnt vmcnt(3)" ::: "memory"); SWRITE(1, SO); __syncthreads();
  for (int j = 1; j + 1 < NT; j += 2) {
    SBAR(); att_qkt(pB0, pB1, K_lds + ATT_SHM_K, qr, r32, hi);
    att_finishSM(pA0, pA1, alA, l_reg, pa0, pa1, pa2, pa3); SBAR();
    SLOAD(SO, (j + 2) * 64); SBAR();
    att_pv_one<0>(o[0], vb0, pa0, pa1, pa2, pa3); att_pv_one<1>(o[1], vb0, pa0, pa1, pa2, pa3); att_partialSM(pB0, pB1, m_reg, mnB, alB);
    __syncthreads(); asm volatile("s_waitcnt vmcnt(3)" ::: "memory"); SWRITE(0, SE);
    RESC(alB); __syncthreads();
    SBAR(); att_qkt(pA0, pA1, K_lds, qr, r32, hi);
    att_finishSM(pB0, pB1, alB, l_reg, pa0, pa1, pa2, pa3); SBAR();
    if (j + 3 < NT) SLOAD(SE, (j + 3) * 64); SBAR();
    att_pv_one<0>(o[0], vb0 + ATT_SHM_V, pa0, pa1, pa2, pa3); att_pv_one<1>(o[1], vb0 + ATT_SHM_V, pa0, pa1, pa2, pa3); att_partialSM(pA0, pA1, m_reg, mnA, alA);
    __syncthreads(); asm volatile("s_waitcnt vmcnt(3)" ::: "memory"); SWRITE(1, SO);
    RESC(alA); __syncthreads();
  }
  SBAR(); att_qkt(pB0, pB1, K_lds + ATT_SHM_K, qr, r32, hi);
  att_finishSM(pA0, pA1, alA, l_reg, pa0, pa1, pa2, pa3); SBAR();
  att_pv_one<0>(o[0], vb0, pa0, pa1, pa2, pa3); att_pv_one<1>(o[1], vb0, pa0, pa1, pa2, pa3); att_partialSM(pB0, pB1, m_reg, mnB, alB);
  __syncthreads(); RESC(alB);
  att_finishSM(pB0, pB1, alB, l_reg, pa0, pa1, pa2, pa3); SBAR();
  att_pv_one<0>(o[0], vb0 + ATT_SHM_V, pa0, pa1, pa2, pa3); att_pv_one<1>(o[1], vb0 + ATT_SHM_V, pa0, pa1, pa2, pa3);
  if (hi == 0) li_l[r32] = l_reg; asm volatile("s_waitcnt lgkmcnt(0)" ::: "memory");
  float rli[16];
#pragma unroll
  for (int r = 0; r < 16; ++r) rli[r] = __builtin_amdgcn_rcpf(li_l[crow(r, hi)]);
  bfu* Ow = (bfu*)(p.ws + OFF_MIX) + (tb + qb * 256 + wid * 32) * 1024 + h * 64;
#pragma unroll
  for (int r = 0; r < 16; ++r) { int orow = crow(r, hi);
#pragma unroll
    for (int d0 = 0; d0 < 2; ++d0) Ow[(size_t)orow * 1024 + d0 * 32 + r32] = f2bf(o[d0][r] * rli[r]); }
#undef SLOAD
#undef SWRITE
#undef RESC
}
__device__ __forceinline__ void attn_phase(const P& p, char* lds, int bid, int nb) {
  const int x = bid & 7, i = bid >> 3, per = nb >> 3;
  for (int j = i; j < 320; j += per) {
    const int pair = (j >> 3) * 8 + x, qb = j & 7;
    attn_item(p, lds, pair >> 3, pair & 7, qb);
  }
}

constexpr int GL_QD = 0, GL_KI = 8192, GL_KDT = 16384, GL_VI = 24576, GL_GLR = 40960, GL_SEG = 45056, GL_BL = 46080, GL_RSS = 46336, GL_DIR = 47360;
constexpr int GL_OLS = 132;
constexpr int GLA_LDS = 2 * GL_DIR;
static_assert(64 * GL_OLS * 4 <= GL_GLR, "output tile must fit over the operand images");
__device__ __forceinline__ int gl_sw(int row, int col) { return row * 128 + ((((col >> 3) ^ (row & 7))) << 4) + (col & 7) * 2; }
__device__ __forceinline__ int gl_v_st(int k, int c) { const int kk = (k & ~0xC) | ((k & 4) << 1) | ((k & 8) >> 1); return ((kk >> 3) * 4 + (c >> 5)) * 512 + ((kk & 7) * 32 + (c & 31)) * 2; }
template <int KS, int HALF> __device__ __forceinline__ s16x4 gl_tr(int vb) { return att_tr_read<KS * 4096 + HALF * 2048>(vb); }
#define GL_PK(L, H) (bf16x8){L[0], L[1], L[2], L[3], H[0], H[1], H[2], H[3]}
__device__ __forceinline__ void gl_pk4(const f32x16& P, int BASE_is8, bf16x8& OUT) {
  unsigned a0, a1, b0, b1;
  if (BASE_is8 == 0) { a0 = cvtpk(P[0], P[1]); a1 = cvtpk(P[2], P[3]); b0 = cvtpk(P[4], P[5]); b1 = cvtpk(P[6], P[7]); }
  else { a0 = cvtpk(P[8], P[9]); a1 = cvtpk(P[10], P[11]); b0 = cvtpk(P[12], P[13]); b1 = cvtpk(P[14], P[15]); }
  auto r0 = __builtin_amdgcn_permlane32_swap(a0, b0, false, false); auto r1 = __builtin_amdgcn_permlane32_swap(a1, b1, false, false);
  u32x4 w = {r0[0], r1[0], r0[1], r1[1]}; OUT = *reinterpret_cast<bf16x8*>(&w);
}
__device__ __forceinline__ float half32_sum(float v) {
  v = row16_sum(v);
  auto rr = __builtin_amdgcn_permlane16_swap(__float_as_uint(v), __float_as_uint(v), false, false);
  return __uint_as_float(rr[0]) + __uint_as_float(rr[1]);
}
__device__ __forceinline__ void gla_item(const P& p, char* lds, int seq, int h) {
  const int tid = threadIdx.x, wid = tid >> 6, lane = tid & 63, r32 = lane & 31, hi = lane >> 5;
  const int dir = wid >> 2, wv = wid & 3, td = tid & 255;
  char* L = lds + dir * GL_DIR;
  float* GLRS = (float*)(L + GL_GLR); float* SEG = (float*)(L + GL_SEG); float* BL = (float*)(L + GL_BL); float* RSS = (float*)(L + GL_RSS);
  const unsigned tb = (unsigned)seq * SEQ;
  const bfu* GQ = (const bfu*)(p.ws + OFF_GQ); const bfu* GK = (const bfu*)(p.ws + OFF_GK); const bfu* GV = (const bfu*)(p.ws + OFF_GV);
  const float* GLR = (const float*)(p.ws + OFF_GLR); const bfu* GOUT = (const bfu*)(p.ws + OFF_GOUT);
  float* OTMP = (float*)(p.ws + OFF_OTMP); bfu* MIX = (bfu*)(p.ws + OFF_MIX);
  const int d = td & 63, seg = td >> 6;
  float gwr[16];
  {
    const float* gw = dir ? p.gbw : p.gfw;
#pragma unroll
    for (int q = 0; q < 16; ++q) gwr[q] = gw[q * 256 + h * 64 + d];
  }
  const float gbias = (dir ? p.gbb : p.gfb)[h * 64 + d];
  f32x16 S0 = {}, S1 = {};
  const int vb = (int)(uintptr_t)(L + GL_VI) + att_v_rd_base(lane) + wv * 512;
  for (int c = 0; c < 32; ++c) {
    const int cc = dir ? 31 - c : c;
    const unsigned t0 = tb + (unsigned)cc * 64u;
#define GL_TOK(sp) (t0 + (unsigned)(dir ? 63 - (sp) : (sp)))
    __syncthreads();
    float qv[16], kv[16];
#pragma unroll
    for (int r = 0; r < 16; ++r) { const unsigned t = GL_TOK(seg * 16 + r); qv[r] = bf2f(GQ[t * 256u + (unsigned)(h * 64 + d)]); kv[r] = bf2f(GK[t * 256u + (unsigned)(h * 64 + d)]); }
    { const int sp = td >> 2, q4 = td & 3; const unsigned t = GL_TOK(sp);
      *(float4*)(GLRS + sp * 16 + q4 * 4) = *(const float4*)(GLR + (t * 32u + (unsigned)(dir * 16 + q4 * 4))); }
#pragma unroll
    for (int i = 0; i < 4; ++i) { const int e = td + 256 * i, sp = e >> 4, ch = e & 15; const unsigned t = GL_TOK(sp);
      *(bf16x8*)(L + GL_VI + gl_v_st(sp, ch * 8)) = *(const bf16x8*)(GV + (t * 512u + (unsigned)(h * 128 + ch * 8))); }
    __syncthreads();
    float bcum[16]; float run = 0.f;
#pragma unroll
    for (int r = 0; r < 16; ++r) {
      const float4* g4 = (const float4*)(GLRS + (seg * 16 + r) * 16);
      float z = gbias;
#pragma unroll
      for (int q = 0; q < 4; ++q) { const float4 v = g4[q]; z += v.x * gwr[4 * q] + v.y * gwr[4 * q + 1] + v.z * gwr[4 * q + 2] + v.w * gwr[4 * q + 3]; }
      const float ls = fminf(z, 0.f) - __logf(1.f + __expf(-fabsf(z)));
      run += ls * (1.f / 16.f); bcum[r] = run;
    }
    SEG[seg * 64 + d] = run;
    __syncthreads();
    {
      const float s0 = SEG[d], s1 = SEG[64 + d], s2 = SEG[128 + d], s3 = SEG[192 + d];
      const float off = (seg > 0 ? s0 : 0.f) + (seg > 1 ? s1 : 0.f) + (seg > 2 ? s2 : 0.f);
      const float total = s0 + s1 + s2 + s3;
      unsigned kd[8];
#pragma unroll
      for (int r = 0; r < 16; ++r) {
        const float b = bcum[r] + off;
        const float e1 = __expf(b), e2 = __expf(-b), e3 = __expf(total - b);
        const int sp = seg * 16 + r;
        *(bfu*)(L + GL_QD + gl_sw(sp, d)) = f2bf(qv[r] * e1);
        *(bfu*)(L + GL_KI + gl_sw(sp, d)) = f2bf(kv[r] * e2);
        const float kdv = kv[r] * e3;
        if (r & 1) kd[r >> 1] = cvtpk(__uint_as_float(kd[r >> 1]), kdv); else kd[r >> 1] = __float_as_uint(kdv);
      }
      *(uint4*)(L + GL_KDT + gl_sw(d, seg * 16)) = make_uint4(kd[0], kd[1], kd[2], kd[3]);
      *(uint4*)(L + GL_KDT + gl_sw(d, seg * 16 + 8)) = make_uint4(kd[4], kd[5], kd[6], kd[7]);
      if (seg == 0) BL[d] = __expf(total);
    }
    __syncthreads();
    f32x16 X00 = {}, X01 = {}, X11 = {};
    {
      const char* KI = L + GL_KI; const char* QD = L + GL_QD;
#pragma unroll
      for (int ks = 0; ks < 4; ++ks) {
        const int col = ks * 16 + hi * 8;
        const bf16x8 a0 = *(const bf16x8*)(KI + gl_sw(r32, col)), a1 = *(const bf16x8*)(KI + gl_sw(32 + r32, col));
        const bf16x8 b0 = *(const bf16x8*)(QD + gl_sw(r32, col)), b1 = *(const bf16x8*)(QD + gl_sw(32 + r32, col));
        X00 = __builtin_amdgcn_mfma_f32_32x32x16_bf16(a0, b0, X00, 0, 0, 0);
        X01 = __builtin_amdgcn_mfma_f32_32x32x16_bf16(a0, b1, X01, 0, 0, 0);
        X11 = __builtin_amdgcn_mfma_f32_32x32x16_bf16(a1, b1, X11, 0, 0, 0);
      }
    }
#pragma unroll
    for (int r = 0; r < 16; ++r) { const bool keep = crow(r, hi) <= r32; X00[r] = keep ? X00[r] : 0.f; X11[r] = keep ? X11[r] : 0.f; }
    const s16x4 l0 = gl_tr<0, 0>(vb), h0 = gl_tr<0, 1>(vb), l1 = gl_tr<1, 0>(vb), h1 = gl_tr<1, 1>(vb);
    const s16x4 l2 = gl_tr<2, 0>(vb), h2 = gl_tr<2, 1>(vb), l3 = gl_tr<3, 0>(vb), h3 = gl_tr<3, 1>(vb);
    asm volatile("s_waitcnt lgkmcnt(0)" ::: "memory"); SBAR();
    const bf16x8 V0 = GL_PK(l0, h0), V1 = GL_PK(l1, h1), V2 = GL_PK(l2, h2), V3 = GL_PK(l3, h3);
    f32x16 o0 = {}, o1 = {};
    { bf16x8 pa0, pa1, pa2, pa3;
      gl_pk4(X00, 0, pa0); gl_pk4(X00, 1, pa1);
      o0 = __builtin_amdgcn_mfma_f32_32x32x16_bf16(pa0, V0, o0, 0, 0, 0);
      o0 = __builtin_amdgcn_mfma_f32_32x32x16_bf16(pa1, V1, o0, 0, 0, 0);
      gl_pk4(X01, 0, pa0); gl_pk4(X01, 1, pa1); gl_pk4(X11, 0, pa2); gl_pk4(X11, 1, pa3);
      o1 = __builtin_amdgcn_mfma_f32_32x32x16_bf16(pa0, V0, o1, 0, 0, 0);
      o1 = __builtin_amdgcn_mfma_f32_32x32x16_bf16(pa1, V1, o1, 0, 0, 0);
      o1 = __builtin_amdgcn_mfma_f32_32x32x16_bf16(pa2, V2, o1, 0, 0, 0);
      o1 = __builtin_amdgcn_mfma_f32_32x32x16_bf16(pa3, V3, o1, 0, 0, 0);
    }
    {
      const char* QD = L + GL_QD;
#pragma unroll
      for (int dt = 0; dt < 2; ++dt) {
        const f32x16& Sx = dt ? S1 : S0;
#pragma unroll
        for (int ks = 0; ks < 2; ++ks) {
          u32x4 sb = {cvtpk(Sx[8 * ks + 0], Sx[8 * ks + 1]), cvtpk(Sx[8 * ks + 2], Sx[8 * ks + 3]), cvtpk(Sx[8 * ks + 4], Sx[8 * ks + 5]), cvtpk(Sx[8 * ks + 6], Sx[8 * ks + 7])};
          const bf16x8 sbf = *reinterpret_cast<bf16x8*>(&sb);
          const int dcol = dt * 32 + ks * 16 + hi * 4;
          const uint2 a0l = *(const uint2*)(QD + gl_sw(r32, dcol)), a0h = *(const uint2*)(QD + gl_sw(r32, dcol + 8));
          const uint2 a1l = *(const uint2*)(QD + gl_sw(32 + r32, dcol)), a1h = *(const uint2*)(QD + gl_sw(32 + r32, dcol + 8));
          u32x4 A0 = {a0l.x, a0l.y, a0h.x, a0h.y}, A1 = {a1l.x, a1l.y, a1h.x, a1h.y};
          o0 = __builtin_amdgcn_mfma_f32_32x32x16_bf16(*reinterpret_cast<bf16x8*>(&A0), sbf, o0, 0, 0, 0);
          o1 = __builtin_amdgcn_mfma_f32_32x32x16_bf16(*reinterpret_cast<bf16x8*>(&A1), sbf, o1, 0, 0, 0);
        }
      }
    }
    {
      const char* KDT = L + GL_KDT;
#pragma unroll
      for (int r = 0; r < 16; ++r) { S0[r] *= BL[crow(r, hi)]; S1[r] *= BL[32 + crow(r, hi)]; }
#pragma unroll
      for (int s = 0; s < 4; ++s) {
        const bf16x8 Vs = s == 0 ? V0 : s == 1 ? V1 : s == 2 ? V2 : V3;
        const bf16x8 a0 = *(const bf16x8*)(KDT + gl_sw(r32, s * 16 + hi * 8)), a1 = *(const bf16x8*)(KDT + gl_sw(32 + r32, s * 16 + hi * 8));
        S0 = __builtin_amdgcn_mfma_f32_32x32x16_bf16(a0, Vs, S0, 0, 0, 0);
        S1 = __builtin_amdgcn_mfma_f32_32x32x16_bf16(a1, Vs, S1, 0, 0, 0);
      }
    }
    __syncthreads();
    {
      float* OL = (float*)L;
#pragma unroll
      for (int r = 0; r < 16; ++r) {
        OL[crow(r, hi) * GL_OLS + wv * 32 + r32] = o0[r];
        OL[(32 + crow(r, hi)) * GL_OLS + wv * 32 + r32] = o1[r];
      }
    }
    __syncthreads();
    {
      const float* OL = (const float*)L;
      const int row = td >> 2, sg = td & 3;
      const unsigned t = GL_TOK(row);
      float4 v[8];
#pragma unroll
      for (int q = 0; q < 8; ++q) v[q] = *(const float4*)(OL + row * GL_OLS + sg * 32 + q * 4);
      float4* og = (float4*)(OTMP + (t * 512u + (unsigned)(h * 128 + sg * 32)));
      if (c < 16) {
#pragma unroll
        for (int q = 0; q < 8; ++q) og[q] = v[q];
      } else {
        float ss = 0.f;
#pragma unroll
        for (int q = 0; q < 8; ++q) { const float4 w = og[q]; v[q].x += w.x; v[q].y += w.y; v[q].z += w.z; v[q].w += w.w;
          ss += v[q].x * v[q].x + v[q].y * v[q].y + v[q].z * v[q].z + v[q].w * v[q].w; }
        ss += dpp_f<0xB1>(ss); ss += dpp_f<0x4E>(ss);
        const float rstd = rsqrtf(ss * (1.f / 128.f) + EPS);
        const uint4* gg = (const uint4*)(GOUT + (t * 512u + (unsigned)(h * 128 + sg * 32)));
        const float4* gn = (const float4*)(p.gla_g + sg * 32);
        uint4* mo = (uint4*)(MIX + (t * 1024u + 512u + (unsigned)(h * 128 + sg * 32)));
#pragma unroll
        for (int q = 0; q < 4; ++q) {
          const uint4 gw4 = gg[q]; const float4 n0 = gn[2 * q], n1 = gn[2 * q + 1];
          const unsigned gws[4] = {gw4.x, gw4.y, gw4.z, gw4.w};
          const float ov[8] = {v[2 * q].x, v[2 * q].y, v[2 * q].z, v[2 * q].w, v[2 * q + 1].x, v[2 * q + 1].y, v[2 * q + 1].z, v[2 * q + 1].w};
          const float nn[8] = {n0.x, n0.y, n0.z, n0.w, n1.x, n1.y, n1.z, n1.w};
          unsigned ow[4];
#pragma unroll
          for (int e = 0; e < 4; ++e) {
            const float g0 = __uint_as_float(gws[e] << 16), g1 = __uint_as_float(gws[e] & 0xffff0000u);
            const float r0 = ov[2 * e] * rstd * nn[2 * e] * (g0 / (1.f + __expf(-g0)));
            const float r1 = ov[2 * e + 1] * rstd * nn[2 * e + 1] * (g1 / (1.f + __expf(-g1)));
            ow[e] = cvtpk(r0, r1);
          }
          mo[q] = make_uint4(ow[0], ow[1], ow[2], ow[3]);
        }
      }
    }
#undef GL_TOK
  }
}
__device__ __forceinline__ void gla_phase(const P& p, char* lds, int bid, int nb) {
  for (int item = bid; item < NSEQ * 4; item += nb) gla_item(p, lds, item >> 2, item & 3);
}

typedef _Float16 h2_t __attribute__((ext_vector_type(2)));
__device__ __forceinline__ unsigned enc_key(float f, unsigned idx, unsigned lowmask) {
  unsigned u = __float_as_uint(f);
  unsigned k = u ^ ((unsigned)((int)u >> 31) | 0x80000000u);
  return (k & ~lowmask) | idx;
}
__device__ __forceinline__ float dec_key(unsigned k, unsigned lowmask) {
  k &= ~lowmask;
  unsigned u = (k & 0x80000000u) ? (k & 0x7fffffffu) : ~k;
  return __uint_as_float(u);
}
__device__ __forceinline__ void ce_desc(unsigned& a, unsigned& b) { unsigned mx = a > b ? a : b, mn = a > b ? b : a; a = mx; b = mn; }
__device__ __forceinline__ void sort16_desc(unsigned (&k)[16]) {
#pragma unroll
  for (int size = 2; size <= 16; size <<= 1)
#pragma unroll
    for (int stride = size >> 1; stride > 0; stride >>= 1)
#pragma unroll
      for (int i = 0; i < 16; ++i) {
        const int l = i ^ stride;
        if (l > i) { if ((i & size) == 0) ce_desc(k[i], k[l]); else ce_desc(k[l], k[i]); }
      }
}
__device__ __forceinline__ void bmerge16_desc(unsigned (&k)[16]) {
#pragma unroll
  for (int stride = 8; stride > 0; stride >>= 1)
#pragma unroll
    for (int i = 0; i < 16; ++i) { const int l = i ^ stride; if (l > i) ce_desc(k[i], k[l]); }
}
__device__ __forceinline__ void merge_top16(unsigned (&top)[16], const unsigned (&nw)[16]) {
#pragma unroll
  for (int i = 0; i < 16; ++i) top[i] = top[i] > nw[15 - i] ? top[i] : nw[15 - i];
  bmerge16_desc(top);
}
constexpr int cand_a(int c) { return c < 16 ? 0 : c < 24 ? 1 : c < 29 ? 2 : c < 33 ? 3 : c < 36 ? 4 : c < 38 ? 5 : c < 40 ? 6 : c < 42 ? 7 : c < 50 ? c - 34 : -1; }
constexpr int cand_b(int c) { return c < 16 ? c : c < 24 ? c - 16 : c < 29 ? c - 24 : c < 33 ? c - 29 : c < 36 ? c - 33 : c < 38 ? c - 36 : c < 40 ? c - 38 : c < 42 ? c - 40 : 0; }

constexpr int PE_TOK = 64;
constexpr int PE_T1_STRIDE = 260;
constexpr int PE_LDS_TOP1 = PE_TOK * PE_T1_STRIDE * 4;
constexpr int PE_LDS = PE_LDS_TOP1 + PE_TOK * 128 * 8;

__device__ __forceinline__ void peer_topk1(const P& p, int tok0, int tl0, int g, unsigned* top1) {
  const int lane = threadIdx.x & 63, r32 = lane & 31, hi = lane >> 5;
  const bfu* SK = (const bfu*)(p.ws + OFF_SK) + (size_t)g * 128 * 128 + (size_t)r32 * 128 + hi * 8;
  const bfu* PQ = (const bfu*)(p.ws + OFF_PQ) + (size_t)(tok0 + r32) * 2048 + g * 128 + hi * 8;
  bf16x8 bq[8];
#pragma unroll
  for (int ks = 0; ks < 8; ++ks) bq[ks] = *reinterpret_cast<const bf16x8*>(PQ + ks * 16);
  unsigned top[16];
#pragma unroll
  for (int kt = 0; kt < 4; ++kt) {
    f32x16 acc = {};
#pragma unroll
    for (int ks = 0; ks < 8; ++ks) {
      bf16x8 a = *reinterpret_cast<const bf16x8*>(SK + (size_t)kt * 32 * 128 + ks * 16);
      acc = __builtin_amdgcn_mfma_f32_32x32x16_bf16(a, bq[ks], acc, 0, 0, 0);
    }
    unsigned key[16];
#pragma unroll
    for (int r = 0; r < 16; ++r) key[r] = enc_key(acc[r], (unsigned)(kt * 32 + (r & 3) + 8 * (r >> 2) + 4 * hi), 127u);
    sort16_desc(key);
    if (kt == 0) {
#pragma unroll
      for (int r = 0; r < 16; ++r) top[r] = key[r];
    } else merge_top16(top, key);
  }
  unsigned m[16];
#pragma unroll
  for (int i = 0; i < 16; ++i) {
    const unsigned mine = hi ? top[15 - i] : top[i];
    auto rr = __builtin_amdgcn_permlane32_swap(mine, mine, false, false);
    m[i] = rr[0] > rr[1] ? rr[0] : rr[1];
  }
  bmerge16_desc(m);
  if (hi == 0) {
    uint4* dst = (uint4*)(top1 + (tl0 + r32) * PE_T1_STRIDE + g * 16);
#pragma unroll
    for (int q = 0; q < 4; ++q) dst[q] = make_uint4(m[4 * q], m[4 * q + 1], m[4 * q + 2], m[4 * q + 3]);
  }
}
__device__ __forceinline__ void peer_topk2(const unsigned* top1, int* pidx, float* pgate) {
  const int tid = threadIdx.x, tl = tid >> 3, hh = tid & 7;
  const unsigned* l1 = top1 + tl * PE_T1_STRIDE + hh * 32;
  unsigned k1[16], k2[16];
#pragma unroll
  for (int q = 0; q < 4; ++q) {
    uint4 a = ((const uint4*)l1)[q], b = ((const uint4*)l1)[4 + q];
    k1[4 * q] = a.x; k1[4 * q + 1] = a.y; k1[4 * q + 2] = a.z; k1[4 * q + 3] = a.w;
    k2[4 * q] = b.x; k2[4 * q + 1] = b.y; k2[4 * q + 2] = b.z; k2[4 * q + 3] = b.w;
  }
  float f1[16], f2[16];
#pragma unroll
  for (int i = 0; i < 16; ++i) { f1[i] = dec_key(k1[i], 127u); f2[i] = dec_key(k2[i], 127u); }
  unsigned top[16];
#pragma unroll
  for (int bt = 0; bt < 4; ++bt) {
    unsigned key[16];
#pragma unroll
    for (int c = 0; c < 16; ++c) {
      const int cc = bt * 16 + c;
      const int a = cand_a(cc), b = cand_b(cc);
      key[c] = (a >= 0) ? enc_key(f1[a >= 0 ? a : 0] + f2[b], (unsigned)((a >= 0 ? a : 0) * 16 + b), 255u) : 0u;
    }
    sort16_desc(key);
    if (bt == 0) {
#pragma unroll
      for (int r = 0; r < 16; ++r) top[r] = key[r];
    } else merge_top16(top, key);
  }
  float s[16]; float sum = 0;
  const float m0 = dec_key(top[0], 255u);
#pragma unroll
  for (int r = 0; r < 16; ++r) { s[r] = __expf(dec_key(top[r], 255u) - m0); sum += s[r]; }
  const float inv = 1.f / sum;
#pragma unroll
  for (int r = 0; r < 16; ++r) {
    const unsigned ab = top[r] & 255u;
    const int i1 = (int)(l1[ab >> 4] & 127u), i2 = (int)(l1[16 + (ab & 15u)] & 127u);
    pidx[tl * 128 + hh * 16 + r] = i1 * 128 + i2;
    pgate[tl * 128 + hh * 16 + r] = s[r] * inv;
  }
}
__device__ __forceinline__ float gelu_tanh_f(float x) {
  float u = 0.7978845608028654f * (x + 0.044715f * x * x * x);
  float th = 1.f - 2.f / (1.f + __expf(2.f * u));
  return 0.5f * x * (1.f + th);
}
__device__ __forceinline__ unsigned pk_h2(float a, float b) { h2_t h = {(_Float16)a, (_Float16)b}; return __builtin_bit_cast(unsigned, h); }
__device__ __forceinline__ void peer_gather_token(const P& p, int t, const int* pidx_t, const float* pgate_t) {
  const int lane = threadIdx.x & 63;
  float* orow = p.out + (size_t)t * 1024;
  float hv[16];
  {
    const float4* hr = (const float4*)orow;
    float4 a = hr[lane * 2], b = hr[lane * 2 + 1], c = hr[128 + lane * 2], d = hr[128 + lane * 2 + 1];
    hv[0] = a.x; hv[1] = a.y; hv[2] = a.z; hv[3] = a.w; hv[4] = b.x; hv[5] = b.y; hv[6] = b.z; hv[7] = b.w;
    hv[8] = c.x; hv[9] = c.y; hv[10] = c.z; hv[11] = c.w; hv[12] = d.x; hv[13] = d.y; hv[14] = d.z; hv[15] = d.w;
  }
  float ss = 0;
#pragma unroll
  for (int i = 0; i < 16; ++i) ss += hv[i] * hv[i];
  ss = wave_sum(ss);
  const float rstd = rsqrtf(ss * (1.f / 1024.f) + EPS);
  unsigned xh[8];
  {
    const float4* gr = (const float4*)p.norm2_g;
    float4 a = gr[lane * 2], b = gr[lane * 2 + 1], c = gr[128 + lane * 2], d = gr[128 + lane * 2 + 1];
    float gg[16] = {a.x, a.y, a.z, a.w, b.x, b.y, b.z, b.w, c.x, c.y, c.z, c.w, d.x, d.y, d.z, d.w};
#pragma unroll
    for (int i = 0; i < 8; ++i) xh[i] = pk_h2(hv[2 * i] * rstd * gg[2 * i], hv[2 * i + 1] * rstd * gg[2 * i + 1]);
  }
  const int myi0 = pidx_t[lane], myi1 = pidx_t[64 + lane];
  const float myg0 = pgate_t[lane], myg1 = pgate_t[64 + lane];
  const __half* UT = (const __half*)(p.ws + OFF_UT) + lane * 8;
  const __half* VT = (const __half*)(p.ws + OFF_VT) + lane * 8;
  float acc32[16];
#pragma unroll
  for (int i = 0; i < 16; ++i) acc32[i] = 0.f;
  h2_t acc16[8];
#pragma unroll
  for (int i = 0; i < 8; ++i) acc16[i] = h2_t{(_Float16)0.f, (_Float16)0.f};
  for (int c = 0; c < 32; ++c) {
    const int isrc = (c < 16) ? myi0 : myi1; const float gsrc = (c < 16) ? myg0 : myg1;
    const int kb = (c & 15) * 4;
    uint4 U[4][2], V[4][2];
#pragma unroll
    for (int q = 0; q < 4; ++q) {
      const int e = __builtin_amdgcn_readlane(isrc, kb + q);
      const uint4* up = (const uint4*)(UT + (size_t)e * 1024); const uint4* vp = (const uint4*)(VT + (size_t)e * 1024);
      U[q][0] = up[0]; U[q][1] = up[64]; V[q][0] = vp[0]; V[q][1] = vp[64];
    }
    float d[4];
#pragma unroll
    for (int q = 0; q < 4; ++q) {
      float s = 0.f;
      const unsigned* u0 = (const unsigned*)&U[q][0]; const unsigned* u1 = (const unsigned*)&U[q][1];
#pragma unroll
      for (int j = 0; j < 4; ++j) s = __builtin_amdgcn_fdot2(__builtin_bit_cast(h2_t, u0[j]), __builtin_bit_cast(h2_t, xh[j]), s, false);
#pragma unroll
      for (int j = 0; j < 4; ++j) s = __builtin_amdgcn_fdot2(__builtin_bit_cast(h2_t, u1[j]), __builtin_bit_cast(h2_t, xh[4 + j]), s, false);
      d[q] = s;
    }
    float s2[2];
#pragma unroll
    for (int q = 0; q < 2; ++q) { auto rr = __builtin_amdgcn_permlane32_swap(__float_as_uint(d[q]), __float_as_uint(d[q + 2]), false, false); s2[q] = __uint_as_float(rr[0]) + __uint_as_float(rr[1]); }
    float act;
    { auto rr = __builtin_amdgcn_permlane16_swap(__float_as_uint(s2[0]), __float_as_uint(s2[1]), false, false); act = __uint_as_float(rr[0]) + __uint_as_float(rr[1]); }
    act = row16_sum(act);
    const float gl = __shfl(gsrc, kb + (lane >> 4));
    const float wl = gl * gelu_tanh_f(act);
    const unsigned whl = pk_h2(wl, wl);
#pragma unroll
    for (int q = 0; q < 4; ++q) {
      const h2_t wq = __builtin_bit_cast(h2_t, (unsigned)__builtin_amdgcn_readlane((int)whl, q * 16));
      const unsigned* v0 = (const unsigned*)&V[q][0]; const unsigned* v1 = (const unsigned*)&V[q][1];
#pragma unroll
      for (int j = 0; j < 4; ++j) acc16[j] = __builtin_bit_cast(h2_t, v0[j]) * wq + acc16[j];
#pragma unroll
      for (int j = 0; j < 4; ++j) acc16[4 + j] = __builtin_bit_cast(h2_t, v1[j]) * wq + acc16[4 + j];
    }
    if ((c & 3) == 3) {
#pragma unroll
      for (int i = 0; i < 8; ++i) { acc32[2 * i] += (float)acc16[i][0]; acc32[2 * i + 1] += (float)acc16[i][1]; acc16[i] = h2_t{(_Float16)0.f, (_Float16)0.f}; }
    }
  }
  float y[16]; ss = 0;
#pragma unroll
  for (int i = 0; i < 16; ++i) { y[i] = hv[i] + acc32[i]; ss += y[i] * y[i]; }
  ss = wave_sum(ss);
  const float rf = rsqrtf(ss * (1.f / 1024.f) + EPS);
  {
    const float4* gr = (const float4*)p.fin_g;
    float4 a = gr[lane * 2], b = gr[lane * 2 + 1], c = gr[128 + lane * 2], d = gr[128 + lane * 2 + 1];
    float4* o4 = (float4*)orow;
    o4[lane * 2] = make_float4(y[0] * rf * a.x, y[1] * rf * a.y, y[2] * rf * a.z, y[3] * rf * a.w);
    o4[lane * 2 + 1] = make_float4(y[4] * rf * b.x, y[5] * rf * b.y, y[6] * rf * b.z, y[7] * rf * b.w);
    o4[128 + lane * 2] = make_float4(y[8] * rf * c.x, y[9] * rf * c.y, y[10] * rf * c.z, y[11] * rf * c.w);
    o4[128 + lane * 2 + 1] = make_float4(y[12] * rf * d.x, y[13] * rf * d.y, y[14] * rf * d.z, y[15] * rf * d.w);
  }
}
__device__ __forceinline__ void peer_phase(const P& p, char* lds, int bid, int nb) {
  unsigned* top1 = (unsigned*)lds; int* pidx = (int*)(lds + PE_LDS_TOP1); float* pgate = (float*)(lds + PE_LDS_TOP1 + PE_TOK * 128 * 4);
  const int wid = threadIdx.x >> 6;
  for (int tile = bid; tile < T / PE_TOK; tile += nb) {
    const int tok0 = tile * PE_TOK;
    __syncthreads();
    for (int task = wid; task < 32; task += 8) peer_topk1(p, tok0 + (task & 1) * 32, (task & 1) * 32, task >> 1, top1);
    __syncthreads();
    peer_topk2(top1, pidx, pgate);
    __syncthreads();
    for (int i = 0; i < 8; ++i) { const int tl = wid * 8 + i; peer_gather_token(p, tok0 + tl, pidx + tl * 128, pgate + tl * 128); }
  }
}

constexpr int cmax(int a, int b) { return a > b ? a : b; }
constexpr int MEGA_LDS = cmax(cmax(G_LDS, ATT_LDS), cmax(PE_LDS, GLA_LDS));
__global__ __launch_bounds__(512) void mega(P p) {
  extern __shared__ __attribute__((aligned(16))) char lds[];
  cg::grid_group grid = cg::this_grid();
  const int bid = blockIdx.x, nb = gridDim.x;
  prep_phase(p, (long)bid * 512 + threadIdx.x, (long)nb * 512);
  grid.sync();
  gemm_phase<1>(p, lds, bid, nb);
  grid.sync();
  gemm_phase<2>(p, lds, bid, nb);
  grid.sync();
  gla_phase(p, lds, bid, nb);
  attn_phase(p, lds, bid, nb);
  grid.sync();
  gemm_phase<4>(p, lds, bid, nb);
  grid.sync();
  gemm_phase<5>(p, lds, bid, nb);
  grid.sync();
  peer_phase(p, lds, bid, nb);
}

extern "C" void kernel_launch(void* const* d_in, const int* in_sizes, int n_in, void* d_out, int out_size, void* d_ws, size_t ws_size,
                              hipStream_t stream) {
  if (ws_size < WS_NEED) { fprintf(stderr, "kernel_launch: ws too small: %zu < %zu\n", ws_size, WS_NEED); return; }
  P p{};
  p.xp = (const float*)d_in[0]; p.xs = (const float*)d_in[1]; p.norm1_g = (const float*)d_in[2]; p.w_in = (const float*)d_in[3];
  p.q_norm_g = (const float*)d_in[4]; p.w_uq = (const float*)d_in[5]; p.kv_norm_g = (const float*)d_in[6]; p.w_ukv = (const float*)d_in[7];
  p.gfw = (const float*)d_in[8]; p.gfb = (const float*)d_in[9]; p.gbw = (const float*)d_in[10]; p.gbb = (const float*)d_in[11];
  p.gla_g = (const float*)d_in[12]; p.w_o = (const float*)d_in[13]; p.norm2_g = (const float*)d_in[14]; p.wq = (const float*)d_in[15];
  p.subk = (const float*)d_in[16]; p.ut = (const float*)d_in[17]; p.vt = (const float*)d_in[18]; p.fin_g = (const float*)d_in[19];
  p.out = (float*)d_out; p.ws = (char*)d_ws;
  for (int i = 0; i < 16; ++i) p.freq[i] = (float)pow(10000.0, -(double)i * 2.0 / 32.0);
  static int grid_blocks = 0;
  if (!grid_blocks) {
    (void)hipFuncSetAttribute((const void*)mega, hipFuncAttributeMaxDynamicSharedMemorySize, MEGA_LDS);
    int dev = 0, cus = 0, per_cu = 0;
    (void)hipGetDevice(&dev);
    (void)hipDeviceGetAttribute(&cus, hipDeviceAttributeMultiprocessorCount, dev);
    (void)hipOccupancyMaxActiveBlocksPerMultiprocessor(&per_cu, mega, 512, MEGA_LDS);
    if (per_cu > 1) per_cu = 1;
    grid_blocks = cus * per_cu;
    if (grid_blocks <= 0) { fprintf(stderr, "kernel_launch: occupancy query gave %d x %d\n", cus, per_cu); grid_blocks = 0; return; }
  }
  void* args[] = {&p};
  hipError_t e = hipLaunchCooperativeKernel((void*)mega, dim3(grid_blocks), dim3(512), args, MEGA_LDS, stream);
  if (e != hipSuccess) fprintf(stderr, "cooperative launch failed: %s (grid %d)\n", hipGetErrorString(e), grid_blocks);
}
```

```cpp
#include <hip/hip_runtime.h>
#include <hip/hip_bf16.h>
#include <hip/hip_fp16.h>
#include <hip/hip_cooperative_groups.h>
namespace cg = cooperative_groups;
#include <cstdio>
#include <cmath>

constexpr int T = 81920, TP = 65536, DM = 1024, SEQ = 2048, NSEQ = 40;
constexpr int INW = 1984;
constexpr float EPS = 1e-6f;

typedef unsigned short bfu;
using bf16x8 = __attribute__((ext_vector_type(8))) short;
using f32x4 = __attribute__((ext_vector_type(4))) float;
using f32x16 = __attribute__((ext_vector_type(16))) float;
__device__ __forceinline__ bfu f2bf(float f) { unsigned u = __float_as_uint(f); u += 0x7fffu + ((u >> 16) & 1u); return (bfu)(u >> 16); }
__device__ __forceinline__ float bf2f(bfu h) { return __uint_as_float(((unsigned)h) << 16); }
__device__ __forceinline__ unsigned cvtpk(float lo, float hi) {
  unsigned r; asm volatile("v_cvt_pk_bf16_f32 %0, %1, %2" : "=v"(r) : "v"(lo), "v"(hi)); return r;
}

constexpr size_t al256(size_t x) { return (x + 255) / 256 * 256; }
constexpr size_t OFF_ROPE  = 0;
constexpr size_t OFF_WIN   = al256(OFF_ROPE + (size_t)2048 * 16 * 8);
constexpr size_t OFF_WUQ   = al256(OFF_WIN + (size_t)2048 * 1024 * 2);
constexpr size_t OFF_WUKV  = al256(OFF_WUQ + (size_t)768 * 256 * 2);
constexpr size_t OFF_WO    = al256(OFF_WUKV + (size_t)1024 * 128 * 2);
constexpr size_t OFF_WPQ   = al256(OFF_WO + (size_t)1024 * 1024 * 2);
constexpr size_t OFF_SK    = al256(OFF_WPQ + (size_t)2048 * 1024 * 2);
constexpr size_t OFF_UT    = al256(OFF_SK + (size_t)2048 * 128 * 2);
constexpr size_t OFF_VT    = al256(OFF_UT + (size_t)16384 * 1024);
constexpr size_t OFF_RSTD1 = al256(OFF_VT + (size_t)16384 * 1024);
constexpr size_t OFF_SSQ   = al256(OFF_RSTD1 + (size_t)T * 4);
constexpr size_t OFF_SSKV  = al256(OFF_SSQ + (size_t)T * 4 * 4);
constexpr size_t OFF_SS2   = al256(OFF_SSKV + (size_t)T * 2 * 4);
constexpr size_t OFF_XB    = al256(OFF_SS2 + (size_t)T * 16 * 4);
constexpr size_t OFF_CQ    = al256(OFF_XB + (size_t)T * 1024 * 2);
constexpr size_t OFF_CKV   = al256(OFF_CQ + (size_t)T * 256 * 2);
constexpr size_t OFF_KR    = al256(OFF_CKV + (size_t)T * 128 * 2);
constexpr size_t OFF_GQ    = al256(OFF_KR + (size_t)T * 32 * 2);
constexpr size_t OFF_GK    = al256(OFF_GQ + (size_t)T * 256 * 2);
constexpr size_t OFF_GV    = al256(OFF_GK + (size_t)T * 256 * 2);
constexpr size_t OFF_GLR   = al256(OFF_GV + (size_t)T * 512 * 2);
constexpr size_t OFF_GOUT  = al256(OFF_GLR + (size_t)T * 32 * 4);
constexpr size_t OFF_QF    = al256(OFF_GOUT + (size_t)T * 512 * 2);
constexpr size_t OFF_KV    = al256(OFF_QF + (size_t)T * 768 * 2);
constexpr size_t OFF_MIX   = al256(OFF_KV + (size_t)T * 1024 * 2);
constexpr size_t WS_NEED   = al256(OFF_MIX + (size_t)T * 1024 * 2);
constexpr size_t OFF_HB    = OFF_XB;
constexpr size_t OFF_PQ    = OFF_KR;
constexpr size_t OFF_OTMP  = OFF_XB;
static_assert(OFF_PQ + (size_t)T * 2048 * 2 <= OFF_MIX, "PQ alias overlaps live data");
static_assert(OFF_OTMP + (size_t)T * 512 * 4 <= OFF_CQ, "OTMP alias");
static_assert(WS_NEED <= (size_t)1073741824, "workspace budget");

struct P {
  const float *xp, *xs, *norm1_g, *w_in, *q_norm_g, *w_uq, *kv_norm_g, *w_ukv, *gfw, *gfb, *gbw, *gbb, *gla_g, *w_o, *norm2_g, *wq,
      *subk, *ut, *vt, *fin_g;
  float* out;
  char* ws;
  float freq[16];
};
__device__ __forceinline__ const float* xrow(const P& p, int t) { return t < TP ? p.xp + (size_t)t * DM : p.xs + (size_t)(t - TP) * DM; }

__device__ __forceinline__ float wave_sum(float v) {
  for (int o = 32; o > 0; o >>= 1) v += __shfl_xor(v, o);
  return v;
}
__device__ __forceinline__ float wave_max(float v) {
  for (int o = 32; o > 0; o >>= 1) v = fmaxf(v, __shfl_xor(v, o));
  return v;
}
template <int CTRL> __device__ __forceinline__ float dpp_f(float v) {
  return __builtin_bit_cast(float, __builtin_amdgcn_update_dpp(0, __builtin_bit_cast(int, v), CTRL, 0xf, 0xf, true));
}
__device__ __forceinline__ float row16_sum(float v) {
  v += dpp_f<0xB1>(v);
  v += dpp_f<0x4E>(v);
  v += dpp_f<0x141>(v);
  v += dpp_f<0x140>(v);
  return v;
}

__device__ __forceinline__ int win_src_col(int n) {
  if (n < 384) return n;
  if (n < 640) return 416 + (n - 384);
  if (n < 896) return 672 + (n - 640);
  if (n < 1408) return 928 + (n - 896);
  if (n < 1920) return 1472 + (n - 1408);
  if (n < 1952) return 384 + (n - 1920);
  if (n < 1984) return 1440 + (n - 1952);
  return -1;
}
__device__ __forceinline__ void cvt_t8(bfu* dst, const float* src, int K, int ldsrc, int n, int srccol, int k0, const float* gain, float scale) {
  unsigned w[4];
  float v[8];
#pragma unroll
  for (int i = 0; i < 8; ++i) {
    float g = gain ? gain[k0 + i] : 1.f;
    v[i] = (srccol >= 0) ? src[(size_t)(k0 + i) * ldsrc + srccol] * g * scale : 0.f;
  }
#pragma unroll
  for (int i = 0; i < 4; ++i) w[i] = cvtpk(v[2 * i], v[2 * i + 1]);
  *(uint4*)(dst + (size_t)n * K + k0) = make_uint4(w[0], w[1], w[2], w[3]);
}
__device__ void prep_phase(const P& p, long gtid, long gthreads) {
  for (long i = gtid; i < 2048 * 16; i += gthreads) {
    int pos = (int)(i >> 4), f = (int)(i & 15);
    float ang = (float)pos * p.freq[f];
    double rev = (double)ang * 0.15915494309189535;
    rev -= rint(rev);
    float r = (float)rev;
    float2 cs; cs.x = __builtin_amdgcn_cosf(r); cs.y = __builtin_amdgcn_sinf(r);
    ((float2*)(p.ws + OFF_ROPE))[i] = cs;
  }
  for (long i = gtid; i < 2048L * 128; i += gthreads) {
    int n = (int)(i & 2047), kc = (int)(i >> 11);
    cvt_t8((bfu*)(p.ws + OFF_WIN), p.w_in, 1024, INW, n, win_src_col(n), kc * 8, p.norm1_g, (n >= 384 && n < 640) ? 0.125f : 1.f);
  }
  for (long i = gtid; i < 768L * 32; i += gthreads) {
    int n = (int)(i % 768), kc = (int)(i / 768);
    cvt_t8((bfu*)(p.ws + OFF_WUQ), p.w_uq, 256, 768, n, n, kc * 8, p.q_norm_g, 1.f);
  }
  for (long i = gtid; i < 1024L * 16; i += gthreads) {
    int n = (int)(i & 1023), kc = (int)(i >> 10);
    cvt_t8((bfu*)(p.ws + OFF_WUKV), p.w_ukv, 128, 1024, n, n, kc * 8, p.kv_norm_g, 1.f);
  }
  for (long i = gtid; i < 1024L * 128; i += gthreads) {
    int n = (int)(i & 1023), kc = (int)(i >> 10);
    cvt_t8((bfu*)(p.ws + OFF_WO), p.w_o, 1024, 1024, n, n, kc * 8, nullptr, 1.f);
  }
  for (long i = gtid; i < 2048L * 128; i += gthreads) {
    int n = (int)(i & 2047), kc = (int)(i >> 11);
    cvt_t8((bfu*)(p.ws + OFF_WPQ), p.wq, 1024, 2048, n, n, kc * 8, p.norm2_g, 1.f);
  }
  for (long i = gtid; i < 2048L * 128 / 8; i += gthreads) {
    const float4* s = (const float4*)(p.subk + i * 8);
    float4 a = s[0], b = s[1];
    *(uint4*)((bfu*)(p.ws + OFF_SK) + i * 8) = make_uint4(cvtpk(a.x, a.y), cvtpk(a.z, a.w), cvtpk(b.x, b.y), cvtpk(b.z, b.w));
  }
  for (long i = gtid; i < 2L * 16384 * 1024 / 16; i += gthreads) {
    const long half = 16384L * 1024 / 16;
    const bool isv = i >= half; const long j = isv ? i - half : i;
    const float sc = isv ? 64.f : 128.f;
    const float4* s4 = (const float4*)((isv ? p.vt : p.ut) + j * 16);
    unsigned w[4];
#pragma unroll
    for (int q = 0; q < 4; ++q) {
      const float4 a = s4[q];
      int pk = __builtin_amdgcn_cvt_pk_fp8_f32(a.x * sc, a.y * sc, 0, false);
      pk = __builtin_amdgcn_cvt_pk_fp8_f32(a.z * sc, a.w * sc, pk, true);
      w[q] = (unsigned)pk;
    }
    *(uint4*)(p.ws + (isv ? OFF_VT : OFF_UT) + j * 16) = make_uint4(w[0], w[1], w[2], w[3]);
  }
  const long gw = gtid >> 6, nw = gthreads >> 6; const int lane = (int)(gtid & 63);
  for (long t = gw; t < T; t += nw) {
    const float4* x = (const float4*)xrow(p, (int)t);
    float4 v[4]; float ss = 0;
#pragma unroll
    for (int i = 0; i < 4; ++i) { v[i] = x[lane + 64 * i]; ss += v[i].x * v[i].x + v[i].y * v[i].y + v[i].z * v[i].z + v[i].w * v[i].w; }
    ss = wave_sum(ss);
    if (lane == 0) ((float*)(p.ws + OFF_RSTD1))[t] = rsqrtf(ss * (1.f / 1024.f) + EPS);
    bfu* xb = (bfu*)(p.ws + OFF_XB) + t * 1024;
#pragma unroll
    for (int i = 0; i < 4; ++i) *(uint2*)(xb + (lane + 64 * i) * 4) = make_uint2(cvtpk(v[i].x, v[i].y), cvtpk(v[i].z, v[i].w));
  }
}

constexpr int G_A_BYTES = 256 * 64 * 2, G_B_BYTES = 128 * 64 * 2, G_STAGE = G_A_BYTES + G_B_BYTES, G_LDS = 2 * G_STAGE;
__device__ __forceinline__ int gswz(int row, int slot) { return row * 128 + ((slot ^ (row & 7)) << 4); }
template <int K>
__device__ __forceinline__ void gemm_mainloop(const bfu* __restrict__ A, int lda, const bfu* __restrict__ Bt, int ldb, char* lds, f32x4 (&acc)[4][4]) {
  const int tid = threadIdx.x, lane = tid & 63, wid = tid >> 6, wm = wid >> 1, wn = wid & 1, fr = lane & 15, fq = lane >> 4;
  constexpr int KT = K / 64;
#pragma unroll
  for (int m = 0; m < 4; ++m)
#pragma unroll
    for (int n = 0; n < 4; ++n) acc[m][n] = f32x4{0.f, 0.f, 0.f, 0.f};
  auto stage = [&](int kt, int buf) {
    char* la = lds + buf * G_STAGE; char* lb = la + G_A_BYTES;
#pragma unroll
    for (int i = 0; i < 4; ++i) {
      int c = tid + 512 * i, row = c >> 3, sl = c & 7;
      __builtin_amdgcn_global_load_lds((const unsigned*)(A + (size_t)row * lda + kt * 64 + ((sl ^ (row & 7)) << 3)), (unsigned*)(la + c * 16), 16, 0, 0);
    }
#pragma unroll
    for (int i = 0; i < 2; ++i) {
      int c = tid + 512 * i, row = c >> 3, sl = c & 7;
      __builtin_amdgcn_global_load_lds((const unsigned*)(Bt + (size_t)row * ldb + kt * 64 + ((sl ^ (row & 7)) << 3)), (unsigned*)(lb + c * 16), 16, 0, 0);
    }
  };
  stage(0, 0);
  asm volatile("s_waitcnt vmcnt(0)" ::: "memory");
  __syncthreads();
  for (int t = 0; t < KT; ++t) {
    if (t + 1 < KT) stage(t + 1, (t + 1) & 1);
    const char* la = lds + (t & 1) * G_STAGE; const char* lb = la + G_A_BYTES;
#pragma unroll
    for (int kk = 0; kk < 2; ++kk) {
      bf16x8 a[4], b[4];
#pragma unroll
      for (int m = 0; m < 4; ++m) a[m] = *(const bf16x8*)(la + gswz(wm * 64 + m * 16 + fr, kk * 4 + fq));
#pragma unroll
      for (int n = 0; n < 4; ++n) b[n] = *(const bf16x8*)(lb + gswz(wn * 64 + n * 16 + fr, kk * 4 + fq));
#pragma unroll
      for (int m = 0; m < 4; ++m)
#pragma unroll
        for (int n = 0; n < 4; ++n) acc[m][n] = __builtin_amdgcn_mfma_f32_16x16x32_bf16(a[m], b[n], acc[m][n], 0, 0, 0);
    }
    asm volatile("s_waitcnt vmcnt(0)" ::: "memory");
    __syncthreads();
  }
}

struct TileCtx { int row0, col0, wm, wn, fr, fq; };

__device__ __forceinline__ void epi_g1(const P& p, const TileCtx& c, f32x4 (&acc)[4][4]) {
  const float* rstd1 = (const float*)(p.ws + OFF_RSTD1);
  const int tn = c.col0 >> 7;
  const float2* rope = (const float2*)(p.ws + OFF_ROPE);
#pragma unroll
  for (int m = 0; m < 4; ++m) {
    const int rb = c.row0 + c.wm * 64 + m * 16 + c.fq * 4;
    float rs[4];
#pragma unroll
    for (int j = 0; j < 4; ++j) rs[j] = rstd1[rb + j];
#pragma unroll
    for (int n = 0; n < 4; ++n)
#pragma unroll
      for (int j = 0; j < 4; ++j) acc[m][n][j] *= rs[j];
    if (tn <= 2) {
      bfu* dst; int ld, cb; float* ssd; int ssld, ssi;
      if (tn < 2) { dst = (bfu*)(p.ws + OFF_CQ); ld = 256; cb = c.col0; ssd = (float*)(p.ws + OFF_SSQ); ssld = 4; ssi = tn * 2 + c.wn; }
      else { dst = (bfu*)(p.ws + OFF_CKV); ld = 128; cb = c.col0 - 256; ssd = (float*)(p.ws + OFF_SSKV); ssld = 2; ssi = c.wn; }
#pragma unroll
      for (int j = 0; j < 4; ++j) {
        float ss = 0;
#pragma unroll
        for (int n = 0; n < 4; ++n) { float v = acc[m][n][j]; ss += v * v; dst[(size_t)(rb + j) * ld + cb + c.wn * 64 + n * 16 + c.fr] = f2bf(v); }
        ss = row16_sum(ss);
        if (c.fr == 0) ssd[(size_t)(rb + j) * ssld + ssi] = ss;
      }
    } else if (tn < 15) {
      bfu* dst; int ld, cb;
      if (tn < 5) { dst = (bfu*)(p.ws + OFF_GQ); ld = 256; cb = c.col0 - 384; }
      else if (tn < 7) { dst = (bfu*)(p.ws + OFF_GK); ld = 256; cb = c.col0 - 640; }
      else if (tn < 11) { dst = (bfu*)(p.ws + OFF_GV); ld = 512; cb = c.col0 - 896; }
      else { dst = (bfu*)(p.ws + OFF_GOUT); ld = 512; cb = c.col0 - 1408; }
#pragma unroll
      for (int j = 0; j < 4; ++j)
#pragma unroll
        for (int n = 0; n < 4; ++n) dst[(size_t)(rb + j) * ld + cb + c.wn * 64 + n * 16 + c.fr] = f2bf(acc[m][n][j]);
    } else if (c.wn == 0) {
      bfu* KR = (bfu*)(p.ws + OFF_KR); float* GLR = (float*)(p.ws + OFF_GLR);
#pragma unroll
      for (int j = 0; j < 4; ++j) {
        const int t = rb + j, pos = t & (SEQ - 1);
        const float2 cs = rope[pos * 16 + c.fr];
        const float x1 = acc[m][0][j], x2 = acc[m][1][j];
        KR[(size_t)t * 32 + c.fr] = f2bf(x1 * cs.x - x2 * cs.y);
        KR[(size_t)t * 32 + 16 + c.fr] = f2bf(x2 * cs.x + x1 * cs.y);
        GLR[(size_t)t * 32 + c.fr] = acc[m][2][j];
        GLR[(size_t)t * 32 + 16 + c.fr] = acc[m][3][j];
      }
    }
  }
}
__device__ __forceinline__ void epi_g2q(const P& p, const TileCtx& c, f32x4 (&acc)[4][4]) {
  const float4* ssq = (const float4*)(p.ws + OFF_SSQ);
  const float2* rope = (const float2*)(p.ws + OFF_ROPE);
  bfu* QF = (bfu*)(p.ws + OFF_QF);
#pragma unroll
  for (int m = 0; m < 4; ++m) {
    const int rb = c.row0 + c.wm * 64 + m * 16 + c.fq * 4;
#pragma unroll
    for (int j = 0; j < 4; ++j) {
      const int t = rb + j, pos = t & (SEQ - 1);
      const float4 s4 = ssq[t];
      const float rs = rsqrtf((s4.x + s4.y + s4.z + s4.w) * (1.f / 256.f) + EPS);
#pragma unroll
      for (int n = 0; n < 4; ++n) {
        const int cb = c.col0 + c.wn * 64 + n * 16, jb = cb % 96;
        float o = acc[m][n][j];
        if (jb == 64) { const float2 cs = rope[pos * 16 + c.fr]; o = acc[m][n][j] * cs.x - acc[m][(n + 1) & 3][j] * cs.y; }
        else if (jb == 80) { const float2 cs = rope[pos * 16 + c.fr]; o = acc[m][n][j] * cs.x + acc[m][(n + 3) & 3][j] * cs.y; }
        QF[(size_t)t * 768 + cb + c.fr] = f2bf(o * rs);
      }
    }
  }
}
__device__ __forceinline__ void epi_g2kv(const P& p, const TileCtx& c, f32x4 (&acc)[4][4]) {
  const float2* sskv = (const float2*)(p.ws + OFF_SSKV);
  bfu* KV = (bfu*)(p.ws + OFF_KV);
#pragma unroll
  for (int m = 0; m < 4; ++m) {
    const int rb = c.row0 + c.wm * 64 + m * 16 + c.fq * 4;
#pragma unroll
    for (int j = 0; j < 4; ++j) {
      const int t = rb + j;
      const float2 s2 = sskv[t];
      const float rs = rsqrtf((s2.x + s2.y) * (1.f / 128.f) + EPS);
#pragma unroll
      for (int n = 0; n < 4; ++n) KV[(size_t)t * 1024 + c.col0 + c.wn * 64 + n * 16 + c.fr] = f2bf(acc[m][n][j] * rs);
    }
  }
}
__device__ __forceinline__ void epi_g4(const P& p, const TileCtx& c, f32x4 (&acc)[4][4]) {
  bfu* HB = (bfu*)(p.ws + OFF_HB); float* SS2 = (float*)(p.ws + OFF_SS2);
  const int tn = c.col0 >> 7;
#pragma unroll
  for (int m = 0; m < 4; ++m) {
    const int rb = c.row0 + c.wm * 64 + m * 16 + c.fq * 4;
#pragma unroll
    for (int j = 0; j < 4; ++j) {
      const int t = rb + j; const float* x = xrow(p, t);
      float ss = 0;
#pragma unroll
      for (int n = 0; n < 4; ++n) {
        const int col = c.col0 + c.wn * 64 + n * 16 + c.fr;
        const float h = x[col] + acc[m][n][j];
        p.out[(size_t)t * 1024 + col] = h; HB[(size_t)t * 1024 + col] = f2bf(h); ss += h * h;
      }
      ss = row16_sum(ss);
      if (c.fr == 0) SS2[(size_t)t * 16 + tn * 2 + c.wn] = ss;
    }
  }
}
__device__ __forceinline__ void epi_g5(const P& p, const TileCtx& c, f32x4 (&acc)[4][4]) {
  const float4* ss2 = (const float4*)(p.ws + OFF_SS2);
  bfu* PQ = (bfu*)(p.ws + OFF_PQ);
#pragma unroll
  for (int m = 0; m < 4; ++m) {
    const int rb = c.row0 + c.wm * 64 + m * 16 + c.fq * 4;
#pragma unroll
    for (int j = 0; j < 4; ++j) {
      const int t = rb + j;
      float s = 0;
#pragma unroll
      for (int q = 0; q < 4; ++q) { const float4 v = ss2[(size_t)t * 4 + q]; s += v.x + v.y + v.z + v.w; }
      const float rs = rsqrtf(s * (1.f / 1024.f) + EPS);
#pragma unroll
      for (int n = 0; n < 4; ++n) PQ[(size_t)t * 2048 + c.col0 + c.wn * 64 + n * 16 + c.fr] = f2bf(acc[m][n][j] * rs);
    }
  }
}

template <int WHICH>
__device__ __forceinline__ void gemm_phase(const P& p, char* lds, int bid, int nb) {
  const int tid = threadIdx.x, lane = tid & 63, wid = tid >> 6;
  TileCtx c; c.wm = wid >> 1; c.wn = wid & 1; c.fr = lane & 15; c.fq = lane >> 4;
  f32x4 acc[4][4];
  constexpr int MT = T / 256;
  if constexpr (WHICH == 1) {
    constexpr int NT = 16;
    for (int tile = bid; tile < MT * NT; tile += nb) {
      c.row0 = (tile / NT) * 256; c.col0 = (tile % NT) * 128;
      gemm_mainloop<1024>((const bfu*)(p.ws + OFF_XB) + (size_t)c.row0 * 1024, 1024, (const bfu*)(p.ws + OFF_WIN) + (size_t)c.col0 * 1024, 1024, lds, acc);
      epi_g1(p, c, acc);
    }
  } else if constexpr (WHICH == 2) {
    constexpr int NT = 6 + 8;
    for (int tile = bid; tile < MT * NT; tile += nb) {
      c.row0 = (tile / NT) * 256; const int tn = tile % NT;
      if (tn < 6) {
        c.col0 = tn * 128;
        gemm_mainloop<256>((const bfu*)(p.ws + OFF_CQ) + (size_t)c.row0 * 256, 256, (const bfu*)(p.ws + OFF_WUQ) + (size_t)c.col0 * 256, 256, lds, acc);
        epi_g2q(p, c, acc);
      } else {
        c.col0 = (tn - 6) * 128;
        gemm_mainloop<128>((const bfu*)(p.ws + OFF_CKV) + (size_t)c.row0 * 128, 128, (const bfu*)(p.ws + OFF_WUKV) + (size_t)c.col0 * 128, 128, lds, acc);
        epi_g2kv(p, c, acc);
      }
    }
  } else if constexpr (WHICH == 4) {
    constexpr int NT = 8;
    for (int tile = bid; tile < MT * NT; tile += nb) {
      c.row0 = (tile / NT) * 256; c.col0 = (tile % NT) * 128;
      gemm_mainloop<1024>((const bfu*)(p.ws + OFF_MIX) + (size_t)c.row0 * 1024, 1024, (const bfu*)(p.ws + OFF_WO) + (size_t)c.col0 * 1024, 1024, lds, acc);
      epi_g4(p, c, acc);
    }
  } else {
    constexpr int NT = 16;
    for (int tile = bid; tile < MT * NT; tile += nb) {
      c.row0 = (tile / NT) * 256; c.col0 = (tile % NT) * 128;
      gemm_mainloop<1024>((const bfu*)(p.ws + OFF_HB) + (size_t)c.row0 * 1024, 1024, (const bfu*)(p.ws + OFF_WPQ) + (size_t)c.col0 * 1024, 1024, lds, acc);
      epi_g5(p, c, acc);
    }
  }
}

using s16x4  = __attribute__((ext_vector_type(4))) short;
using u32x4  = __attribute__((ext_vector_type(4))) unsigned;
constexpr float ATT_SCALE = 0.10206207261596577f;
constexpr float ATT_THR = 8.f;
constexpr int ATT_SHM_V = 64 * 64 * 2, ATT_SHM_K = 64 * 256, ATT_LDS = 2 * ATT_SHM_V + 2 * ATT_SHM_K + 8 * 64 * 4;
#define KSWZ(row, colB) ((row) * 256 + ((colB) ^ (((row) & 7) << 4)))
#define SBAR() __builtin_amdgcn_sched_barrier(0)
__device__ __forceinline__ int crow(int r, int hi) { return (r & 3) + 8 * (r >> 2) + 4 * hi; }
__device__ __forceinline__ void att_partialSM(f32x16& p0, f32x16& p1, float& m_reg, float& mn, float& alpha) {
  constexpr float C = ATT_SCALE * 1.4426950408889634f;
  float pmax = p0[0];
#pragma unroll
  for (int r = 1; r < 16; ++r) pmax = fmaxf(pmax, p0[r]);
#pragma unroll
  for (int r = 0; r < 16; ++r) pmax = fmaxf(pmax, p1[r]);
  { auto rr = __builtin_amdgcn_permlane32_swap(__float_as_uint(pmax), __float_as_uint(pmax), false, false);
    pmax = fmaxf(__uint_as_float(rr[0]), __uint_as_float(rr[1])); }
  if (__builtin_expect(__all(pmax - m_reg <= ATT_THR / ATT_SCALE), 1)) { mn = m_reg; alpha = 1.f; }
  else { mn = fmaxf(m_reg, pmax); alpha = __builtin_amdgcn_exp2f((m_reg - mn) * C); m_reg = mn; }
  float mnC = -mn * C;
#pragma unroll
  for (int r = 0; r < 16; ++r) p0[r] = fmaf(p0[r], C, mnC);
#pragma unroll
  for (int r = 0; r < 16; ++r) p1[r] = fmaf(p1[r], C, mnC);
#pragma unroll
  for (int r = 0; r < 16; ++r) p0[r] = __builtin_amdgcn_exp2f(p0[r]);
}
__device__ __forceinline__ void att_finishSM(f32x16& p0, f32x16& p1, float alpha, float& l_reg, bf16x8& pa0, bf16x8& pa1, bf16x8& pa2, bf16x8& pa3) {
#pragma unroll
  for (int r = 0; r < 16; ++r) p1[r] = __builtin_amdgcn_exp2f(p1[r]);
  float ps = 0;
#pragma unroll
  for (int r = 0; r < 16; ++r) ps += p0[r];
#pragma unroll
  for (int r = 0; r < 16; ++r) ps += p1[r];
  { auto rr = __builtin_amdgcn_permlane32_swap(__float_as_uint(ps), __float_as_uint(ps), false, false);
    ps = __uint_as_float(rr[0]) + __uint_as_float(rr[1]); }
  l_reg = l_reg * alpha + ps;
#define PK4(PP, BASE, OUT) do { unsigned a0 = cvtpk(PP[BASE + 0], PP[BASE + 1]), a1 = cvtpk(PP[BASE + 2], PP[BASE + 3]);   \
    unsigned b0 = cvtpk(PP[BASE + 4], PP[BASE + 5]), b1 = cvtpk(PP[BASE + 6], PP[BASE + 7]);                              \
    auto r0 = __builtin_amdgcn_permlane32_swap(a0, b0, false, false); auto r1 = __builtin_amdgcn_permlane32_swap(a1, b1, false, false); \
    u32x4 w = {r0[0], r1[0], r0[1], r1[1]}; OUT = *reinterpret_cast<bf16x8*>(&w); } while (0)
  PK4(p0, 0, pa0); PK4(p0, 8, pa1); PK4(p1, 0, pa2); PK4(p1, 8, pa3);
#undef PK4
}
__device__ __forceinline__ void att_qkt(f32x16& p0, f32x16& p1, const char* Ks, const bf16x8* qr, int r32, int hi) {
  p0 = f32x16{}; p1 = f32x16{};
#pragma unroll
  for (int d0 = 0; d0 < 6; ++d0) { int cb = (d0 * 16 + hi * 8) * 2;
    bf16x8 b0 = *reinterpret_cast<const bf16x8*>(Ks + KSWZ(r32, cb));
    bf16x8 b1 = *reinterpret_cast<const bf16x8*>(Ks + KSWZ(32 + r32, cb));
    p0 = __builtin_amdgcn_mfma_f32_32x32x16_bf16(b0, qr[d0], p0, 0, 0, 0);
    p1 = __builtin_amdgcn_mfma_f32_32x32x16_bf16(b1, qr[d0], p1, 0, 0, 0); }
}
__device__ __forceinline__ int att_v_st(int k, int c) { const int kk = (k & ~0xC) | ((k & 4) << 1) | ((k & 8) >> 1); return ((kk >> 3) * 2 + (c >> 5)) * 512 + ((kk & 7) * 32 + (c & 31)) * 2; }
__device__ __forceinline__ int att_v_rd_base(int lane) { return ((lane & 3) << 3) | (((lane >> 2) & 3) << 6) | (((lane >> 4) & 1) << 5) | (((lane >> 5) & 1) << 8); }
constexpr int att_v_rd_off(int d0, int ks, int half) { return d0 * 512 + ks * 2048 + half * 1024; }
template <int OFF> __device__ __forceinline__ s16x4 att_tr_read(int vb) {
  s16x4 r; asm volatile("ds_read_b64_tr_b16 %0, %1 offset:%2" : "=&v"(r) : "v"(vb), "i"(OFF) : "memory"); return r;
}
template <int D0> __device__ __forceinline__ void att_pv_one(f32x16& od, int vb, bf16x8 pa0, bf16x8 pa1, bf16x8 pa2, bf16x8 pa3) {
  const s16x4 l0 = att_tr_read<att_v_rd_off(D0, 0, 0)>(vb), h0 = att_tr_read<att_v_rd_off(D0, 0, 1)>(vb), l1 = att_tr_read<att_v_rd_off(D0, 1, 0)>(vb), h1 = att_tr_read<att_v_rd_off(D0, 1, 1)>(vb);
  const s16x4 l2 = att_tr_read<att_v_rd_off(D0, 2, 0)>(vb), h2 = att_tr_read<att_v_rd_off(D0, 2, 1)>(vb), l3 = att_tr_read<att_v_rd_off(D0, 3, 0)>(vb), h3 = att_tr_read<att_v_rd_off(D0, 3, 1)>(vb);
  asm volatile("s_waitcnt lgkmcnt(0)" ::: "memory"); SBAR();
#define PK(L, H) (bf16x8){L[0], L[1], L[2], L[3], H[0], H[1], H[2], H[3]}
  od = __builtin_amdgcn_mfma_f32_32x32x16_bf16(pa0, PK(l0, h0), od, 0, 0, 0);
  od = __builtin_amdgcn_mfma_f32_32x32x16_bf16(pa1, PK(l1, h1), od, 0, 0, 0);
  od = __builtin_amdgcn_mfma_f32_32x32x16_bf16(pa2, PK(l2, h2), od, 0, 0, 0);
  od = __builtin_amdgcn_mfma_f32_32x32x16_bf16(pa3, PK(l3, h3), od, 0, 0, 0);
#undef PK
}
__device__ __forceinline__ void attn_item(const P& p, char* lds, int seq, int h, int qb) {
  const int tid = threadIdx.x, wid = tid >> 6, lane = tid & 63, r32 = lane & 31, hi = lane >> 5;
  char* V_lds = lds; char* K_lds = lds + 2 * ATT_SHM_V;
  float* wsl = (float*)(lds + 2 * ATT_SHM_V + 2 * ATT_SHM_K) + wid * 64; float* li_l = wsl; float* al_l = wsl + 32;
  const size_t tb = (size_t)seq * SEQ;
  const bfu* QF = (const bfu*)(p.ws + OFF_QF); const bfu* KVg = (const bfu*)(p.ws + OFF_KV) + tb * 1024 + h * 128; const bfu* KRg = (const bfu*)(p.ws + OFF_KR) + tb * 32;
  float m_reg = -1e30f, l_reg = 0; f32x16 o[2] = {}; bf16x8 qr[6];
  const bfu* Qw = QF + (tb + qb * 256 + wid * 32 + r32) * 768 + h * 96 + hi * 8;
#pragma unroll
  for (int d0 = 0; d0 < 6; ++d0) qr[d0] = *reinterpret_cast<const bf16x8*>(Qw + d0 * 16);
  const int sk = tid >> 3, sch = tid & 7, rk = (tid >> 2) & 63, rch = tid & 3;
  const int vst = att_v_st(sk, sch * 8), kst = KSWZ(sk, sch * 16), rst = KSWZ(rk, 128 + rch * 16);
  const int vb0 = (int)(uintptr_t)V_lds + att_v_rd_base(lane);
  struct { bf16x8 v, k, r; } sr_[2];
#define SLOAD(i, k0) do { sr_[i].v = *reinterpret_cast<const bf16x8*>(KVg + (size_t)((k0) + sk) * 1024 + 64 + sch * 8); \
    sr_[i].k = *reinterpret_cast<const bf16x8*>(KVg + (size_t)((k0) + sk) * 1024 + sch * 8);                              \
    if (tid < 256) sr_[i].r = *reinterpret_cast<const bf16x8*>(KRg + (size_t)((k0) + rk) * 32 + rch * 8); } while (0)
#define SWRITE(b, i) do { *(bf16x8*)(V_lds + (b) * ATT_SHM_V + vst) = sr_[i].v; *(bf16x8*)(K_lds + (b) * ATT_SHM_K + kst) = sr_[i].k; \
    if (tid < 256) *(bf16x8*)(K_lds + (b) * ATT_SHM_K + rst) = sr_[i].r; } while (0)
#define RESC(a) do { if (__any((a) < 1.f)) { if (hi == 0) al_l[r32] = (a); asm volatile("s_waitcnt lgkmcnt(0)" ::: "memory"); \
    for (int d = 0; d < 2; ++d) for (int r = 0; r < 16; ++r) o[d][r] *= al_l[crow(r, hi)]; } } while (0)
  f32x16 pA0, pA1, pB0, pB1; float mnA, mnB, alA, alB; bf16x8 pa0, pa1, pa2, pa3; constexpr int NT = SEQ / 64;
  constexpr int SE = 0, SO = 1;
  __syncthreads();
  SLOAD(SE, 0); asm volatile("s_waitcnt vmcnt(0)" ::: "memory"); SWRITE(0, SE); __syncthreads();
  att_qkt(pA0, pA1, K_lds, qr, r32, hi); att_partialSM(pA0, pA1, m_reg, mnA, alA);
  SLOAD(SO, 64); SLOAD(SE, 128);
  asm volatile("s_waitcnt vmcnt(3)" ::: "memory"); SWRITE(1, SO); __syncthreads();
  for (int j = 1; j + 1 < NT; j += 2) {
    SBAR(); att_qkt(pB0, pB1, K_lds + ATT_SHM_K, qr, r32, hi);
    att_finishSM(pA0, pA1, alA, l_reg, pa0, pa1, pa2, pa3); SBAR();
    SLOAD(SO, (j + 2) * 64); SBAR();
    att_pv_one<0>(o[0], vb0, pa0, pa1, pa2, pa3); att_pv_one<1>(o[1], vb0, pa0, pa1, pa2, pa3); att_partialSM(pB0, pB1, m_reg, mnB, alB);
    __syncthreads(); asm volatile("s_waitcnt vmcnt(3)" ::: "memory"); SWRITE(0, SE);
    RESC(alB); __syncthreads();
    SBAR(); att_qkt(pA0, pA1, K_lds, qr, r32, hi);
    att_finishSM(pB0, pB1, alB, l_reg, pa0, pa1, pa2, pa3); SBAR();
    if (j + 3 < NT) SLOAD(SE, (j + 3) * 64); SBAR();
    att_pv_one<0>(o[0], vb0 + ATT_SHM_V, pa0, pa1, pa2, pa3); att_pv_one<1>(o[1], vb0 + ATT_SHM_V, pa0, pa1, pa2, pa3); att_partialSM(pA0, pA1, m_reg, mnA, alA);
    __syncthreads(); asm volatile("s_waitcnt vmcnt(3)" ::: "memory"); SWRITE(1, SO);
    RESC(alA); __syncthreads();
  }
  SBAR(); att_qkt(pB0, pB1, K_lds + ATT_SHM_K, qr, r32, hi);
  att_finishSM(pA0, pA1, alA, l_reg, pa0, pa1, pa2, pa3); SBAR();
  att_pv_one<0>(o[0], vb0, pa0, pa1, pa2, pa3); att_pv_one<1>(o[1], vb0, pa0, pa1, pa2, pa3); att_partialSM(pB0, pB1, m_reg, mnB, alB);
  __syncthreads(); RESC(alB);
  att_finishSM(pB0, pB1, alB, l_reg, pa0, pa1, pa2, pa3); SBAR();
  att_pv_one<0>(o[0], vb0 + ATT_SHM_V, pa0, pa1, pa2, pa3); att_pv_one<1>(o[1], vb0 + ATT_SHM_V, pa0, pa1, pa2, pa3);
  if (hi == 0) li_l[r32] = l_reg; asm volatile("s_waitcnt lgkmcnt(0)" ::: "memory");
  float rli[16];
#pragma unroll
  for (int r = 0; r < 16; ++r) rli[r] = __builtin_amdgcn_rcpf(li_l[crow(r, hi)]);
  bfu* Ow = (bfu*)(p.ws + OFF_MIX) + (tb + qb * 256 + wid * 32) * 1024 + h * 64;
#pragma unroll
  for (int r = 0; r < 16; ++r) { int orow = crow(r, hi);
#pragma unroll
    for (int d0 = 0; d0 < 2; ++d0) Ow[(size_t)orow * 1024 + d0 * 32 + r32] = f2bf(o[d0][r] * rli[r]); }
#undef SLOAD
#undef SWRITE
#undef RESC
}
__device__ __forceinline__ void attn_phase(const P& p, char* lds, int bid, int nb) {
  const int x = bid & 7, i = bid >> 3, per = nb >> 3;
  for (int j = i; j < 320; j += per) {
    const int pair = (j >> 3) * 8 + x, qb = j & 7;
    attn_item(p, lds, pair >> 3, pair & 7, qb);
  }
}

constexpr int GL_QD = 0, GL_KI = 8192, GL_KDT = 16384, GL_VI = 24576, GL_GLR = 40960, GL_SEG = 45056, GL_BL = 46080, GL_RSS = 46336, GL_DIR = 47360;
constexpr int GL_OLS = 132;
constexpr int GLA_LDS = 2 * GL_DIR;
static_assert(64 * GL_OLS * 4 <= GL_GLR, "output tile must fit over the operand images");
__device__ __forceinline__ int gl_sw(int row, int col) { return row * 128 + ((((col >> 3) ^ (row & 7))) << 4) + (col & 7) * 2; }
__device__ __forceinline__ int gl_v_st(int k, int c) { const int kk = (k & ~0xC) | ((k & 4) << 1) | ((k & 8) >> 1); return ((kk >> 3) * 4 + (c >> 5)) * 512 + ((kk & 7) * 32 + (c & 31)) * 2; }
template <int KS, int HALF> __device__ __forceinline__ s16x4 gl_tr(int vb) { return att_tr_read<KS * 4096 + HALF * 2048>(vb); }
#define GL_PK(L, H) (bf16x8){L[0], L[1], L[2], L[3], H[0], H[1], H[2], H[3]}
__device__ __forceinline__ void gl_pk4(const f32x16& P, int BASE_is8, bf16x8& OUT) {
  unsigned a0, a1, b0, b1;
  if (BASE_is8 == 0) { a0 = cvtpk(P[0], P[1]); a1 = cvtpk(P[2], P[3]); b0 = cvtpk(P[4], P[5]); b1 = cvtpk(P[6], P[7]); }
  else { a0 = cvtpk(P[8], P[9]); a1 = cvtpk(P[10], P[11]); b0 = cvtpk(P[12], P[13]); b1 = cvtpk(P[14], P[15]); }
  auto r0 = __builtin_amdgcn_permlane32_swap(a0, b0, false, false); auto r1 = __builtin_amdgcn_permlane32_swap(a1, b1, false, false);
  u32x4 w = {r0[0], r1[0], r0[1], r1[1]}; OUT = *reinterpret_cast<bf16x8*>(&w);
}
__device__ __forceinline__ float half32_sum(float v) {
  v = row16_sum(v);
  auto rr = __builtin_amdgcn_permlane16_swap(__float_as_uint(v), __float_as_uint(v), false, false);
  return __uint_as_float(rr[0]) + __uint_as_float(rr[1]);
}
__device__ __forceinline__ void gla_item(const P& p, char* lds, int seq, int h) {
  const int tid = threadIdx.x, wid = tid >> 6, lane = tid & 63, r32 = lane & 31, hi = lane >> 5;
  const int dir = wid >> 2, wv = wid & 3, td = tid & 255;
  char* L = lds + dir * GL_DIR;
  float* GLRS = (float*)(L + GL_GLR); float* SEG = (float*)(L + GL_SEG); float* BL = (float*)(L + GL_BL); float* RSS = (float*)(L + GL_RSS);
  const unsigned tb = (unsigned)seq * SEQ;
  const bfu* GQ = (const bfu*)(p.ws + OFF_GQ); const bfu* GK = (const bfu*)(p.ws + OFF_GK); const bfu* GV = (const bfu*)(p.ws + OFF_GV);
  const float* GLR = (const float*)(p.ws + OFF_GLR); const bfu* GOUT = (const bfu*)(p.ws + OFF_GOUT);
  float* OTMP = (float*)(p.ws + OFF_OTMP); bfu* MIX = (bfu*)(p.ws + OFF_MIX);
  const int d = td & 63, seg = td >> 6;
  float gwr[16];
  {
    const float* gw = dir ? p.gbw : p.gfw;
#pragma unroll
    for (int q = 0; q < 16; ++q) gwr[q] = gw[q * 256 + h * 64 + d];
  }
  const float gbias = (dir ? p.gbb : p.gfb)[h * 64 + d];
  f32x16 S0 = {}, S1 = {};
  const int vb = (int)(uintptr_t)(L + GL_VI) + att_v_rd_base(lane) + wv * 512;
  for (int c = 0; c < 32; ++c) {
    const int cc = dir ? 31 - c : c;
    const unsigned t0 = tb + (unsigned)cc * 64u;
#define GL_TOK(sp) (t0 + (unsigned)(dir ? 63 - (sp) : (sp)))
    __syncthreads();
    float qv[16], kv[16];
#pragma unroll
    for (int r = 0; r < 16; ++r) { const unsigned t = GL_TOK(seg * 16 + r); qv[r] = bf2f(GQ[t * 256u + (unsigned)(h * 64 + d)]); kv[r] = bf2f(GK[t * 256u + (unsigned)(h * 64 + d)]); }
    { const int sp = td >> 2, q4 = td & 3; const unsigned t = GL_TOK(sp);
      *(float4*)(GLRS + sp * 16 + q4 * 4) = *(const float4*)(GLR + (t * 32u + (unsigned)(dir * 16 + q4 * 4))); }
#pragma unroll
    for (int i = 0; i < 4; ++i) { const int e = td + 256 * i, sp = e >> 4, ch = e & 15; const unsigned t = GL_TOK(sp);
      *(bf16x8*)(L + GL_VI + gl_v_st(sp, ch * 8)) = *(const bf16x8*)(GV + (t * 512u + (unsigned)(h * 128 + ch * 8))); }
    __syncthreads();
    float bcum[16]; float run = 0.f;
#pragma unroll
    for (int r = 0; r < 16; ++r) {
      const float4* g4 = (const float4*)(GLRS + (seg * 16 + r) * 16);
      float z = gbias;
#pragma unroll
      for (int q = 0; q < 4; ++q) { const float4 v = g4[q]; z += v.x * gwr[4 * q] + v.y * gwr[4 * q + 1] + v.z * gwr[4 * q + 2] + v.w * gwr[4 * q + 3]; }
      const float ls = fminf(z, 0.f) - __logf(1.f + __expf(-fabsf(z)));
      run += ls * (1.f / 16.f); bcum[r] = run;
    }
    SEG[seg * 64 + d] = run;
    __syncthreads();
    {
      const float s0 = SEG[d], s1 = SEG[64 + d], s2 = SEG[128 + d], s3 = SEG[192 + d];
      const float off = (seg > 0 ? s0 : 0.f) + (seg > 1 ? s1 : 0.f) + (seg > 2 ? s2 : 0.f);
      const float total = s0 + s1 + s2 + s3;
      unsigned kd[8];
#pragma unroll
      for (int r = 0; r < 16; ++r) {
        const float b = bcum[r] + off;
        const float e1 = __expf(b), e2 = __expf(-b), e3 = __expf(total - b);
        const int sp = seg * 16 + r;
        *(bfu*)(L + GL_QD + gl_sw(sp, d)) = f2bf(qv[r] * e1);
        *(bfu*)(L + GL_KI + gl_sw(sp, d)) = f2bf(kv[r] * e2);
        const float kdv = kv[r] * e3;
        if (r & 1) kd[r >> 1] = cvtpk(__uint_as_float(kd[r >> 1]), kdv); else kd[r >> 1] = __float_as_uint(kdv);
      }
      *(uint4*)(L + GL_KDT + gl_sw(d, seg * 16)) = make_uint4(kd[0], kd[1], kd[2], kd[3]);
      *(uint4*)(L + GL_KDT + gl_sw(d, seg * 16 + 8)) = make_uint4(kd[4], kd[5], kd[6], kd[7]);
      if (seg == 0) BL[d] = __expf(total);
    }
    __syncthreads();
    f32x16 X00 = {}, X01 = {}, X11 = {};
    {
      const char* KI = L + GL_KI; const char* QD = L + GL_QD;
#pragma unroll
      for (int ks = 0; ks < 4; ++ks) {
        const int col = ks * 16 + hi * 8;
        const bf16x8 a0 = *(const bf16x8*)(KI + gl_sw(r32, col)), a1 = *(const bf16x8*)(KI + gl_sw(32 + r32, col));
        const bf16x8 b0 = *(const bf16x8*)(QD + gl_sw(r32, col)), b1 = *(const bf16x8*)(QD + gl_sw(32 + r32, col));
        X00 = __builtin_amdgcn_mfma_f32_32x32x16_bf16(a0, b0, X00, 0, 0, 0);
        X01 = __builtin_amdgcn_mfma_f32_32x32x16_bf16(a0, b1, X01, 0, 0, 0);
        X11 = __builtin_amdgcn_mfma_f32_32x32x16_bf16(a1, b1, X11, 0, 0, 0);
      }
    }
#pragma unroll
    for (int r = 0; r < 16; ++r) { const bool keep = crow(r, hi) <= r32; X00[r] = keep ? X00[r] : 0.f; X11[r] = keep ? X11[r] : 0.f; }
    const s16x4 l0 = gl_tr<0, 0>(vb), h0 = gl_tr<0, 1>(vb), l1 = gl_tr<1, 0>(vb), h1 = gl_tr<1, 1>(vb);
    const s16x4 l2 = gl_tr<2, 0>(vb), h2 = gl_tr<2, 1>(vb), l3 = gl_tr<3, 0>(vb), h3 = gl_tr<3, 1>(vb);
    asm volatile("s_waitcnt lgkmcnt(0)" ::: "memory"); SBAR();
    const bf16x8 V0 = GL_PK(l0, h0), V1 = GL_PK(l1, h1), V2 = GL_PK(l2, h2), V3 = GL_PK(l3, h3);
    f32x16 o0 = {}, o1 = {};
    { bf16x8 pa0, pa1, pa2, pa3;
      gl_pk4(X00, 0, pa0); gl_pk4(X00, 1, pa1);
      o0 = __builtin_amdgcn_mfma_f32_32x32x16_bf16(pa0, V0, o0, 0, 0, 0);
      o0 = __builtin_amdgcn_mfma_f32_32x32x16_bf16(pa1, V1, o0, 0, 0, 0);
      gl_pk4(X01, 0, pa0); gl_pk4(X01, 1, pa1); gl_pk4(X11, 0, pa2); gl_pk4(X11, 1, pa3);
      o1 = __builtin_amdgcn_mfma_f32_32x32x16_bf16(pa0, V0, o1, 0, 0, 0);
      o1 = __builtin_amdgcn_mfma_f32_32x32x16_bf16(pa1, V1, o1, 0, 0, 0);
      o1 = __builtin_amdgcn_mfma_f32_32x32x16_bf16(pa2, V2, o1, 0, 0, 0);
      o1 = __builtin_amdgcn_mfma_f32_32x32x16_bf16(pa3, V3, o1, 0, 0, 0);
    }
    {
      const char* QD = L + GL_QD;
#pragma unroll
      for (int dt = 0; dt < 2; ++dt) {
        const f32x16& Sx = dt ? S1 : S0;
#pragma unroll
        for (int ks = 0; ks < 2; ++ks) {
          u32x4 sb = {cvtpk(Sx[8 * ks + 0], Sx[8 * ks + 1]), cvtpk(Sx[8 * ks + 2], Sx[8 * ks + 3]), cvtpk(Sx[8 * ks + 4], Sx[8 * ks + 5]), cvtpk(Sx[8 * ks + 6], Sx[8 * ks + 7])};
          const bf16x8 sbf = *reinterpret_cast<bf16x8*>(&sb);
          const int dcol = dt * 32 + ks * 16 + hi * 4;
          const uint2 a0l = *(const uint2*)(QD + gl_sw(r32, dcol)), a0h = *(const uint2*)(QD + gl_sw(r32, dcol + 8));
          const uint2 a1l = *(const uint2*)(QD + gl_sw(32 + r32, dcol)), a1h = *(const uint2*)(QD + gl_sw(32 + r32, dcol + 8));
          u32x4 A0 = {a0l.x, a0l.y, a0h.x, a0h.y}, A1 = {a1l.x, a1l.y, a1h.x, a1h.y};
          o0 = __builtin_amdgcn_mfma_f32_32x32x16_bf16(*reinterpret_cast<bf16x8*>(&A0), sbf, o0, 0, 0, 0);
          o1 = __builtin_amdgcn_mfma_f32_32x32x16_bf16(*reinterpret_cast<bf16x8*>(&A1), sbf, o1, 0, 0, 0);
        }
      }
    }
    {
      const char* KDT = L + GL_KDT;
#pragma unroll
      for (int r = 0; r < 16; ++r) { S0[r] *= BL[crow(r, hi)]; S1[r] *= BL[32 + crow(r, hi)]; }
#pragma unroll
      for (int s = 0; s < 4; ++s) {
        const bf16x8 Vs = s == 0 ? V0 : s == 1 ? V1 : s == 2 ? V2 : V3;
        const bf16x8 a0 = *(const bf16x8*)(KDT + gl_sw(r32, s * 16 + hi * 8)), a1 = *(const bf16x8*)(KDT + gl_sw(32 + r32, s * 16 + hi * 8));
        S0 = __builtin_amdgcn_mfma_f32_32x32x16_bf16(a0, Vs, S0, 0, 0, 0);
        S1 = __builtin_amdgcn_mfma_f32_32x32x16_bf16(a1, Vs, S1, 0, 0, 0);
      }
    }
    __syncthreads();
    {
      float* OL = (float*)L;
#pragma unroll
      for (int r = 0; r < 16; ++r) {
        OL[crow(r, hi) * GL_OLS + wv * 32 + r32] = o0[r];
        OL[(32 + crow(r, hi)) * GL_OLS + wv * 32 + r32] = o1[r];
      }
    }
    __syncthreads();
    {
      const float* OL = (const float*)L;
      const int row = td >> 2, sg = td & 3;
      const unsigned t = GL_TOK(row);
      float4 v[8];
#pragma unroll
      for (int q = 0; q < 8; ++q) v[q] = *(const float4*)(OL + row * GL_OLS + sg * 32 + q * 4);
      float4* og = (float4*)(OTMP + (t * 512u + (unsigned)(h * 128 + sg * 32)));
      if (c < 16) {
#pragma unroll
        for (int q = 0; q < 8; ++q) og[q] = v[q];
      } else {
        float ss = 0.f;
#pragma unroll
        for (int q = 0; q < 8; ++q) { const float4 w = og[q]; v[q].x += w.x; v[q].y += w.y; v[q].z += w.z; v[q].w += w.w;
          ss += v[q].x * v[q].x + v[q].y * v[q].y + v[q].z * v[q].z + v[q].w * v[q].w; }
        ss += dpp_f<0xB1>(ss); ss += dpp_f<0x4E>(ss);
        const float rstd = rsqrtf(ss * (1.f / 128.f) + EPS);
        const uint4* gg = (const uint4*)(GOUT + (t * 512u + (unsigned)(h * 128 + sg * 32)));
        const float4* gn = (const float4*)(p.gla_g + sg * 32);
        uint4* mo = (uint4*)(MIX + (t * 1024u + 512u + (unsigned)(h * 128 + sg * 32)));
#pragma unroll
        for (int q = 0; q < 4; ++q) {
          const uint4 gw4 = gg[q]; const float4 n0 = gn[2 * q], n1 = gn[2 * q + 1];
          const unsigned gws[4] = {gw4.x, gw4.y, gw4.z, gw4.w};
          const float ov[8] = {v[2 * q].x, v[2 * q].y, v[2 * q].z, v[2 * q].w, v[2 * q + 1].x, v[2 * q + 1].y, v[2 * q + 1].z, v[2 * q + 1].w};
          const float nn[8] = {n0.x, n0.y, n0.z, n0.w, n1.x, n1.y, n1.z, n1.w};
          unsigned ow[4];
#pragma unroll
          for (int e = 0; e < 4; ++e) {
            const float g0 = __uint_as_float(gws[e] << 16), g1 = __uint_as_float(gws[e] & 0xffff0000u);
            const float r0 = ov[2 * e] * rstd * nn[2 * e] * (g0 / (1.f + __expf(-g0)));
            const float r1 = ov[2 * e + 1] * rstd * nn[2 * e + 1] * (g1 / (1.f + __expf(-g1)));
            ow[e] = cvtpk(r0, r1);
          }
          mo[q] = make_uint4(ow[0], ow[1], ow[2], ow[3]);
        }
      }
    }
#undef GL_TOK
  }
}
__device__ __forceinline__ void gla_phase(const P& p, char* lds, int bid, int nb) {
  for (int item = bid; item < NSEQ * 4; item += nb) gla_item(p, lds, item >> 2, item & 3);
}

typedef _Float16 h2_t __attribute__((ext_vector_type(2)));
__device__ __forceinline__ unsigned enc_key(float f, unsigned idx, unsigned lowmask) {
  unsigned u = __float_as_uint(f);
  unsigned k = u ^ ((unsigned)((int)u >> 31) | 0x80000000u);
  return (k & ~lowmask) | idx;
}
__device__ __forceinline__ float dec_key(unsigned k, unsigned lowmask) {
  k &= ~lowmask;
  unsigned u = (k & 0x80000000u) ? (k & 0x7fffffffu) : ~k;
  return __uint_as_float(u);
}
__device__ __forceinline__ void ce_desc(unsigned& a, unsigned& b) { unsigned mx = a > b ? a : b, mn = a > b ? b : a; a = mx; b = mn; }
__device__ __forceinline__ void sort16_desc(unsigned (&k)[16]) {
#pragma unroll
  for (int size = 2; size <= 16; size <<= 1)
#pragma unroll
    for (int stride = size >> 1; stride > 0; stride >>= 1)
#pragma unroll
      for (int i = 0; i < 16; ++i) {
        const int l = i ^ stride;
        if (l > i) { if ((i & size) == 0) ce_desc(k[i], k[l]); else ce_desc(k[l], k[i]); }
      }
}
__device__ __forceinline__ void bmerge16_desc(unsigned (&k)[16]) {
#pragma unroll
  for (int stride = 8; stride > 0; stride >>= 1)
#pragma unroll
    for (int i = 0; i < 16; ++i) { const int l = i ^ stride; if (l > i) ce_desc(k[i], k[l]); }
}
__device__ __forceinline__ void merge_top16(unsigned (&top)[16], const unsigned (&nw)[16]) {
#pragma unroll
  for (int i = 0; i < 16; ++i) top[i] = top[i] > nw[15 - i] ? top[i] : nw[15 - i];
  bmerge16_desc(top);
}
constexpr int cand_a(int c) { return c < 16 ? 0 : c < 24 ? 1 : c < 29 ? 2 : c < 33 ? 3 : c < 36 ? 4 : c < 38 ? 5 : c < 40 ? 6 : c < 42 ? 7 : c < 50 ? c - 34 : -1; }
constexpr int cand_b(int c) { return c < 16 ? c : c < 24 ? c - 16 : c < 29 ? c - 24 : c < 33 ? c - 29 : c < 36 ? c - 33 : c < 38 ? c - 36 : c < 40 ? c - 38 : c < 42 ? c - 40 : 0; }

constexpr int PE_TOK = 64;
constexpr int PE_T1_STRIDE = 260;
constexpr int PE_LDS_TOP1 = PE_TOK * PE_T1_STRIDE * 4;
constexpr int PE_LDS = PE_LDS_TOP1 + PE_TOK * 128 * 8;

__device__ __forceinline__ void peer_topk1(const P& p, int tok0, int tl0, int g, unsigned* top1) {
  const int lane = threadIdx.x & 63, r32 = lane & 31, hi = lane >> 5;
  const bfu* SK = (const bfu*)(p.ws + OFF_SK) + (size_t)g * 128 * 128 + (size_t)r32 * 128 + hi * 8;
  const bfu* PQ = (const bfu*)(p.ws + OFF_PQ) + (size_t)(tok0 + r32) * 2048 + g * 128 + hi * 8;
  bf16x8 bq[8];
#pragma unroll
  for (int ks = 0; ks < 8; ++ks) bq[ks] = *reinterpret_cast<const bf16x8*>(PQ + ks * 16);
  unsigned top[16];
#pragma unroll
  for (int kt = 0; kt < 4; ++kt) {
    f32x16 acc = {};
#pragma unroll
    for (int ks = 0; ks < 8; ++ks) {
      bf16x8 a = *reinterpret_cast<const bf16x8*>(SK + (size_t)kt * 32 * 128 + ks * 16);
      acc = __builtin_amdgcn_mfma_f32_32x32x16_bf16(a, bq[ks], acc, 0, 0, 0);
    }
    unsigned key[16];
#pragma unroll
    for (int r = 0; r < 16; ++r) key[r] = enc_key(acc[r], (unsigned)(kt * 32 + (r & 3) + 8 * (r >> 2) + 4 * hi), 127u);
    sort16_desc(key);
    if (kt == 0) {
#pragma unroll
      for (int r = 0; r < 16; ++r) top[r] = key[r];
    } else merge_top16(top, key);
  }
  unsigned m[16];
#pragma unroll
  for (int i = 0; i < 16; ++i) {
    const unsigned mine = hi ? top[15 - i] : top[i];
    auto rr = __builtin_amdgcn_permlane32_swap(mine, mine, false, false);
    m[i] = rr[0] > rr[1] ? rr[0] : rr[1];
  }
  bmerge16_desc(m);
  if (hi == 0) {
    uint4* dst = (uint4*)(top1 + (tl0 + r32) * PE_T1_STRIDE + g * 16);
#pragma unroll
    for (int q = 0; q < 4; ++q) dst[q] = make_uint4(m[4 * q], m[4 * q + 1], m[4 * q + 2], m[4 * q + 3]);
  }
}
__device__ __forceinline__ void peer_topk2(const unsigned* top1, int* pidx, float* pgate) {
  const int tid = threadIdx.x, tl = tid >> 3, hh = tid & 7;
  const unsigned* l1 = top1 + tl * PE_T1_STRIDE + hh * 32;
  unsigned k1[16], k2[16];
#pragma unroll
  for (int q = 0; q < 4; ++q) {
    uint4 a = ((const uint4*)l1)[q], b = ((const uint4*)l1)[4 + q];
    k1[4 * q] = a.x; k1[4 * q + 1] = a.y; k1[4 * q + 2] = a.z; k1[4 * q + 3] = a.w;
    k2[4 * q] = b.x; k2[4 * q + 1] = b.y; k2[4 * q + 2] = b.z; k2[4 * q + 3] = b.w;
  }
  float f1[16], f2[16];
#pragma unroll
  for (int i = 0; i < 16; ++i) { f1[i] = dec_key(k1[i], 127u); f2[i] = dec_key(k2[i], 127u); }
  unsigned top[16];
#pragma unroll
  for (int bt = 0; bt < 4; ++bt) {
    unsigned key[16];
#pragma unroll
    for (int c = 0; c < 16; ++c) {
      const int cc = bt * 16 + c;
      const int a = cand_a(cc), b = cand_b(cc);
      key[c] = (a >= 0) ? enc_key(f1[a >= 0 ? a : 0] + f2[b], (unsigned)((a >= 0 ? a : 0) * 16 + b), 255u) : 0u;
    }
    sort16_desc(key);
    if (bt == 0) {
#pragma unroll
      for (int r = 0; r < 16; ++r) top[r] = key[r];
    } else merge_top16(top, key);
  }
  float s[16]; float sum = 0;
  const float m0 = dec_key(top[0], 255u);
#pragma unroll
  for (int r = 0; r < 16; ++r) { s[r] = __expf(dec_key(top[r], 255u) - m0); sum += s[r]; }
  const float inv = 1.f / sum;
#pragma unroll
  for (int r = 0; r < 16; ++r) {
    const unsigned ab = top[r] & 255u;
    const int i1 = (int)(l1[ab >> 4] & 127u), i2 = (int)(l1[16 + (ab & 15u)] & 127u);
    pidx[tl * 128 + hh * 16 + r] = i1 * 128 + i2;
    pgate[tl * 128 + hh * 16 + r] = s[r] * inv;
  }
}
__device__ __forceinline__ float gelu_tanh_f(float x) {
  float u = 0.7978845608028654f * (x + 0.044715f * x * x * x);
  float th = 1.f - 2.f / (1.f + __expf(2.f * u));
  return 0.5f * x * (1.f + th);
}
__device__ __forceinline__ unsigned pk_h2(float a, float b) { h2_t h = {(_Float16)a, (_Float16)b}; return __builtin_bit_cast(unsigned, h); }
__device__ __forceinline__ void peer_gather_token(const P& p, int t, const int* pidx_t, const float* pgate_t) {
  const int lane = threadIdx.x & 63;
  float* orow = p.out + (size_t)t * 1024;
  float hv[16];
  {
    const float4* hr = (const float4*)orow + lane * 4;
#pragma unroll
    for (int q = 0; q < 4; ++q) { const float4 a = hr[q]; hv[4 * q] = a.x; hv[4 * q + 1] = a.y; hv[4 * q + 2] = a.z; hv[4 * q + 3] = a.w; }
  }
  float ss = 0;
#pragma unroll
  for (int i = 0; i < 16; ++i) ss += hv[i] * hv[i];
  ss = wave_sum(ss);
  const float rstd = rsqrtf(ss * (1.f / 1024.f) + EPS);
  unsigned xh[8];
  {
    const float4* gr = (const float4*)p.norm2_g + lane * 4;
#pragma unroll
    for (int q = 0; q < 4; ++q) { const float4 g = gr[q];
      xh[2 * q] = pk_h2(hv[4 * q] * rstd * g.x, hv[4 * q + 1] * rstd * g.y); xh[2 * q + 1] = pk_h2(hv[4 * q + 2] * rstd * g.z, hv[4 * q + 3] * rstd * g.w); }
  }
  const int myi0 = pidx_t[lane], myi1 = pidx_t[64 + lane];
  const float myg0 = pgate_t[lane], myg1 = pgate_t[64 + lane];
  const uint4* UT = (const uint4*)(p.ws + OFF_UT) + lane;
  const uint4* VT = (const uint4*)(p.ws + OFF_VT) + lane;
  float acc32[16];
#pragma unroll
  for (int i = 0; i < 16; ++i) acc32[i] = 0.f;
  h2_t acc16[8];
#pragma unroll
  for (int i = 0; i < 8; ++i) acc16[i] = h2_t{(_Float16)0.f, (_Float16)0.f};
  for (int c = 0; c < 16; ++c) {
    const int isrc = (c < 8) ? myi0 : myi1; const float gsrc = (c < 8) ? myg0 : myg1;
    const int kb = (c & 7) * 8;
    uint4 U[8], V[8];
#pragma unroll
    for (int q = 0; q < 8; ++q) {
      const int e = __builtin_amdgcn_readlane(isrc, kb + q);
      U[q] = UT[(size_t)e * 64]; V[q] = VT[(size_t)e * 64];
    }
    float d[8];
#pragma unroll
    for (int q = 0; q < 8; ++q) {
      float s = 0.f;
      const unsigned uw[4] = {U[q].x, U[q].y, U[q].z, U[q].w};
#pragma unroll
      for (int j = 0; j < 4; ++j) {
        s = __builtin_amdgcn_fdot2(__builtin_amdgcn_cvt_scalef32_pk_f16_fp8((int)uw[j], 0.0078125f, false), __builtin_bit_cast(h2_t, xh[2 * j]), s, false);
        s = __builtin_amdgcn_fdot2(__builtin_amdgcn_cvt_scalef32_pk_f16_fp8((int)uw[j], 0.0078125f, true), __builtin_bit_cast(h2_t, xh[2 * j + 1]), s, false);
      }
      d[q] = s;
    }
    float s4[4], s2[2];
#pragma unroll
    for (int q = 0; q < 4; ++q) { auto rr = __builtin_amdgcn_permlane32_swap(__float_as_uint(d[q]), __float_as_uint(d[q + 4]), false, false); s4[q] = __uint_as_float(rr[0]) + __uint_as_float(rr[1]); }
#pragma unroll
    for (int q = 0; q < 2; ++q) { auto rr = __builtin_amdgcn_permlane16_swap(__float_as_uint(s4[q]), __float_as_uint(s4[q + 2]), false, false); s2[q] = __uint_as_float(rr[0]) + __uint_as_float(rr[1]); }
    const bool b3 = (lane & 8) != 0;
    const float keep = b3 ? s2[1] : s2[0], give = b3 ? s2[0] : s2[1];
    float act = keep + dpp_f<0x128>(give);
    act += dpp_f<0xB1>(act); act += dpp_f<0x4E>(act); act += dpp_f<0x141>(act);
    const float gl = __shfl(gsrc, kb + (lane >> 3));
    const float wl = gl * gelu_tanh_f(act);
    const unsigned whl = pk_h2(wl, wl);
#pragma unroll
    for (int q = 0; q < 8; ++q) {
      const h2_t wq = __builtin_bit_cast(h2_t, (unsigned)__builtin_amdgcn_readlane((int)whl, q * 8));
      const unsigned vw[4] = {V[q].x, V[q].y, V[q].z, V[q].w};
#pragma unroll
      for (int j = 0; j < 4; ++j) {
        acc16[2 * j] = __builtin_amdgcn_cvt_scalef32_pk_f16_fp8((int)vw[j], 0.015625f, false) * wq + acc16[2 * j];
        acc16[2 * j + 1] = __builtin_amdgcn_cvt_scalef32_pk_f16_fp8((int)vw[j], 0.015625f, true) * wq + acc16[2 * j + 1];
      }
    }
    if (c & 1) {
#pragma unroll
      for (int i = 0; i < 8; ++i) { acc32[2 * i] += (float)acc16[i][0]; acc32[2 * i + 1] += (float)acc16[i][1]; acc16[i] = h2_t{(_Float16)0.f, (_Float16)0.f}; }
    }
  }
  float y[16]; ss = 0;
#pragma unroll
  for (int i = 0; i < 16; ++i) { y[i] = hv[i] + acc32[i]; ss += y[i] * y[i]; }
  ss = wave_sum(ss);
  const float rf = rsqrtf(ss * (1.f / 1024.f) + EPS);
  {
    const float4* gr = (const float4*)p.fin_g + lane * 4;
    float4* o4 = (float4*)orow + lane * 4;
#pragma unroll
    for (int q = 0; q < 4; ++q) { const float4 g = gr[q]; o4[q] = make_float4(y[4 * q] * rf * g.x, y[4 * q + 1] * rf * g.y, y[4 * q + 2] * rf * g.z, y[4 * q + 3] * rf * g.w); }
  }
}
__device__ __forceinline__ void peer_phase(const P& p, char* lds, int bid, int nb) {
  unsigned* top1 = (unsigned*)lds; int* pidx = (int*)(lds + PE_LDS_TOP1); float* pgate = (float*)(lds + PE_LDS_TOP1 + PE_TOK * 128 * 4);
  const int wid = threadIdx.x >> 6;
  for (int tile = bid; tile < T / PE_TOK; tile += nb) {
    const int tok0 = tile * PE_TOK;
    __syncthreads();
    for (int task = wid; task < 32; task += 8) peer_topk1(p, tok0 + (task & 1) * 32, (task & 1) * 32, task >> 1, top1);
    __syncthreads();
    peer_topk2(top1, pidx, pgate);
    __syncthreads();
    for (int i = 0; i < 8; ++i) { const int tl = wid * 8 + i; peer_gather_token(p, tok0 + tl, pidx + tl * 128, pgate + tl * 128); }
  }
}

constexpr int cmax(int a, int b) { return a > b ? a : b; }
constexpr int MEGA_LDS = cmax(cmax(G_LDS, ATT_LDS), cmax(PE_LDS, GLA_LDS));
__global__ __launch_bounds__(512) void mega(P p) {
  extern __shared__ __attribute__((aligned(16))) char lds[];
  cg::grid_group grid = cg::this_grid();
  const int bid = blockIdx.x, nb = gridDim.x;
  prep_phase(p, (long)bid * 512 + threadIdx.x, (long)nb * 512);
  grid.sync();
  gemm_phase<1>(p, lds, bid, nb);
  grid.sync();
  gemm_phase<2>(p, lds, bid, nb);
  grid.sync();
  gla_phase(p, lds, bid, nb);
  attn_phase(p, lds, bid, nb);
  grid.sync();
  gemm_phase<4>(p, lds, bid, nb);
  grid.sync();
  gemm_phase<5>(p, lds, bid, nb);
  grid.sync();
  peer_phase(p, lds, bid, nb);
}

extern "C" void kernel_launch(void* const* d_in, const int* in_sizes, int n_in, void* d_out, int out_size, void* d_ws, size_t ws_size,
                              hipStream_t stream) {
  if (ws_size < WS_NEED) { fprintf(stderr, "kernel_launch: ws too small: %zu < %zu\n", ws_size, WS_NEED); return; }
  P p{};
  p.xp = (const float*)d_in[0]; p.xs = (const float*)d_in[1]; p.norm1_g = (const float*)d_in[2]; p.w_in = (const float*)d_in[3];
  p.q_norm_g = (const float*)d_in[4]; p.w_uq = (const float*)d_in[5]; p.kv_norm_g = (const float*)d_in[6]; p.w_ukv = (const float*)d_in[7];
  p.gfw = (const float*)d_in[8]; p.gfb = (const float*)d_in[9]; p.gbw = (const float*)d_in[10]; p.gbb = (const float*)d_in[11];
  p.gla_g = (const float*)d_in[12]; p.w_o = (const float*)d_in[13]; p.norm2_g = (const float*)d_in[14]; p.wq = (const float*)d_in[15];
  p.subk = (const float*)d_in[16]; p.ut = (const float*)d_in[17]; p.vt = (const float*)d_in[18]; p.fin_g = (const float*)d_in[19];
  p.out = (float*)d_out; p.ws = (char*)d_ws;
  for (int i = 0; i < 16; ++i) p.freq[i] = (float)pow(10000.0, -(double)i * 2.0 / 32.0);
  static int grid_blocks = 0;
  if (!grid_blocks) {
    (void)hipFuncSetAttribute((const void*)mega, hipFuncAttributeMaxDynamicSharedMemorySize, MEGA_LDS);
    int dev = 0, cus = 0, per_cu = 0;
    (void)hipGetDevice(&dev);
    (void)hipDeviceGetAttribute(&cus, hipDeviceAttributeMultiprocessorCount, dev);
    (void)hipOccupancyMaxActiveBlocksPerMultiprocessor(&per_cu, mega, 512, MEGA_LDS);
    if (per_cu > 1) per_cu = 1;
    grid_blocks = cus * per_cu;
    if (grid_blocks <= 0) { fprintf(stderr, "kernel_launch: occupancy query gave %d x %d\n", cus, per_cu); grid_blocks = 0; return; }
  }
  void* args[] = {&p};
  hipError_t e = hipLaunchCooperativeKernel((void*)mega, dim3(grid_blocks), dim3(512), args, MEGA_LDS, stream);
  if (e != hipSuccess) fprintf(stderr, "cooperative launch failed: %s (grid %d)\n", hipGetErrorString(e), grid_blocks);
}
```

```cpp
#include <hip/hip_runtime.h>
#include <hip/hip_bf16.h>
#include <hip/hip_fp16.h>
#include <hip/hip_cooperative_groups.h>
namespace cg = cooperative_groups;
#include <cstdio>
#include <cmath>

#define PROBE 0
extern __shared__ __attribute__((aligned(16))) unsigned char lds_u[];
constexpr int WIDTAB_OFF = 140 * 1024, LDS_TOTAL = WIDTAB_OFF + 256;
__device__ __forceinline__ unsigned hw_slot() { return (unsigned)__builtin_amdgcn_s_getreg((5 << 11) | 4) & 63u; }
__device__ __forceinline__ int lane_id() { return (int)__builtin_amdgcn_mbcnt_hi(~0u, __builtin_amdgcn_mbcnt_lo(~0u, 0u)); }
__device__ __forceinline__ void tidx_init() { if (lane_id() == 0) ((volatile unsigned*)(lds_u + WIDTAB_OFF))[hw_slot()] = threadIdx.x >> 6; asm volatile("s_waitcnt lgkmcnt(0)" ::: "memory"); }
__device__ __forceinline__ int tidx() {
  const unsigned w = ((volatile unsigned*)(lds_u + WIDTAB_OFF))[hw_slot()];
  int t = (int)(w * 64u) + lane_id(); asm volatile("" : "+v"(t)); return t;
}

constexpr int T = 81920, TP = 65536, DM = 1024, SEQ = 2048, NSEQ = 40;
constexpr int INW = 1984;
constexpr float EPS = 1e-6f;
constexpr float ATT_QSCALE = 0.10206207261596577f * 1.4426950408889634f;
constexpr float PE_SU = 896.f;

typedef unsigned short bfu;
using bf16x8 = __attribute__((ext_vector_type(8))) short;
using f32x4 = __attribute__((ext_vector_type(4))) float;
using f32x16 = __attribute__((ext_vector_type(16))) float;
__device__ __forceinline__ bfu f2bf(float f) { unsigned u = __float_as_uint(f); u += 0x7fffu + ((u >> 16) & 1u); return (bfu)(u >> 16); }
__device__ __forceinline__ float bf2f(bfu h) { return __uint_as_float(((unsigned)h) << 16); }
__device__ __forceinline__ unsigned cvtpk(float lo, float hi) {
  unsigned r; asm volatile("v_cvt_pk_bf16_f32 %0, %1, %2" : "=v"(r) : "v"(lo), "v"(hi)); return r;
}

__device__ __forceinline__ uint4 pack8(const float (&v)[8]) { return make_uint4(cvtpk(v[0], v[1]), cvtpk(v[2], v[3]), cvtpk(v[4], v[5]), cvtpk(v[6], v[7])); }

constexpr size_t al256(size_t x) { return (x + 255) / 256 * 256; }
constexpr size_t OFF_XBAR  = 0;
constexpr size_t OFF_ROPE  = 16384;
constexpr size_t OFF_WIN   = al256(OFF_ROPE + (size_t)2048 * 16 * 8);
constexpr size_t OFF_WQKV  = al256(OFF_WIN + (size_t)2048 * 1024 * 2);
constexpr size_t OFF_WO    = al256(OFF_WQKV + (size_t)1792 * 384 * 2);
constexpr size_t OFF_WPQ   = al256(OFF_WO + (size_t)1024 * 1024 * 2);
constexpr size_t OFF_SK    = al256(OFF_WPQ + (size_t)2048 * 1024 * 2);
constexpr size_t OFF_UT    = al256(OFF_SK + (size_t)2048 * 128 * 2);
constexpr size_t OFF_VT    = al256(OFF_UT + (size_t)16384 * 1024);
constexpr size_t OFF_RSTD1 = al256(OFF_VT + (size_t)16384 * 1024);
constexpr size_t OFF_SSQ   = al256(OFF_RSTD1 + (size_t)T * 4);
constexpr size_t OFF_SSKV  = al256(OFF_SSQ + (size_t)T * 4 * 4);
constexpr size_t OFF_SS2   = al256(OFF_SSKV + (size_t)T * 4 * 4);
constexpr size_t OFF_XB    = al256(OFF_SS2 + (size_t)T * 16 * 4);
constexpr size_t OFF_KR    = al256(OFF_XB + (size_t)T * 1024 * 2);
constexpr size_t OFF_GQ    = al256(OFF_KR + (size_t)T * 32 * 2);
constexpr size_t OFF_GK    = al256(OFF_GQ + (size_t)T * 256 * 2);
constexpr size_t OFF_GV    = al256(OFF_GK + (size_t)T * 256 * 2);
constexpr size_t OFF_GLR   = al256(OFF_GV + (size_t)T * 512 * 2);
constexpr size_t OFF_GOUT  = al256(OFF_GLR + (size_t)T * 32 * 4);
constexpr size_t OFF_QF    = al256(OFF_GOUT + (size_t)T * 512 * 2);
constexpr size_t OFF_KV    = al256(OFF_QF + (size_t)T * 768 * 2);
constexpr size_t OFF_MIX   = al256(OFF_KV + (size_t)T * 1024 * 2);
constexpr size_t OFF_CQKV  = al256(OFF_MIX + (size_t)T * 1024 * 2);
constexpr size_t OFF_OTMP  = OFF_CQKV;
constexpr size_t WS_NEED   = al256(OFF_OTMP + (size_t)T * 512 * 2);
constexpr size_t OFF_HB    = OFF_XB;
constexpr size_t OFF_PQ    = OFF_KR;
static_assert(OFF_PQ + (size_t)T * 2048 * 2 <= OFF_MIX, "PQ alias overlaps live data");
static_assert(WS_NEED <= (size_t)1073741824, "workspace budget");

struct P {
  const float *xp, *xs, *norm1_g, *w_in, *q_norm_g, *w_uq, *kv_norm_g, *w_ukv, *gfw, *gfb, *gbw, *gbb, *gla_g, *w_o, *norm2_g, *wq,
      *subk, *ut, *vt, *fin_g;
  float* out;
  char* ws;
  float freq[16];
};
__device__ __forceinline__ const float* xrow(const P& p, int t) { return t < TP ? p.xp + (size_t)t * DM : p.xs + (size_t)(t - TP) * DM; }

__device__ __forceinline__ float wave_sum(float v) {
  for (int o = 32; o > 0; o >>= 1) v += __shfl_xor(v, o);
  return v;
}
__device__ __forceinline__ float wave_max(float v) {
  for (int o = 32; o > 0; o >>= 1) v = fmaxf(v, __shfl_xor(v, o));
  return v;
}
template <int CTRL> __device__ __forceinline__ float dpp_f(float v) {
  return __builtin_bit_cast(float, __builtin_amdgcn_update_dpp(0, __builtin_bit_cast(int, v), CTRL, 0xf, 0xf, true));
}
__device__ __forceinline__ float row16_sum(float v) {
  v += dpp_f<0xB1>(v);
  v += dpp_f<0x4E>(v);
  v += dpp_f<0x141>(v);
  v += dpp_f<0x140>(v);
  return v;
}

__device__ __forceinline__ int win_src_col(int n) {
  if (n < 384) return n;
  if (n < 416) return 384 + (n - 384);
  if (n < 448) return 1440 + (n - 416);
  if (n < 512) return -1;
  if (n < 768) return 416 + (n - 512);
  if (n < 1024) return 672 + (n - 768);
  if (n < 1536) return 928 + (n - 1024);
  return 1472 + (n - 1536);
}
__device__ __forceinline__ void cvt_t8(bfu* dst, const float* src, int K, int ldsrc, int n, int srccol, int k0, const float* gain, float scale) {
  unsigned w[4];
  float v[8];
#pragma unroll
  for (int i = 0; i < 8; ++i) {
    float g = gain ? gain[k0 + i] : 1.f;
    v[i] = (srccol >= 0) ? src[(size_t)(k0 + i) * ldsrc + srccol] * g * scale : 0.f;
  }
#pragma unroll
  for (int i = 0; i < 4; ++i) w[i] = cvtpk(v[2 * i], v[2 * i + 1]);
  *(uint4*)(dst + (size_t)n * K + k0) = make_uint4(w[0], w[1], w[2], w[3]);
}
__device__ __forceinline__ void prep_phase(const P& p, long gtid, long gthreads) {
  if (gtid < 4096) ((unsigned*)(p.ws + OFF_XBAR))[gtid] = 0u;
  for (long i = gtid; i < 2048 * 16; i += gthreads) {
    int pos = (int)(i >> 4), f = (int)(i & 15);
    float ang = (float)pos * p.freq[f];
    double rev = (double)ang * 0.15915494309189535;
    rev -= rint(rev);
    float r = (float)rev;
    float2 cs; cs.x = __builtin_amdgcn_cosf(r); cs.y = __builtin_amdgcn_sinf(r);
    ((float2*)(p.ws + OFF_ROPE))[i] = cs;
  }
  for (long i = gtid; i < 2048L * 128; i += gthreads) {
    int n = (int)(i & 2047), kc = (int)(i >> 11);
    cvt_t8((bfu*)(p.ws + OFF_WIN), p.w_in, 1024, INW, n, win_src_col(n), kc * 8, p.norm1_g, (n >= 512 && n < 768) ? 0.125f : 1.f);
  }
  for (long i = gtid; i < 1792L * 48; i += gthreads) {
    const int n = (int)(i % 1792), k0 = (int)(i / 1792) * 8;
    float v[8];
#pragma unroll
    for (int e = 0; e < 8; ++e) {
      const int k = k0 + e;
      v[e] = (n < 768) ? (k < 256 ? p.w_uq[(size_t)k * 768 + n] * p.q_norm_g[k] : 0.f)
                       : (k >= 256 ? p.w_ukv[(size_t)(k - 256) * 1024 + (n - 768)] * p.kv_norm_g[k - 256] : 0.f);
    }
    *(uint4*)((bfu*)(p.ws + OFF_WQKV) + (size_t)n * 384 + k0) = pack8(v);
  }
  for (long i = gtid; i < 1024L * 128; i += gthreads) {
    int n = (int)(i & 1023), kc = (int)(i >> 10);
    cvt_t8((bfu*)(p.ws + OFF_WO), p.w_o, 1024, 1024, n, n, kc * 8, nullptr, 1.f);
  }
  for (long i0 = gtid; i0 < 2L * 16384 * 1024 / 16; i0 += 2 * gthreads) {
    const long half = 16384L * 1024 / 16;
    float4 a[2][4];
#pragma unroll
    for (int u = 0; u < 2; ++u) { const long i = i0 + u * gthreads; if (i >= 2 * half) continue; const bool isv = i >= half; const long j = isv ? i - half : i;
      const float4* s4 = (const float4*)((isv ? p.vt : p.ut) + j * 16);
#pragma unroll
      for (int q = 0; q < 4; ++q) a[u][q] = s4[q]; }
#pragma unroll
    for (int u = 0; u < 2; ++u) { const long i = i0 + u * gthreads; if (i >= 2 * half) continue; const bool isv = i >= half; const long j = isv ? i - half : i;
      unsigned w[4];
#pragma unroll
      for (int q = 0; q < 4; ++q) {
        const float4 av = a[u][q];
        if (isv) {
          int pk = __builtin_amdgcn_cvt_pk_fp8_f32(av.x * 64.f, av.y * 64.f, 0, false);
          pk = __builtin_amdgcn_cvt_pk_fp8_f32(av.z * 64.f, av.w * 64.f, pk, true);
          w[q] = (unsigned)pk;
        } else {
          const float4 g = *(const float4*)(p.norm2_g + ((j * 16) & 1023) + q * 4);
          const int q0 = (int)fminf(fmaxf(rintf(av.x * g.x * PE_SU), -127.f), 127.f), q1 = (int)fminf(fmaxf(rintf(av.y * g.y * PE_SU), -127.f), 127.f);
          const int q2 = (int)fminf(fmaxf(rintf(av.z * g.z * PE_SU), -127.f), 127.f), q3 = (int)fminf(fmaxf(rintf(av.w * g.w * PE_SU), -127.f), 127.f);
          w[q] = (unsigned)(q0 & 255) | ((unsigned)(q1 & 255) << 8) | ((unsigned)(q2 & 255) << 16) | ((unsigned)(q3 & 255) << 24);
        }
      }
      *(uint4*)(p.ws + (isv ? OFF_VT : OFF_UT) + j * 16) = make_uint4(w[0], w[1], w[2], w[3]); }
  }
  const long gw = gtid >> 6, nw = gthreads >> 6; const int lane = (int)(gtid & 63);
  for (long t = gw; t < T; t += 2 * nw) {
    const long t2 = t + nw; const bool has2 = t2 < T;
    const float4* x = (const float4*)xrow(p, (int)t); const float4* y = (const float4*)xrow(p, (int)(has2 ? t2 : t));
    float4 v[4], w[4]; float ss = 0, s2 = 0;
#pragma unroll
    for (int i = 0; i < 4; ++i) { v[i] = x[lane + 64 * i]; w[i] = y[lane + 64 * i]; }
#pragma unroll
    for (int i = 0; i < 4; ++i) { ss += v[i].x * v[i].x + v[i].y * v[i].y + v[i].z * v[i].z + v[i].w * v[i].w; s2 += w[i].x * w[i].x + w[i].y * w[i].y + w[i].z * w[i].z + w[i].w * w[i].w; }
    ss = wave_sum(ss); s2 = wave_sum(s2);
    if (lane == 0) { ((float*)(p.ws + OFF_RSTD1))[t] = rsqrtf(ss * (1.f / 1024.f) + EPS); if (has2) ((float*)(p.ws + OFF_RSTD1))[t2] = rsqrtf(s2 * (1.f / 1024.f) + EPS); }
    bfu* xb = (bfu*)(p.ws + OFF_XB) + t * 1024; bfu* yb = (bfu*)(p.ws + OFF_XB) + t2 * 1024;
#pragma unroll
    for (int i = 0; i < 4; ++i) *(uint2*)(xb + (lane + 64 * i) * 4) = make_uint2(cvtpk(v[i].x, v[i].y), cvtpk(v[i].z, v[i].w));
    if (has2) {
#pragma unroll
      for (int i = 0; i < 4; ++i) *(uint2*)(yb + (lane + 64 * i) * 4) = make_uint2(cvtpk(w[i].x, w[i].y), cvtpk(w[i].z, w[i].w));
    }
  }
}

constexpr int FOLD_LDS = (128 * 129 + 64 * 128) * 4;
__device__ __forceinline__ void prep_foldkeys(const P& p, char* lds, int bid, int nb) {
  float* sk = (float*)lds; float* wqs = sk + 128 * 129;
  const int tid = tidx(), key = tid & 127, kkg = tid >> 7;
  for (int tile = bid; tile < 256; tile += nb) {
    const int g = tile >> 4, kk0 = (tile & 15) * 64;
    __syncthreads();
#pragma unroll
    for (int i = 0; i < 8; ++i) { const int e = tid + 512 * i, row = e >> 5, c4 = e & 31;
      const float4 v = *(const float4*)(p.subk + ((size_t)(g * 128 + row) * 128 + c4 * 4));
      float* d = sk + row * 129 + c4 * 4; d[0] = v.x; d[1] = v.y; d[2] = v.z; d[3] = v.w; }
#pragma unroll
    for (int i = 0; i < 4; ++i) { const int e = tid + 512 * i, row = e >> 5, c4 = e & 31;
      *(float4*)(wqs + row * 128 + c4 * 4) = *(const float4*)(p.wq + ((size_t)(kk0 + row) * 2048 + g * 128 + c4 * 4)); }
    __syncthreads();
    float acc[16];
#pragma unroll
    for (int i = 0; i < 16; ++i) acc[i] = 0.f;
    for (int d4 = 0; d4 < 32; ++d4) {
      const float a0 = sk[key * 129 + d4 * 4], a1 = sk[key * 129 + d4 * 4 + 1], a2 = sk[key * 129 + d4 * 4 + 2], a3 = sk[key * 129 + d4 * 4 + 3];
#pragma unroll
      for (int i = 0; i < 16; ++i) { const float4 w = *(const float4*)(wqs + (kkg * 16 + i) * 128 + d4 * 4); acc[i] += a0 * w.x + a1 * w.y + a2 * w.z + a3 * w.w; }
    }
    float v[8], w8[8];
#pragma unroll
    for (int i = 0; i < 8; ++i) { v[i] = acc[i] * p.norm2_g[kk0 + kkg * 16 + i]; w8[i] = acc[8 + i] * p.norm2_g[kk0 + kkg * 16 + 8 + i]; }
    uint4* dst = (uint4*)((bfu*)(p.ws + OFF_WPQ) + (size_t)(g * 128 + key) * 1024 + kk0 + kkg * 16);
    dst[0] = pack8(v); dst[1] = pack8(w8);
  }
}

namespace pg8 {
#define PG8_LAS __attribute__((address_space(3)))
typedef unsigned short bf16_t;
typedef short bf16x8 __attribute__((ext_vector_type(8)));
typedef float f32x4 __attribute__((ext_vector_type(4)));
typedef unsigned u32x4 __attribute__((ext_vector_type(4)));
constexpr int BM = 256, BK = 64, HALF = 128, HTB = HALF * BK * 2  , STAGE_BYTES = 8 * HTB, NXCD = 8, WGM = 8;

__host__ __device__ __forceinline__ int lds_byte(int r, int c) { const int st = (r >> 4) * 2 + (c >> 5), rr = r & 15, cc = c & 31, ob = rr * 64 + cc * 2; return st * 1024 + (ob ^ (((ob >> 9) & 1) << 5)); }
__host__ __device__ __forceinline__ void stage_rc(int b, int& R, int& C) { const int st = b / 1024, sb = b % 1024, swz = sb ^ (((sb >> 9) & 1) << 5); R = (st >> 1) * 16 + swz / 64; C = (st & 1) * 32 + (swz % 64) / 2; }
__host__ __device__ __forceinline__ int perm32(int rho) { const int n = rho >> 4, i = rho & 15; return 8 * (i >> 2) + 4 * n + (i & 3); }

struct Unit { int pm, pn; };
struct Gemm { const bf16_t* A; const bf16_t* Bt; int M, N, K; };

struct StaticOrder {
    int nM, nN, nwg, G, c;
    __host__ __device__ void init(int M, int N, int G_, int c_) { nM = M / BM; nN = N / BM; nwg = nM * nN; G = G_; c = c_; }
    __host__ __device__ bool next(int i, Unit& u) const {
        const long L = (long)i * G + c; if (L >= nwg) return false;
        int wgid = (int)L; { const int q = nwg / NXCD, r = nwg % NXCD, xcd = wgid % NXCD, off = wgid / NXCD; wgid = (xcd < r ? xcd * (q + 1) : r * (q + 1) + (xcd - r) * q) + off; }
        const int nig = WGM * nN, gid = wgid / nig, fm = gid * WGM, gsz = (nM - fm) < WGM ? (nM - fm) : WGM;
        u.pm = fm + ((wgid % nig) % gsz); u.pn = (wgid % nig) / gsz; return true;
    }
    __device__ __forceinline__ void a_ready(const Unit&) const {}
    __device__ __forceinline__ void done(const Unit&) const {}
};
template <class Epi, class Sched, bool STAMP = false>
__device__ __forceinline__ void gemm_phase(PG8_LAS unsigned char* lds, const Gemm g, const Sched& S, const Epi& E, unsigned long long* stamps) {
    const int tid = tidx(), wid = __builtin_amdgcn_readfirstlane(tid >> 6), lane = tid & 63, wr = wid >> 2, wc = wid & 3, fr = lane & 15, fq = lane >> 4;
    const int K = g.K, nt = K / BK;
    int ts_lo = 0, ts_hi = 0, nts = 0; const unsigned long long rt_entry = STAMP ? (unsigned long long)wall_clock64() : 0ull;
#define PG8_STAMP() do { if (STAMP && wid == 0 && nts < 64) { const unsigned long long _c = (unsigned long long)clock64(); \
        ts_lo = (lane == nts) ? (int)(unsigned)_c : ts_lo; ts_hi = (lane == nts) ? (int)(unsigned)(_c >> 32) : ts_hi; ++nts; } } while (0)
    PG8_STAMP();
    unsigned voffA[2], voffB[2];
#pragma unroll
    for (int i = 0; i < 2; ++i) { int R, C; stage_rc(tid * 16 + i * 8192, R, C); const int Rb = Epi::PERM ? ((R & ~31) + perm32(R & 31)) : R;
        voffA[i] = (unsigned)(R * K + C) * 2u; voffB[i] = (unsigned)(Rb * K + C) * 2u; }
    const size_t kstep = (size_t)(BK * 2);
    const size_t hstep = (size_t)HALF * K * 2;
    const size_t tstep = 2 * hstep;
    const unsigned ldsw = (unsigned)wid * 1024u;
    const int aoff = lds_byte(wr * 64 + fr, fq * 8), boff = lds_byte(wc * 32 + fr, fq * 8);
#define PG8_SA(b, h) (((b) * 2 + (h)) * HTB)
#define PG8_SB(b, h) ((4 + (b) * 2 + (h)) * HTB)
#define PG8_STAGE(bufoff, gbase, voff) do { _Pragma("unroll") for (int _i = 0; _i < 2; ++_i) \
        __builtin_amdgcn_global_load_lds((const unsigned*)((const char*)(gbase) + (voff)[_i]), (PG8_LAS unsigned*)(lds + (bufoff) + ldsw + _i * 8192), 16, 0, 0); } while (0)
#define PG8_LDA(dst, b, h) do { _Pragma("unroll") for (int m = 0; m < 4; ++m) _Pragma("unroll") for (int k = 0; k < 2; ++k) dst[m][k] = *(const PG8_LAS bf16x8*)(lds + PG8_SA(b, h) + aoff + m * 2048 + k * 1024); } while (0)
#define PG8_LDB(dst, b, h) do { _Pragma("unroll") for (int n = 0; n < 2; ++n) _Pragma("unroll") for (int k = 0; k < 2; ++k) dst[n][k] = *(const PG8_LAS bf16x8*)(lds + PG8_SB(b, h) + boff + n * 2048 + k * 1024); } while (0)
#define PG8_MMA(ai, bj, At, Bt) do { __builtin_amdgcn_s_setprio(1); _Pragma("unroll") for (int m = 0; m < 4; ++m) _Pragma("unroll") for (int n = 0; n < 2; ++n) _Pragma("unroll") for (int k = 0; k < 2; ++k) \
        acc[ai][bj][m][n] = __builtin_amdgcn_mfma_f32_16x16x32_bf16(Bt[n][k], At[m][k], acc[ai][bj][m][n], 0, 0, 0); __builtin_amdgcn_s_setprio(0); } while (0)
#define PG8_WAIT_V(n) asm volatile("s_waitcnt vmcnt(" #n ")" ::: "memory")
#define PG8_WAIT_L(n) asm volatile("s_waitcnt lgkmcnt(" #n ")" ::: "memory")
#define PG8_BAR __builtin_amdgcn_s_barrier()
#define PG8_SCHED __builtin_amdgcn_sched_barrier(0)
    Unit cur, nxt; int ui = 0;
    if (!S.next(0, cur)) return;
    f32x4 acc[2][2][4][2];
#pragma unroll
    for (int a = 0; a < 2; ++a)
#pragma unroll
        for (int b = 0; b < 2; ++b)
#pragma unroll
            for (int m = 0; m < 4; ++m)
#pragma unroll
                for (int n = 0; n < 2; ++n) acc[a][b][m][n] = (f32x4){0.f, 0.f, 0.f, 0.f};
    bf16x8 At[4][2], B0[2][2], B1[2][2];
    const char* cA = (const char*)g.A + (size_t)cur.pm * tstep; const char* cB = (const char*)g.Bt + (size_t)cur.pn * tstep;
    S.a_ready(cur);
    PG8_STAGE(PG8_SB(0, 0), cB, voffB); PG8_STAGE(PG8_SA(0, 0), cA, voffA); PG8_STAGE(PG8_SB(0, 1), cB + hstep, voffB); PG8_STAGE(PG8_SA(0, 1), cA + hstep, voffA);
    if (wr == 1) PG8_BAR;
    PG8_WAIT_V(4); PG8_BAR;
    PG8_STAGE(PG8_SB(1, 0), cB + kstep, voffB); PG8_STAGE(PG8_SA(1, 0), cA + kstep, voffA); PG8_STAGE(PG8_SB(1, 1), cB + hstep + kstep, voffB);
    PG8_WAIT_V(6); PG8_BAR;
    PG8_STAMP();
    for (;;) {
        const bool has_next = S.next(ui + 1, nxt);
        const char* nA = has_next ? (const char*)g.A + (size_t)nxt.pm * tstep : cA; const char* nB = has_next ? (const char*)g.Bt + (size_t)nxt.pn * tstep : cB;
        for (int t = 0; t < nt; t += 2) {
            const bool last = (t == nt - 2);
            const char* a1 = cA + (size_t)(t + 1) * kstep;
            const char* a2 = last ? nA : cA + (size_t)(t + 2) * kstep; const char* b2 = last ? nB : cB + (size_t)(t + 2) * kstep;
            const char* a3 = a2 + kstep; const char* b3 = b2 + kstep;
            if (last && has_next) S.a_ready(nxt);
            PG8_LDB(B0, 0, 0); PG8_SCHED; PG8_LDA(At, 0, 0); PG8_STAGE(PG8_SA(1, 1), a1 + hstep, voffA);
            PG8_WAIT_L(8); PG8_BAR; PG8_WAIT_L(0); PG8_MMA(0, 0, At, B0); PG8_BAR; PG8_SCHED;
            PG8_LDB(B1, 0, 1); PG8_STAGE(PG8_SB(0, 0), b2, voffB);
            PG8_BAR; PG8_WAIT_L(0); PG8_MMA(0, 1, At, B1); PG8_BAR;
            PG8_LDA(At, 0, 1); PG8_STAGE(PG8_SA(0, 0), a2, voffA);
            PG8_BAR; PG8_WAIT_L(0); PG8_MMA(1, 0, At, B0); PG8_BAR; PG8_SCHED;
            PG8_STAGE(PG8_SB(0, 1), b2 + hstep, voffB);
            PG8_WAIT_V(6); PG8_BAR; PG8_MMA(1, 1, At, B1); PG8_BAR;
            PG8_LDB(B0, 1, 0); PG8_SCHED; PG8_LDA(At, 1, 0); PG8_STAGE(PG8_SA(0, 1), a2 + hstep, voffA);
            PG8_WAIT_L(8); PG8_BAR; PG8_WAIT_L(0); PG8_MMA(0, 0, At, B0); PG8_BAR; PG8_SCHED;
            PG8_LDB(B1, 1, 1); PG8_STAGE(PG8_SB(1, 0), b3, voffB);
            PG8_BAR; PG8_WAIT_L(0); PG8_MMA(0, 1, At, B1); PG8_BAR;
            PG8_LDA(At, 1, 1); PG8_STAGE(PG8_SA(1, 0), a3, voffA);
            PG8_BAR; PG8_WAIT_L(0); PG8_MMA(1, 0, At, B0); PG8_BAR; PG8_SCHED;
            PG8_STAGE(PG8_SB(1, 1), b3 + hstep, voffB);
            PG8_WAIT_V(6); PG8_BAR; PG8_MMA(1, 1, At, B1); PG8_BAR;
        }
        PG8_STAMP();
        if constexpr (!Epi::AFTER_DRAIN) { E(acc, cur, wr, wc, fr, fq); S.done(cur); }
        PG8_STAMP();
        if (!has_next) break;
#pragma unroll
        for (int a = 0; a < 2; ++a)
#pragma unroll
            for (int b = 0; b < 2; ++b)
#pragma unroll
                for (int m = 0; m < 4; ++m)
#pragma unroll
                    for (int n = 0; n < 2; ++n) acc[a][b][m][n] = (f32x4){0.f, 0.f, 0.f, 0.f};
        cur = nxt; cA = nA; cB = nB; ++ui;
    }
    PG8_WAIT_V(0);
    if (wr == 0) PG8_BAR;
    PG8_BAR;
    if constexpr (Epi::AFTER_DRAIN) { E.fused(acc, cur, wr, wc, fr, fq, lds, wid, lane); S.done(cur); }
    PG8_STAMP();
    if (STAMP && wid == 0) { stamps[lane] = lane < nts ? (((unsigned long long)(unsigned)ts_hi << 32) | (unsigned)ts_lo) : 0ull;
        if (lane == 62) stamps[62] = rt_entry; if (lane == 63) stamps[63] = (unsigned long long)wall_clock64(); }
#undef PG8_STAMP
#undef PG8_SA
#undef PG8_SB
#undef PG8_STAGE
#undef PG8_LDA
#undef PG8_LDB
#undef PG8_MMA
#undef PG8_WAIT_V
#undef PG8_WAIT_L
#undef PG8_BAR
#undef PG8_SCHED
}
}
__device__ __forceinline__ float x4sum(float v) {
  auto r1 = __builtin_amdgcn_permlane16_swap(__float_as_uint(v), __float_as_uint(v), false, false);
  const float s = __uint_as_float(r1[0]) + __uint_as_float(r1[1]);
  auto r2 = __builtin_amdgcn_permlane32_swap(__float_as_uint(s), __float_as_uint(s), false, false);
  return __uint_as_float(r2[0]) + __uint_as_float(r2[1]);
}
__device__ __forceinline__ float other32(float v, bool upper) {
  auto rr = __builtin_amdgcn_permlane32_swap(__float_as_uint(v), __float_as_uint(v), false, false);
  return __uint_as_float(upper ? rr[0] : rr[1]);
}
__device__ __forceinline__ void rope8(float (&v)[8], const float2* rope, int pos, int fq) {
  const bool upper = fq >= 2;
  const float4* cs4 = (const float4*)(rope + pos * 16 + (fq & 1) * 8);
#pragma unroll
  for (int q = 0; q < 4; ++q) {
    const float4 c2 = cs4[q];
    const float o0 = other32(v[2 * q], upper), o1 = other32(v[2 * q + 1], upper);
    v[2 * q] = upper ? (v[2 * q] * c2.x + o0 * c2.y) : (v[2 * q] * c2.x - o0 * c2.y);
    v[2 * q + 1] = upper ? (v[2 * q + 1] * c2.z + o1 * c2.w) : (v[2 * q + 1] * c2.z - o1 * c2.w);
  }
}
typedef unsigned ntu4 __attribute__((ext_vector_type(4)));
__device__ __forceinline__ void st_nt(void* d, const uint4 v) { const ntu4 w = {v.x, v.y, v.z, v.w}; __builtin_nontemporal_store(w, (ntu4*)d); }
struct EpiG1 {
  static constexpr bool PERM = true, AFTER_DRAIN = false;
  char* ws;
  __device__ __forceinline__ void operator()(const pg8::f32x4 (&acc)[2][2][4][2], const pg8::Unit& u, int wr, int wc, int fr, int fq) const {
    const float* rstd1 = (const float*)(ws + OFF_RSTD1);
    const int pn = u.pn, colh = wc * 32 + fq * 8;
    float rs8[8];
#pragma unroll
    for (int i = 0; i < 8; ++i) rs8[i] = rstd1[u.pm * 256 + (i >> 2) * 128 + wr * 64 + (i & 3) * 16 + fr];
#pragma unroll
    for (int ai = 0; ai < 2; ++ai)
#pragma unroll
      for (int m = 0; m < 4; ++m) {
        __builtin_amdgcn_sched_barrier(0);
        const int r = u.pm * 256 + ai * 128 + wr * 64 + m * 16 + fr;
        const float rs = rs8[ai * 4 + m];
        float ss = 0.f;
#pragma unroll
        for (int bj = 0; bj < 2; ++bj) {
          float v[8];
#pragma unroll
          for (int e = 0; e < 4; ++e) { v[e] = acc[ai][bj][m][0][e] * rs; v[4 + e] = acc[ai][bj][m][1][e] * rs; }
          if (pn == 1 && bj == 1) {
            if (wc == 0) { rope8(v, (const float2*)(ws + OFF_ROPE), r & (SEQ - 1), fq); *(uint4*)((bfu*)(ws + OFF_KR) + (size_t)r * 32 + fq * 8) = pack8(v); }
            else if (wc == 1) { float4* g = (float4*)((float*)(ws + OFF_GLR) + (size_t)r * 32 + fq * 8); g[0] = make_float4(v[0], v[1], v[2], v[3]); g[1] = make_float4(v[4], v[5], v[6], v[7]); }
          } else {
            unsigned base, ld, cb;
            if (pn == 0) { base = (unsigned)OFF_CQKV; ld = 384; cb = bj * 128; }
            else if (pn == 1) { base = (unsigned)OFF_CQKV; ld = 384; cb = 256; }
            else if (pn == 2) { base = (unsigned)OFF_GQ; ld = 256; cb = bj * 128; }
            else if (pn == 3) { base = (unsigned)OFF_GK; ld = 256; cb = bj * 128; }
            else if (pn < 6) { base = (unsigned)OFF_GV; ld = 512; cb = (pn - 4) * 256 + bj * 128; }
            else { base = (unsigned)OFF_GOUT; ld = 512; cb = (pn - 6) * 256 + bj * 128; }
            st_nt(ws + (base + ((unsigned)r * ld + cb + (unsigned)colh) * 2u), pack8(v));
#pragma unroll
            for (int e = 0; e < 8; ++e) ss += v[e] * v[e];
          }
        }
        if (pn <= 1) {
          ss = x4sum(ss);
          if (fq == 0) ((float*)(ws + (pn == 0 ? OFF_SSQ : OFF_SSKV)))[(size_t)r * 4 + wc] = ss;
        }
      }
  }
};
struct EpiG2 {
  static constexpr bool PERM = true, AFTER_DRAIN = false;
  char* ws;
  __device__ __forceinline__ void operator()(const pg8::f32x4 (&acc)[2][2][4][2], const pg8::Unit& u, int wr, int wc, int fr, int fq) const {
    const int pn = u.pn;
    float rs8[8];
    {
      float4 s8[8];
#pragma unroll
      for (int i = 0; i < 8; ++i) s8[i] = ((const float4*)(ws + (pn < 3 ? OFF_SSQ : OFF_SSKV)))[u.pm * 256 + (i >> 2) * 128 + wr * 64 + (i & 3) * 16 + fr];
#pragma unroll
      for (int i = 0; i < 8; ++i) rs8[i] = rsqrtf((s8[i].x + s8[i].y + s8[i].z + s8[i].w) * (pn < 3 ? (1.f / 256.f) : (1.f / 128.f)) + EPS);
    }
#pragma unroll
    for (int ai = 0; ai < 2; ++ai)
#pragma unroll
      for (int m = 0; m < 4; ++m) {
        __builtin_amdgcn_sched_barrier(0);
        const int r = u.pm * 256 + ai * 128 + wr * 64 + m * 16 + fr;
        const float rs = rs8[ai * 4 + m];
#pragma unroll
        for (int bj = 0; bj < 2; ++bj) {
          float v[8];
#pragma unroll
          for (int e = 0; e < 4; ++e) { v[e] = acc[ai][bj][m][0][e] * rs; v[4 + e] = acc[ai][bj][m][1][e] * rs; }
          if (pn < 3) {
            const int g0 = pn * 256 + bj * 128 + wc * 32;
#pragma unroll
            for (int e = 0; e < 8; ++e) v[e] *= ATT_QSCALE;
            if (g0 % 96 == 64) rope8(v, (const float2*)(ws + OFF_ROPE), r & (SEQ - 1), fq);
            st_nt((bfu*)(ws + OFF_QF) + (size_t)r * 768 + g0 + fq * 8, pack8(v));
          } else {
            st_nt((bfu*)(ws + OFF_KV) + (size_t)r * 1024 + (pn - 3) * 256 + bj * 128 + wc * 32 + fq * 8, pack8(v));
          }
        }
      }
  }
};
struct EpiG4 {
  static constexpr bool PERM = true, AFTER_DRAIN = false;
  const P* pp;
  __device__ __forceinline__ void operator()(const pg8::f32x4 (&acc)[2][2][4][2], const pg8::Unit& u, int wr, int wc, int fr, int fq) const {
    const P& p = *pp;
    pg8::u32x4 xin[8];
#define G4_LOADX(IT) _Pragma("unroll") for (int bj = 0; bj < 2; ++bj) \
      xin[((IT) & 3) * 2 + bj] = *(const pg8::u32x4*)(p.ws + ((unsigned)OFF_HB + ((unsigned)(u.pm * 256 + ((IT) >> 2) * 128 + wr * 64 + ((IT) & 3) * 16 + fr) * 1024u + (unsigned)(u.pn * 256 + bj * 128 + wc * 32 + fq * 8)) * 2u));
    G4_LOADX(0) G4_LOADX(1) G4_LOADX(2) G4_LOADX(3)
#pragma unroll
    for (int ai = 0; ai < 2; ++ai) {
#pragma unroll
      for (int m = 0; m < 4; ++m) {
        __builtin_amdgcn_sched_barrier(0);
        const int r = u.pm * 256 + ai * 128 + wr * 64 + m * 16 + fr;
        float ss = 0.f;
#pragma unroll
        for (int bj = 0; bj < 2; ++bj) {
          const int c = u.pn * 256 + bj * 128 + wc * 32 + fq * 8;
          uint4* hx = (uint4*)(p.ws + ((unsigned)OFF_HB + ((unsigned)r * 1024u + (unsigned)c) * 2u));
          const pg8::u32x4 xw = xin[((ai * 4 + m) & 3) * 2 + bj]; const unsigned xs[4] = {xw[0], xw[1], xw[2], xw[3]};
          float v[8];
#pragma unroll
          for (int e = 0; e < 4; ++e) { v[2 * e] = __uint_as_float(xs[e] << 16) + acc[ai][bj][m][e >> 1][(2 * e) & 3]; v[2 * e + 1] = __uint_as_float(xs[e] & 0xffff0000u) + acc[ai][bj][m][e >> 1][(2 * e + 1) & 3]; }
          *hx = pack8(v);
#pragma unroll
          for (int e = 0; e < 8; ++e) ss += v[e] * v[e];
        }
        ss = x4sum(ss);
        if (fq == 0) ((float*)(p.ws + OFF_SS2))[(size_t)r * 16 + u.pn * 4 + wc] = ss;
        if (ai == 0) { G4_LOADX(4 + m) }
      }
    }
#undef G4_LOADX
  }
};
__device__ __forceinline__ unsigned pkf16(float a, float b) { typedef _Float16 hh2 __attribute__((ext_vector_type(2))); const hh2 h = {(_Float16)a, (_Float16)b}; return __builtin_bit_cast(unsigned, h); }
struct EpiG5 {
  static constexpr bool PERM = true, AFTER_DRAIN = false;
  char* ws;
  __device__ __forceinline__ void operator()(const pg8::f32x4 (&acc)[2][2][4][2], const pg8::Unit& u, int wr, int wc, int fr, int fq) const {
#pragma unroll
    for (int ai = 0; ai < 2; ++ai)
#pragma unroll
      for (int m = 0; m < 4; ++m) {
        const int r = u.pm * 256 + ai * 128 + wr * 64 + m * 16 + fr;
#pragma unroll
        for (int bj = 0; bj < 2; ++bj) {
          float v[8];
#pragma unroll
          for (int e = 0; e < 4; ++e) { v[e] = acc[ai][bj][m][0][e]; v[4 + e] = acc[ai][bj][m][1][e]; }
          st_nt(ws + ((unsigned)OFF_PQ + ((unsigned)r * 2048u + (unsigned)(u.pn * 256 + bj * 128 + wc * 32 + fq * 8)) * 2u), make_uint4(pkf16(v[0], v[1]), pkf16(v[2], v[3]), pkf16(v[4], v[5]), pkf16(v[6], v[7])));
        }
      }
  }
};
template <class Epi>
__device__ __forceinline__ void run_gemm(PG8_LAS unsigned char* lds, const bfu* A, const bfu* Bt, int M, int N, int K, const Epi& E, int bid, int nb) {
  asm volatile("" : "+s"(K));
  pg8::Gemm g; g.A = A; g.Bt = Bt; g.M = M; g.N = N; g.K = K;
  pg8::StaticOrder S; S.init(M, N, nb, bid);
  pg8::gemm_phase<Epi, pg8::StaticOrder, false>(lds, g, S, E, nullptr);
}

using s16x4  = __attribute__((ext_vector_type(4))) short;
using u32x4  = __attribute__((ext_vector_type(4))) unsigned;
constexpr float ATT_SCALE = 0.10206207261596577f;
constexpr float ATT_THR = 8.f;
constexpr int ATT_SHM_V = 64 * 64 * 2, ATT_SHM_K = 64 * 256, ATT_LDS = 2 * ATT_SHM_V + 2 * ATT_SHM_K + 8 * 64 * 4;
#define KSWZ(row, colB) ((row) * 256 + ((colB) ^ (((row) & 7) << 4)))
#define SBAR() __builtin_amdgcn_sched_barrier(0)
__device__ __forceinline__ int crow(int r, int hi) { return (r & 3) + 8 * (r >> 2) + 4 * hi; }
__device__ __forceinline__ void att_partialSM(f32x16& p0, f32x16& p1, float& m_run, float& alpha, bool first) {
  constexpr float THR2 = ATT_THR * 1.4426950408889634f;
  float pmax = fmaxf(fmaxf(p0[0], p0[1]), p0[2]);
#pragma unroll
  for (int r = 3; r < 15; r += 2) pmax = fmaxf(fmaxf(pmax, p0[r]), p0[r + 1]);
  pmax = fmaxf(pmax, p0[15]);
#pragma unroll
  for (int r = 0; r < 16; r += 2) pmax = fmaxf(fmaxf(pmax, p1[r]), p1[r + 1]);
  { auto rr = __builtin_amdgcn_permlane32_swap(__float_as_uint(pmax), __float_as_uint(pmax), false, false);
    pmax = fmaxf(__uint_as_float(rr[0]), __uint_as_float(rr[1])); }
  if (__builtin_expect(!first && __all(pmax <= THR2), 1)) { alpha = 1.f; }
  else {
    const float dlt = first ? pmax : fmaxf(pmax, 0.f);
    alpha = first ? 1.f : __builtin_amdgcn_exp2f(-dlt); m_run += dlt;
#pragma unroll
    for (int r = 0; r < 16; ++r) { p0[r] -= dlt; p1[r] -= dlt; }
  }
#pragma unroll
  for (int r = 0; r < 16; ++r) p0[r] = __builtin_amdgcn_exp2f(p0[r]);
}
__device__ __forceinline__ void att_finishSM(f32x16& p0, f32x16& p1, float alpha, float& l_reg, bf16x8& pa0, bf16x8& pa1, bf16x8& pa2, bf16x8& pa3) {
#pragma unroll
  for (int r = 0; r < 16; ++r) p1[r] = __builtin_amdgcn_exp2f(p1[r]);
  float ps = 0;
#pragma unroll
  for (int r = 0; r < 16; ++r) ps += p0[r];
#pragma unroll
  for (int r = 0; r < 16; ++r) ps += p1[r];
  { auto rr = __builtin_amdgcn_permlane32_swap(__float_as_uint(ps), __float_as_uint(ps), false, false);
    ps = __uint_as_float(rr[0]) + __uint_as_float(rr[1]); }
  l_reg = l_reg * alpha + ps;
#define PK4(PP, BASE, OUT) do { unsigned a0 = cvtpk(PP[BASE + 0], PP[BASE + 1]), a1 = cvtpk(PP[BASE + 2], PP[BASE + 3]);   \
    unsigned b0 = cvtpk(PP[BASE + 4], PP[BASE + 5]), b1 = cvtpk(PP[BASE + 6], PP[BASE + 7]);                              \
    auto r0 = __builtin_amdgcn_permlane32_swap(a0, b0, false, false); auto r1 = __builtin_amdgcn_permlane32_swap(a1, b1, false, false); \
    u32x4 w = {r0[0], r1[0], r0[1], r1[1]}; OUT = *reinterpret_cast<bf16x8*>(&w); } while (0)
  PK4(p0, 0, pa0); PK4(p0, 8, pa1); PK4(p1, 0, pa2); PK4(p1, 8, pa3);
#undef PK4
}
__device__ __forceinline__ void att_qkt(f32x16& p0, f32x16& p1, const char* Ks, const bf16x8* qr, int r32, int hi, float init) {
#pragma unroll
  for (int r = 0; r < 16; ++r) { p0[r] = init; p1[r] = init; }
#pragma unroll
  for (int d0 = 0; d0 < 6; ++d0) { int cb = (d0 * 16 + hi * 8) * 2;
    bf16x8 b0 = *reinterpret_cast<const bf16x8*>(Ks + KSWZ(r32, cb));
    bf16x8 b1 = *reinterpret_cast<const bf16x8*>(Ks + KSWZ(32 + r32, cb));
    p0 = __builtin_amdgcn_mfma_f32_32x32x16_bf16(b0, qr[d0], p0, 0, 0, 0);
    p1 = __builtin_amdgcn_mfma_f32_32x32x16_bf16(b1, qr[d0], p1, 0, 0, 0); }
}
__device__ __forceinline__ int att_v_st(int k, int c) { const int kk = (k & ~0xC) | ((k & 4) << 1) | ((k & 8) >> 1); return ((kk >> 3) * 2 + (c >> 5)) * 512 + ((kk & 7) * 32 + (c & 31)) * 2; }
__device__ __forceinline__ int att_v_rd_base(int lane) { return ((lane & 3) << 3) | (((lane >> 2) & 3) << 6) | (((lane >> 4) & 1) << 5) | (((lane >> 5) & 1) << 8); }
constexpr int att_v_rd_off(int d0, int ks, int half) { return d0 * 512 + ks * 2048 + half * 1024; }
template <int OFF> __device__ __forceinline__ s16x4 att_tr_read(int vb) {
  s16x4 r; asm volatile("ds_read_b64_tr_b16 %0, %1 offset:%2" : "=&v"(r) : "v"(vb), "i"(OFF) : "memory"); return r;
}
template <int D0> __device__ __forceinline__ void att_pv_one(f32x16& od, int vb, bf16x8 pa0, bf16x8 pa1, bf16x8 pa2, bf16x8 pa3) {
  const s16x4 l0 = att_tr_read<att_v_rd_off(D0, 0, 0)>(vb), h0 = att_tr_read<att_v_rd_off(D0, 0, 1)>(vb), l1 = att_tr_read<att_v_rd_off(D0, 1, 0)>(vb), h1 = att_tr_read<att_v_rd_off(D0, 1, 1)>(vb);
  const s16x4 l2 = att_tr_read<att_v_rd_off(D0, 2, 0)>(vb), h2 = att_tr_read<att_v_rd_off(D0, 2, 1)>(vb), l3 = att_tr_read<att_v_rd_off(D0, 3, 0)>(vb), h3 = att_tr_read<att_v_rd_off(D0, 3, 1)>(vb);
  asm volatile("s_waitcnt lgkmcnt(0)" ::: "memory"); SBAR();
#define PK(L, H) (bf16x8){L[0], L[1], L[2], L[3], H[0], H[1], H[2], H[3]}
  od = __builtin_amdgcn_mfma_f32_32x32x16_bf16(pa0, PK(l0, h0), od, 0, 0, 0);
  od = __builtin_amdgcn_mfma_f32_32x32x16_bf16(pa1, PK(l1, h1), od, 0, 0, 0);
  od = __builtin_amdgcn_mfma_f32_32x32x16_bf16(pa2, PK(l2, h2), od, 0, 0, 0);
  od = __builtin_amdgcn_mfma_f32_32x32x16_bf16(pa3, PK(l3, h3), od, 0, 0, 0);
#undef PK
}
__device__ __forceinline__ void attn_item(const P& p, char* lds, int seq, int h, int qb) {
  const int tid = tidx(), wid = tid >> 6, lane = tid & 63, r32 = lane & 31, hi = lane >> 5;
  char* V_lds = lds; char* K_lds = lds + 2 * ATT_SHM_V;
  float* wsl = (float*)(lds + 2 * ATT_SHM_V + 2 * ATT_SHM_K) + wid * 64; float* li_l = wsl; float* al_l = wsl + 32;
  const size_t tb = (size_t)seq * SEQ;
  const bfu* QF = (const bfu*)(p.ws + OFF_QF); const bfu* KVg = (const bfu*)(p.ws + OFF_KV) + tb * 1024 + h * 128; const bfu* KRg = (const bfu*)(p.ws + OFF_KR) + tb * 32;
  float m_run = 0.f, l_reg = 0; f32x16 o[2] = {}; bf16x8 qr[6];
  const bfu* Qw = QF + (tb + qb * 256 + wid * 32 + r32) * 768 + h * 96 + hi * 8;
#pragma unroll
  for (int d0 = 0; d0 < 6; ++d0) qr[d0] = *reinterpret_cast<const bf16x8*>(Qw + d0 * 16);
  const int sk = tid >> 3, sch = tid & 7, rk = (tid >> 2) & 63, rch = tid & 3;
  const int vst = att_v_st(sk, sch * 8), kst = KSWZ(sk, sch * 16), rst = KSWZ(rk, 128 + rch * 16);
  const int vb0 = (int)(uintptr_t)V_lds + att_v_rd_base(lane);
  struct { bf16x8 v, k, r; } sr_[2];
#define SLOAD(i, k0) do { sr_[i].v = *reinterpret_cast<const bf16x8*>(KVg + (size_t)((k0) + sk) * 1024 + 64 + sch * 8); \
    sr_[i].k = *reinterpret_cast<const bf16x8*>(KVg + (size_t)((k0) + sk) * 1024 + sch * 8);                              \
    if (tid < 256) sr_[i].r = *reinterpret_cast<const bf16x8*>(KRg + (size_t)((k0) + rk) * 32 + rch * 8); } while (0)
#define SWRITE(b, i) do { *(bf16x8*)(V_lds + (b) * ATT_SHM_V + vst) = sr_[i].v; *(bf16x8*)(K_lds + (b) * ATT_SHM_K + kst) = sr_[i].k; \
    if (tid < 256) *(bf16x8*)(K_lds + (b) * ATT_SHM_K + rst) = sr_[i].r; } while (0)
#define RESC(a) do { if (__any((a) < 1.f)) { if (hi == 0) al_l[r32] = (a); asm volatile("s_waitcnt lgkmcnt(0)" ::: "memory"); \
    for (int d = 0; d < 2; ++d) for (int r = 0; r < 16; ++r) o[d][r] *= al_l[crow(r, hi)]; } } while (0)
  f32x16 pA0, pA1, pB0, pB1; float alA, alB; bf16x8 pa0, pa1, pa2, pa3; constexpr int NT = SEQ / 64;
  constexpr int SE = 0, SO = 1;
  __syncthreads();
  SLOAD(SE, 0); asm volatile("s_waitcnt vmcnt(0)" ::: "memory"); SWRITE(0, SE); __syncthreads();
  att_qkt(pA0, pA1, K_lds, qr, r32, hi, 0.f); att_partialSM(pA0, pA1, m_run, alA, true);
  SLOAD(SO, 64); SLOAD(SE, 128);
  asm volatile("s_waitcnt vmcnt(3)" ::: "memory"); SWRITE(1, SO); __syncthreads();
  for (int j = 1; j + 1 < NT; j += 2) {
    SBAR(); att_qkt(pB0, pB1, K_lds + ATT_SHM_K, qr, r32, hi, -m_run);
    att_finishSM(pA0, pA1, alA, l_reg, pa0, pa1, pa2, pa3); SBAR();
    SLOAD(SO, (j + 2) * 64); SBAR();
    att_pv_one<0>(o[0], vb0, pa0, pa1, pa2, pa3); att_pv_one<1>(o[1], vb0, pa0, pa1, pa2, pa3); att_partialSM(pB0, pB1, m_run, alB, false);
    __syncthreads(); asm volatile("s_waitcnt vmcnt(3)" ::: "memory"); SWRITE(0, SE);
    RESC(alB); __syncthreads();
    SBAR(); att_qkt(pA0, pA1, K_lds, qr, r32, hi, -m_run);
    att_finishSM(pB0, pB1, alB, l_reg, pa0, pa1, pa2, pa3); SBAR();
    if (j + 3 < NT) SLOAD(SE, (j + 3) * 64); SBAR();
    att_pv_one<0>(o[0], vb0 + ATT_SHM_V, pa0, pa1, pa2, pa3); att_pv_one<1>(o[1], vb0 + ATT_SHM_V, pa0, pa1, pa2, pa3); att_partialSM(pA0, pA1, m_run, alA, false);
    __syncthreads(); asm volatile("s_waitcnt vmcnt(3)" ::: "memory"); SWRITE(1, SO);
    RESC(alA); __syncthreads();
  }
  SBAR(); att_qkt(pB0, pB1, K_lds + ATT_SHM_K, qr, r32, hi, -m_run);
  att_finishSM(pA0, pA1, alA, l_reg, pa0, pa1, pa2, pa3); SBAR();
  att_pv_one<0>(o[0], vb0, pa0, pa1, pa2, pa3); att_pv_one<1>(o[1], vb0, pa0, pa1, pa2, pa3); att_partialSM(pB0, pB1, m_run, alB, false);
  __syncthreads(); RESC(alB);
  att_finishSM(pB0, pB1, alB, l_reg, pa0, pa1, pa2, pa3); SBAR();
  att_pv_one<0>(o[0], vb0 + ATT_SHM_V, pa0, pa1, pa2, pa3); att_pv_one<1>(o[1], vb0 + ATT_SHM_V, pa0, pa1, pa2, pa3);
  if (hi == 0) li_l[r32] = l_reg; asm volatile("s_waitcnt lgkmcnt(0)" ::: "memory");
  float rli[16];
#pragma unroll
  for (int r = 0; r < 16; ++r) rli[r] = __builtin_amdgcn_rcpf(li_l[crow(r, hi)]);
  bfu* Ow = (bfu*)(p.ws + OFF_MIX) + (tb + qb * 256 + wid * 32) * 1024 + h * 64;
#pragma unroll
  for (int r = 0; r < 16; ++r) { int orow = crow(r, hi);
#pragma unroll
    for (int d0 = 0; d0 < 2; ++d0) Ow[(size_t)orow * 1024 + d0 * 32 + r32] = f2bf(o[d0][r] * rli[r]); }
#undef SLOAD
#undef SWRITE
#undef RESC
}
constexpr int ATT_S0 = 6;
__device__ __forceinline__ void attn_phase(const P& p, char* lds, int bid, int nb) {
  const int x = bid & 7, i = bid >> 3, per = nb >> 3;
  if (per == 32) {
    const bool glab = i < 20;
    for (int sl = glab ? ATT_S0 : 0; ; ++sl) {
      const int k = sl < ATT_S0 ? sl * 12 + (i - 20) : ATT_S0 * 12 + (sl - ATT_S0) * 32 + (i + 12) % 32;
      if (k >= 320) break;
      const int pair = (k >> 3) * 8 + x;
      attn_item(p, lds, pair >> 3, pair & 7, k & 7);
    }
  } else {
    for (int j = i; j < 320; j += per) {
      const int pair = (j >> 3) * 8 + x, qb = j & 7;
      attn_item(p, lds, pair >> 3, pair & 7, qb);
    }
  }
}

constexpr int GL_QD = 0, GL_KI = 8192, GL_KDT = 16384, GL_QR = 24576, GL_KR = 32768, GL_VI = 40960, GL_GLR = 57344  , GL_SEG = 65536, GL_BL = 66560, GL_RSS = 66816, GL_DIR = 67840;
constexpr int GL_OLS = 136;
constexpr int GLA_LDS = 2 * GL_DIR;
static_assert(64 * GL_OLS * 2 <= GL_QR, "output tile must fit over QD / KI / KDT");
__device__ __forceinline__ int gl_sw(int row, int col) { return row * 128 + ((((col >> 3) ^ (row & 7))) << 4) + (col & 7) * 2; }
__device__ __forceinline__ int gl_v_st(int k, int c) { const int kk = (k & ~0xC) | ((k & 4) << 1) | ((k & 8) >> 1); return ((kk >> 3) * 4 + (c >> 5)) * 512 + ((kk & 7) * 32 + (c & 31)) * 2; }
template <int KS, int HALF> __device__ __forceinline__ s16x4 gl_tr(int vb) { return att_tr_read<KS * 4096 + HALF * 2048>(vb); }
#define GL_PK(L, H) (bf16x8){L[0], L[1], L[2], L[3], H[0], H[1], H[2], H[3]}
__device__ __forceinline__ void gl_pk4(const f32x16& P, int BASE_is8, bf16x8& OUT) {
  unsigned a0, a1, b0, b1;
  if (BASE_is8 == 0) { a0 = cvtpk(P[0], P[1]); a1 = cvtpk(P[2], P[3]); b0 = cvtpk(P[4], P[5]); b1 = cvtpk(P[6], P[7]); }
  else { a0 = cvtpk(P[8], P[9]); a1 = cvtpk(P[10], P[11]); b0 = cvtpk(P[12], P[13]); b1 = cvtpk(P[14], P[15]); }
  auto r0 = __builtin_amdgcn_permlane32_swap(a0, b0, false, false); auto r1 = __builtin_amdgcn_permlane32_swap(a1, b1, false, false);
  u32x4 w = {r0[0], r1[0], r0[1], r1[1]}; OUT = *reinterpret_cast<bf16x8*>(&w);
}
__device__ __forceinline__ float half32_sum(float v) {
  v = row16_sum(v);
  auto rr = __builtin_amdgcn_permlane16_swap(__float_as_uint(v), __float_as_uint(v), false, false);
  return __uint_as_float(rr[0]) + __uint_as_float(rr[1]);
}
__device__ __forceinline__ void gla_item(const P& p, char* lds, int seq, int h) {
  const int tid = tidx(), wid = tid >> 6, lane = tid & 63, r32 = lane & 31, hi = lane >> 5;
  const int dir = wid >> 2, wv = wid & 3, td_ = tid & 255;
  char* L = lds + dir * GL_DIR;
  float* GLRS = (float*)(L + GL_GLR); float* SEG = (float*)(L + GL_SEG); float* BL = (float*)(L + GL_BL); float* RSS = (float*)(L + GL_RSS);
  const unsigned tb = (unsigned)seq * SEQ;
  const bfu* GQ = (const bfu*)(p.ws + OFF_GQ); const bfu* GK = (const bfu*)(p.ws + OFF_GK); const bfu* GV = (const bfu*)(p.ws + OFF_GV);
  const float* GLR = (const float*)(p.ws + OFF_GLR); const bfu* GOUT = (const bfu*)(p.ws + OFF_GOUT);
  bfu* OTMP = (bfu*)(p.ws + OFF_OTMP); bfu* MIX = (bfu*)(p.ws + OFF_MIX);
  const int d_ = td_ & 63, seg_ = td_ >> 6;
  float gwr[16]; float gbias;
  { const int d = d_;
  {
    const float* gw = dir ? p.gbw : p.gfw;
#pragma unroll
    for (int q = 0; q < 16; ++q) gwr[q] = gw[q * 256 + h * 64 + d];
  }
  gbias = (dir ? p.gbb : p.gfb)[h * 64 + d]; }
  f32x16 S0 = {}, S1 = {};
  const int vb = (int)(uintptr_t)(L + GL_VI) + att_v_rd_base(lane) + wv * 512;
  u32x4 pq0, pq1, pk0, pk1;
#define GL_PREFETCH(CCN, TD) do { const unsigned t0n = tb + (unsigned)(CCN) * 64u; \
    { const int sp = (TD) >> 2, q4 = (TD) & 3; const unsigned t = t0n + (unsigned)(dir ? 63 - sp : sp); \
      const u32x4* qs = (const u32x4*)(GQ + (t * 256u + (unsigned)(h * 64 + q4 * 16))); pq0 = qs[0]; pq1 = qs[1]; \
      const u32x4* ks = (const u32x4*)(GK + (t * 256u + (unsigned)(h * 64 + q4 * 16))); pk0 = ks[0]; pk1 = ks[1]; } } while (0)
#define GL_VDMA(CCN, LANE) do { const unsigned t0n = tb + (unsigned)(CCN) * 64u; \
    _Pragma("unroll") for (int i = 0; i < 4; ++i) { const int off = (i * 4 + wv) * 1024 + (LANE) * 16, blk = off >> 9, in = off & 511; \
      const int kk = (blk >> 2) * 8 + (in >> 6), k = (kk & ~0xC) | ((kk & 4) << 1) | ((kk & 8) >> 1), cv = (blk & 3) * 32 + ((in & 63) >> 1); \
      const unsigned t = t0n + (unsigned)(dir ? 63 - k : k); \
      __builtin_amdgcn_global_load_lds((const unsigned*)(GV + (t * 512u + (unsigned)(h * 128 + cv))), (unsigned*)(L + GL_VI + (i * 4 + wv) * 1024), 16, 0, 0); } } while (0)
#define GL_GDMA(CCN, TD, BUF) do { const unsigned t0n = tb + (unsigned)(CCN) * 64u; const int sp = (TD) >> 2, q4 = (TD) & 3; const unsigned t = t0n + (unsigned)(dir ? 63 - sp : sp); \
    __builtin_amdgcn_global_load_lds((const unsigned*)(GLR + (t * 32u + (unsigned)(dir * 16 + q4 * 4))), (unsigned*)(GLRS + (BUF) * 1024 + wv * 256), 16, 0, 0); } while (0)
  GL_GDMA(dir ? 31 : 0, td_, 0);
  GL_PREFETCH(dir ? 31 : 0, td_);
  GL_VDMA(dir ? 31 : 0, lane);
  if (td_ < 128) RSS[td_] = p.gla_g[td_];
  u32x4 ogv[4], ggv[4];
  for (int c = 0; c < 32; ++c) {
    const int cc = dir ? 31 - c : c;
    const unsigned t0 = tb + (unsigned)cc * 64u;
#define GL_TOK(sp) (t0 + (unsigned)(dir ? 63 - (sp) : (sp)))
    asm volatile("s_waitcnt vmcnt(3)" ::: "memory");
    __builtin_amdgcn_sched_barrier(0);
    int d = d_, seg = seg_, td = td_;
    asm volatile("" : "+v"(d), "+v"(seg), "+v"(td));
    { const int sp = td >> 2, q4 = td & 3;
      u32x4* qd = (u32x4*)(L + GL_QR + sp * 128 + q4 * 32); qd[0] = pq0; qd[1] = pq1;
      u32x4* kd2 = (u32x4*)(L + GL_KR + sp * 128 + q4 * 32); kd2[0] = pk0; kd2[1] = pk1; }
    const float* GLC = GLRS + (c & 1) * 1024;
    float bcum[16]; float run = 0.f;
#pragma unroll
    for (int rb = 0; rb < 8; ++rb) {
      float4 g[2][4];
#pragma unroll
      for (int r = 0; r < 2; ++r)
#pragma unroll
        for (int q = 0; q < 4; ++q) g[r][q] = *(const float4*)(GLC + (seg * 16 + rb * 2 + r) * 16 + q * 4);
      __builtin_amdgcn_sched_barrier(0);
#pragma unroll
      for (int r = 0; r < 2; ++r) {
        float z = gbias;
#pragma unroll
        for (int q = 0; q < 4; ++q) { const float4 v = g[r][q]; z += v.x * gwr[4 * q] + v.y * gwr[4 * q + 1] + v.z * gwr[4 * q + 2] + v.w * gwr[4 * q + 3]; }
        const float ls = fminf(z, 0.f) - 0.6931471805599453f * __builtin_amdgcn_logf(1.f + __expf(-fabsf(z)));
        run += ls * (1.f / 16.f); bcum[rb * 2 + r] = run;
      }
      __builtin_amdgcn_sched_barrier(0);
    }
    SEG[seg * 64 + d] = run;
    __syncthreads();
    {
      float qv[16], kv[16];
#pragma unroll
      for (int r = 0; r < 16; ++r) { qv[r] = bf2f(*(const bfu*)(L + GL_QR + (seg * 16 + r) * 128 + d * 2)); kv[r] = bf2f(*(const bfu*)(L + GL_KR + (seg * 16 + r) * 128 + d * 2)); }
      const float s0 = SEG[d], s1 = SEG[64 + d], s2 = SEG[128 + d], s3 = SEG[192 + d];
      const float off = (seg > 0 ? s0 : 0.f) + (seg > 1 ? s1 : 0.f) + (seg > 2 ? s2 : 0.f);
      const float total = s0 + s1 + s2 + s3;
      unsigned kd[8];
#pragma unroll
      for (int r = 0; r < 16; ++r) {
        const float b = bcum[r] + off;
        const float e1 = __expf(b), e2 = __expf(-b), e3 = __expf(total - b);
        const int sp = seg * 16 + r;
        *(bfu*)(L + GL_QD + gl_sw(sp, d)) = f2bf(qv[r] * e1);
        *(bfu*)(L + GL_KI + gl_sw(sp, d)) = f2bf(kv[r] * e2);
        const float kdv = kv[r] * e3;
        if (r & 1) kd[r >> 1] = cvtpk(__uint_as_float(kd[r >> 1]), kdv); else kd[r >> 1] = __float_as_uint(kdv);
      }
      *(uint4*)(L + GL_KDT + gl_sw(d, seg * 16)) = make_uint4(kd[0], kd[1], kd[2], kd[3]);
      *(uint4*)(L + GL_KDT + gl_sw(d, seg * 16 + 8)) = make_uint4(kd[4], kd[5], kd[6], kd[7]);
      if (seg == 0) BL[d] = __expf(total);
    }
    asm volatile("s_waitcnt vmcnt(0)" ::: "memory");
    __syncthreads();
    f32x16 X00 = {}, X01 = {}, X11 = {};
    {
      const char* KI = L + GL_KI; const char* QD = L + GL_QD;
#pragma unroll
      for (int ks = 0; ks < 4; ++ks) {
        const int col = ks * 16 + hi * 8;
        const bf16x8 a0 = *(const bf16x8*)(KI + gl_sw(r32, col)), a1 = *(const bf16x8*)(KI + gl_sw(32 + r32, col));
        const bf16x8 b0 = *(const bf16x8*)(QD + gl_sw(r32, col)), b1 = *(const bf16x8*)(QD + gl_sw(32 + r32, col));
        X00 = __builtin_amdgcn_mfma_f32_32x32x16_bf16(a0, b0, X00, 0, 0, 0);
        X01 = __builtin_amdgcn_mfma_f32_32x32x16_bf16(a0, b1, X01, 0, 0, 0);
        X11 = __builtin_amdgcn_mfma_f32_32x32x16_bf16(a1, b1, X11, 0, 0, 0);
      }
    }
#pragma unroll
    for (int r = 0; r < 16; ++r) { const bool keep = crow(r, hi) <= r32; X00[r] = keep ? X00[r] : 0.f; X11[r] = keep ? X11[r] : 0.f; }
    const s16x4 l0 = gl_tr<0, 0>(vb), h0 = gl_tr<0, 1>(vb), l1 = gl_tr<1, 0>(vb), h1 = gl_tr<1, 1>(vb);
    const s16x4 l2 = gl_tr<2, 0>(vb), h2 = gl_tr<2, 1>(vb), l3 = gl_tr<3, 0>(vb), h3 = gl_tr<3, 1>(vb);
    asm volatile("s_waitcnt lgkmcnt(0)" ::: "memory"); SBAR();
    const bf16x8 V0 = GL_PK(l0, h0), V1 = GL_PK(l1, h1), V2 = GL_PK(l2, h2), V3 = GL_PK(l3, h3);
    f32x16 o0 = {}, o1 = {};
    { bf16x8 pa0, pa1, pa2, pa3;
      gl_pk4(X00, 0, pa0); gl_pk4(X00, 1, pa1);
      o0 = __builtin_amdgcn_mfma_f32_32x32x16_bf16(pa0, V0, o0, 0, 0, 0);
      o0 = __builtin_amdgcn_mfma_f32_32x32x16_bf16(pa1, V1, o0, 0, 0, 0);
      gl_pk4(X01, 0, pa0); gl_pk4(X01, 1, pa1); gl_pk4(X11, 0, pa2); gl_pk4(X11, 1, pa3);
      o1 = __builtin_amdgcn_mfma_f32_32x32x16_bf16(pa0, V0, o1, 0, 0, 0);
      o1 = __builtin_amdgcn_mfma_f32_32x32x16_bf16(pa1, V1, o1, 0, 0, 0);
      o1 = __builtin_amdgcn_mfma_f32_32x32x16_bf16(pa2, V2, o1, 0, 0, 0);
      o1 = __builtin_amdgcn_mfma_f32_32x32x16_bf16(pa3, V3, o1, 0, 0, 0);
    }
    {
      const char* QD = L + GL_QD;
#pragma unroll
      for (int dt = 0; dt < 2; ++dt) {
        const f32x16& Sx = dt ? S1 : S0;
#pragma unroll
        for (int ks = 0; ks < 2; ++ks) {
          u32x4 sb = {cvtpk(Sx[8 * ks + 0], Sx[8 * ks + 1]), cvtpk(Sx[8 * ks + 2], Sx[8 * ks + 3]), cvtpk(Sx[8 * ks + 4], Sx[8 * ks + 5]), cvtpk(Sx[8 * ks + 6], Sx[8 * ks + 7])};
          const bf16x8 sbf = *reinterpret_cast<bf16x8*>(&sb);
          const int dcol = dt * 32 + ks * 16 + hi * 4;
          const uint2 a0l = *(const uint2*)(QD + gl_sw(r32, dcol)), a0h = *(const uint2*)(QD + gl_sw(r32, dcol + 8));
          const uint2 a1l = *(const uint2*)(QD + gl_sw(32 + r32, dcol)), a1h = *(const uint2*)(QD + gl_sw(32 + r32, dcol + 8));
          u32x4 A0 = {a0l.x, a0l.y, a0h.x, a0h.y}, A1 = {a1l.x, a1l.y, a1h.x, a1h.y};
          o0 = __builtin_amdgcn_mfma_f32_32x32x16_bf16(*reinterpret_cast<bf16x8*>(&A0), sbf, o0, 0, 0, 0);
          o1 = __builtin_amdgcn_mfma_f32_32x32x16_bf16(*reinterpret_cast<bf16x8*>(&A1), sbf, o1, 0, 0, 0);
        }
      }
    }
    {
      const char* KDT = L + GL_KDT;
#pragma unroll
      for (int r = 0; r < 16; ++r) { S0[r] *= BL[crow(r, hi)]; S1[r] *= BL[32 + crow(r, hi)]; }
#pragma unroll
      for (int s = 0; s < 4; ++s) {
        const bf16x8 Vs = s == 0 ? V0 : s == 1 ? V1 : s == 2 ? V2 : V3;
        const bf16x8 a0 = *(const bf16x8*)(KDT + gl_sw(r32, s * 16 + hi * 8)), a1 = *(const bf16x8*)(KDT + gl_sw(32 + r32, s * 16 + hi * 8));
        S0 = __builtin_amdgcn_mfma_f32_32x32x16_bf16(a0, Vs, S0, 0, 0, 0);
        S1 = __builtin_amdgcn_mfma_f32_32x32x16_bf16(a1, Vs, S1, 0, 0, 0);
      }
    }
    __syncthreads();
    if (c < 31) { int tdp = td; asm volatile("" : "+v"(tdp)); GL_PREFETCH(dir ? 30 - c : c + 1, tdp); int lp = tdp & 63; GL_VDMA(dir ? 30 - c : c + 1, lp); GL_GDMA(dir ? 30 - c : c + 1, tdp, (c + 1) & 1); }
    if (c >= 16) { int tdq = td; asm volatile("" : "+v"(tdq)); const int row = tdq >> 2, sg = tdq & 3; const unsigned t = GL_TOK(row);
      const u32x4* og = (const u32x4*)(OTMP + (t * 512u + (unsigned)(h * 128 + sg * 32))); const u32x4* gg = (const u32x4*)(GOUT + (t * 512u + (unsigned)(h * 128 + sg * 32)));
#pragma unroll
      for (int q = 0; q < 4; ++q) { ogv[q] = og[q]; ggv[q] = gg[q]; } }
    {
      bfu* OL = (bfu*)L;
#pragma unroll
      for (int r = 0; r < 16; ++r) {
        OL[crow(r, hi) * GL_OLS + wv * 32 + r32] = (bfu)cvtpk(o0[r], o0[r]);
        OL[(32 + crow(r, hi)) * GL_OLS + wv * 32 + r32] = (bfu)cvtpk(o1[r], o1[r]);
      }
    }
    __syncthreads();
    {
      const bfu* OL = (const bfu*)L;
      const int row = td >> 2, sg = td & 3;
      const unsigned t = GL_TOK(row);
      uint4 ow4[4];
#pragma unroll
      for (int q = 0; q < 4; ++q) ow4[q] = *(const uint4*)(OL + row * GL_OLS + sg * 32 + q * 8);
      uint4* og = (uint4*)(OTMP + (t * 512u + (unsigned)(h * 128 + sg * 32)));
      if (c < 16) {
#pragma unroll
        for (int q = 0; q < 4; ++q) og[q] = ow4[q];
      } else {
#define GL_SUM8(Q, OV) do { const unsigned wa[4] = {ow4[Q].x, ow4[Q].y, ow4[Q].z, ow4[Q].w}; \
          _Pragma("unroll") for (int e = 0; e < 4; ++e) { OV[2 * e] = __uint_as_float(wa[e] << 16) + __uint_as_float(ogv[Q][e] << 16); \
            OV[2 * e + 1] = __uint_as_float(wa[e] & 0xffff0000u) + __uint_as_float(ogv[Q][e] & 0xffff0000u); } } while (0)
        float ss = 0.f;
#pragma unroll
        for (int q = 0; q < 4; ++q) { float ov[8]; GL_SUM8(q, ov);
#pragma unroll
          for (int e = 0; e < 8; ++e) ss += ov[e] * ov[e]; }
        ss += dpp_f<0xB1>(ss); ss += dpp_f<0x4E>(ss);
        const float rstd = rsqrtf(ss * (1.f / 128.f) + EPS);
        const float4* gn = (const float4*)(RSS + sg * 32);
        uint4* mo = (uint4*)(MIX + (t * 1024u + 512u + (unsigned)(h * 128 + sg * 32)));
#pragma unroll
        for (int q = 0; q < 4; ++q) {
          const float4 n0 = gn[2 * q], n1 = gn[2 * q + 1];
          const unsigned gws[4] = {ggv[q][0], ggv[q][1], ggv[q][2], ggv[q][3]};
          float ov[8]; GL_SUM8(q, ov);
          const float nn[8] = {n0.x, n0.y, n0.z, n0.w, n1.x, n1.y, n1.z, n1.w};
          unsigned ow[4];
#pragma unroll
          for (int e = 0; e < 4; ++e) {
            const float g0 = __uint_as_float(gws[e] << 16), g1 = __uint_as_float(gws[e] & 0xffff0000u);
            const float r0 = ov[2 * e] * rstd * nn[2 * e] * (g0 / (1.f + __expf(-g0)));
            const float r1 = ov[2 * e + 1] * rstd * nn[2 * e + 1] * (g1 / (1.f + __expf(-g1)));
            ow[e] = cvtpk(r0, r1);
          }
          mo[q] = make_uint4(ow[0], ow[1], ow[2], ow[3]);
        }
      }
    }
#undef GL_SUM8
#undef GL_TOK
  }
#undef GL_PREFETCH
#undef GL_GDMA
#undef GL_VDMA
}
__device__ __forceinline__ void gla_phase(const P& p, char* lds, int bid, int nb) {
  for (int item = bid; item < NSEQ * 4; item += nb) gla_item(p, lds, item >> 2, item & 3);
}

typedef _Float16 h2_t __attribute__((ext_vector_type(2)));
__device__ __forceinline__ unsigned enc_key(float f, unsigned idx, unsigned lowmask) {
  unsigned u = __float_as_uint(f);
  unsigned k = u ^ ((unsigned)((int)u >> 31) | 0x80000000u);
  return (k & ~lowmask) | idx;
}
__device__ __forceinline__ float dec_key(unsigned k, unsigned lowmask) {
  k &= ~lowmask;
  unsigned u = (k & 0x80000000u) ? (k & 0x7fffffffu) : ~k;
  return __uint_as_float(u);
}
__device__ __forceinline__ void ce_desc(unsigned& a, unsigned& b) { unsigned mx = a > b ? a : b, mn = a > b ? b : a; a = mx; b = mn; }
__device__ __forceinline__ void sort16_desc(unsigned (&k)[16]) {
#pragma unroll
  for (int size = 2; size <= 16; size <<= 1)
#pragma unroll
    for (int stride = size >> 1; stride > 0; stride >>= 1)
#pragma unroll
      for (int i = 0; i < 16; ++i) {
        const int l = i ^ stride;
        if (l > i) { if ((i & size) == 0) ce_desc(k[i], k[l]); else ce_desc(k[l], k[i]); }
      }
}
__device__ __forceinline__ void bmerge16_desc(unsigned (&k)[16]) {
#pragma unroll
  for (int stride = 8; stride > 0; stride >>= 1)
#pragma unroll
    for (int i = 0; i < 16; ++i) { const int l = i ^ stride; if (l > i) ce_desc(k[i], k[l]); }
}
__device__ __forceinline__ void merge_top16(unsigned (&top)[16], const unsigned (&nw)[16]) {
#pragma unroll
  for (int i = 0; i < 16; ++i) top[i] = top[i] > nw[15 - i] ? top[i] : nw[15 - i];
  bmerge16_desc(top);
}
constexpr int cand_a(int c) { return c < 16 ? 0 : c < 24 ? 1 : c < 29 ? 2 : c < 33 ? 3 : c < 36 ? 4 : c < 38 ? 5 : c < 40 ? 6 : c < 42 ? 7 : c < 50 ? c - 34 : -1; }
constexpr int cand_b(int c) { return c < 16 ? c : c < 24 ? c - 16 : c < 29 ? c - 24 : c < 33 ? c - 29 : c < 36 ? c - 33 : c < 38 ? c - 36 : c < 40 ? c - 38 : c < 42 ? c - 40 : 0; }

constexpr int PE_TOK = 64;
constexpr int PE_T1_STRIDE = 260;
constexpr int PE_STARTS_B = PE_TOK * 20 * 4;
constexpr int PE_RING_B = 8 * 8192;
constexpr int PE_LDS_TOP1 = PE_STARTS_B + PE_RING_B;
static_assert(PE_TOK * PE_T1_STRIDE * 4 <= PE_LDS_TOP1, "top1 image must fit region 0");
constexpr int PE_LDS = PE_LDS_TOP1 + PE_TOK * 128 * 8;

__device__ __forceinline__ void peer_topk1_fin(const unsigned (&top)[16], int tl, int g, int hi, unsigned* top1) {
  unsigned m[16];
#pragma unroll
  for (int i = 0; i < 16; ++i) {
    const unsigned mine = hi ? top[15 - i] : top[i];
    auto rr = __builtin_amdgcn_permlane32_swap(mine, mine, false, false);
    m[i] = rr[0] > rr[1] ? rr[0] : rr[1];
  }
  bmerge16_desc(m);
  if (hi == 0) {
    uint4* dst = (uint4*)(top1 + tl * PE_T1_STRIDE + g * 16);
#pragma unroll
    for (int q = 0; q < 4; ++q) dst[q] = make_uint4(m[4 * q], m[4 * q + 1], m[4 * q + 2], m[4 * q + 3]);
  }
}
__device__ __forceinline__ void peer_topk1(const P& p, int tok0, int g, unsigned* top1) {
  const int lane = tidx() & 63, r32 = lane & 31, hi = lane >> 5;
  const uint4* S0 = (const uint4*)((const _Float16*)(p.ws + OFF_PQ) + (size_t)(tok0 + r32) * 2048 + g * 128 + hi * 64);
  const uint4* S1 = S0 + (size_t)32 * 2048 * 2 / 16;
  uint4 sa[8], sb[8];
#pragma unroll
  for (int q = 0; q < 8; ++q) { sa[q] = S0[q]; sb[q] = S1[q]; }
  unsigned top0[16], top1r[16];
#pragma unroll
  for (int kt = 0; kt < 4; ++kt) {
    unsigned key0[16], key1[16];
#pragma unroll
    for (int q = 0; q < 2; ++q) {
      const unsigned wa[4] = {sa[2 * kt + q].x, sa[2 * kt + q].y, sa[2 * kt + q].z, sa[2 * kt + q].w};
      const unsigned wb[4] = {sb[2 * kt + q].x, sb[2 * kt + q].y, sb[2 * kt + q].z, sb[2 * kt + q].w};
#pragma unroll
      for (int e = 0; e < 4; ++e) {
        const unsigned idx = (unsigned)(hi * 64 + kt * 16 + q * 8 + 2 * e);
        const h2_t ha = __builtin_bit_cast(h2_t, wa[e]), hb = __builtin_bit_cast(h2_t, wb[e]);
        key0[q * 8 + 2 * e] = enc_key((float)ha[0], idx, 127u); key0[q * 8 + 2 * e + 1] = enc_key((float)ha[1], idx + 1u, 127u);
        key1[q * 8 + 2 * e] = enc_key((float)hb[0], idx, 127u); key1[q * 8 + 2 * e + 1] = enc_key((float)hb[1], idx + 1u, 127u);
      }
    }
    sort16_desc(key0); sort16_desc(key1);
    if (kt == 0) {
#pragma unroll
      for (int r = 0; r < 16; ++r) { top0[r] = key0[r]; top1r[r] = key1[r]; }
    } else { merge_top16(top0, key0); merge_top16(top1r, key1); }
  }
  peer_topk1_fin(top0, r32, g, hi, top1);
  peer_topk1_fin(top1r, 32 + r32, g, hi, top1);
}
__device__ __forceinline__ void peer_topk2(const P& p, int tok0, const unsigned* top1, int* pidx, float* pgate) {
  const int tid = tidx(), tl = tid >> 3, hh = tid & 7;
  float rs2;
  { const float4* s4 = (const float4*)(p.ws + OFF_SS2) + (size_t)(tok0 + tl) * 4; float sq = 0.f;
#pragma unroll
    for (int q = 0; q < 4; ++q) { const float4 t = s4[q]; sq += t.x + t.y + t.z + t.w; }
    rs2 = rsqrtf(sq * (1.f / 1024.f) + EPS); }
  const unsigned* l1 = top1 + tl * PE_T1_STRIDE + hh * 32;
  unsigned k1[16], k2[16];
#pragma unroll
  for (int q = 0; q < 4; ++q) {
    uint4 a = ((const uint4*)l1)[q], b = ((const uint4*)l1)[4 + q];
    k1[4 * q] = a.x; k1[4 * q + 1] = a.y; k1[4 * q + 2] = a.z; k1[4 * q + 3] = a.w;
    k2[4 * q] = b.x; k2[4 * q + 1] = b.y; k2[4 * q + 2] = b.z; k2[4 * q + 3] = b.w;
  }
  float f1[16], f2[16];
#pragma unroll
  for (int i = 0; i < 16; ++i) { f1[i] = dec_key(k1[i], 127u) * rs2; f2[i] = dec_key(k2[i], 127u) * rs2; }
  unsigned top[16];
#pragma unroll
  for (int bt = 0; bt < 4; ++bt) {
    unsigned key[16];
#pragma unroll
    for (int c = 0; c < 16; ++c) {
      const int cc = bt * 16 + c;
      const int a = cand_a(cc), b = cand_b(cc);
      key[c] = (a >= 0) ? enc_key(f1[a >= 0 ? a : 0] + f2[b], (unsigned)((a >= 0 ? a : 0) * 16 + b), 255u) : 0u;
    }
    sort16_desc(key);
    if (bt == 0) {
#pragma unroll
      for (int r = 0; r < 16; ++r) top[r] = key[r];
    } else merge_top16(top, key);
  }
  float s[16]; float sum = 0;
  const float m0 = dec_key(top[0], 255u);
#pragma unroll
  for (int r = 0; r < 16; ++r) { s[r] = __expf(dec_key(top[r], 255u) - m0); sum += s[r]; }
  const float inv = 1.f / sum;
#pragma unroll
  for (int r = 0; r < 16; ++r) {
    const unsigned ab = top[r] & 255u;
    const int i1 = (int)(l1[ab >> 4] & 127u), i2 = (int)(l1[16 + (ab & 15u)] & 127u);
    pidx[tl * 128 + hh * 16 + r] = i1 * 128 + i2;
    pgate[tl * 128 + hh * 16 + r] = s[r] * inv;
  }
}
__device__ __forceinline__ float gelu_tanh_f(float x) {
  float u = 0.7978845608028654f * (x + 0.044715f * x * x * x);
  float th = 1.f - 2.f / (1.f + __expf(2.f * u));
  return 0.5f * x * (1.f + th);
}
__device__ __forceinline__ unsigned pk_h2(float a, float b) { h2_t h = {(_Float16)a, (_Float16)b}; return __builtin_bit_cast(unsigned, h); }
constexpr int PE_NR = 16;
__device__ __forceinline__ void peer_sort_picks(int* pidx_t, float* pgate_t, int* starts_t) {
  const int lane = tidx() & 63;
  const int i0 = pidx_t[lane], i1 = pidx_t[64 + lane];
  const float g0 = pgate_t[lane], g1 = pgate_t[64 + lane];
  const int r0 = i0 >> 10, r1 = i1 >> 10;
  int pos0 = 0, pos1 = 0, base = 0, sv = 128;
#pragma unroll
  for (int r = 0; r < PE_NR; ++r) {
    const unsigned long long m0 = __ballot(r0 == r), m1 = __ballot(r1 == r);
    const int c0 = __popcll(m0), c1 = __popcll(m1);
    const int b0 = (int)__builtin_amdgcn_mbcnt_hi((unsigned)(m0 >> 32), __builtin_amdgcn_mbcnt_lo((unsigned)m0, 0u));
    const int b1 = (int)__builtin_amdgcn_mbcnt_hi((unsigned)(m1 >> 32), __builtin_amdgcn_mbcnt_lo((unsigned)m1, 0u));
    pos0 = (r0 == r) ? base + b0 : pos0;
    pos1 = (r1 == r) ? base + c0 + b1 : pos1;
    sv = (lane == r) ? base : sv;
    base += c0 + c1;
  }
  pidx_t[pos0] = i0; pgate_t[pos0] = g0; pidx_t[pos1] = i1; pgate_t[pos1] = g1;
  if (lane <= PE_NR) starts_t[lane] = sv;
}
__device__ __forceinline__ int peer_idx4(const int* pidx_t, int k, int e, int lane) { return pidx_t[min(k + (lane & 3), e - 1)]; }
template <int NP>
__device__ __forceinline__ void peer_issue(const char* UTb, const char* VTb, int ev, char* ring, int lane) {
  const unsigned l16 = (unsigned)lane * 16u;
#pragma unroll
  for (int q = 0; q < NP; ++q) {
    const size_t rowoff = (size_t)(unsigned)__builtin_amdgcn_readlane(ev, q) << 10;
    __builtin_amdgcn_global_load_lds((const unsigned*)(UTb + rowoff + l16), (unsigned*)(ring + q * 2048), 16, 0, 0);
    __builtin_amdgcn_global_load_lds((const unsigned*)(VTb + rowoff + l16), (unsigned*)(ring + q * 2048 + 1024), 16, 0, 0);
  }
}
__device__ __forceinline__ float gelu_tanh_fast(float x) {
  const float u = 0.7978845608028654f * (x + 0.044715f * x * x * x);
  return x * __builtin_amdgcn_rcpf(1.f + __expf(-2.f * u));
}
template <int NP>
__device__ __forceinline__ void peer_compute(const uint4 (&U)[4], const uint4 (&V)[4], float gl, const int (&xq)[4], float xscale, h2_t (&acc)[8], int lane) {
  float d[4];
#pragma unroll
  for (int q = 0; q < 4; ++q) {
    if (q < NP) {
      int s = __builtin_amdgcn_sdot4((int)U[q].x, xq[0], 0, false);
      s = __builtin_amdgcn_sdot4((int)U[q].y, xq[1], s, false);
      s = __builtin_amdgcn_sdot4((int)U[q].z, xq[2], s, false);
      s = __builtin_amdgcn_sdot4((int)U[q].w, xq[3], s, false);
      d[q] = (float)s;
    } else d[q] = 0.f;
  }
  float act;
  if (NP == 4) {
    float s2[2];
#pragma unroll
    for (int q = 0; q < 2; ++q) { auto rr = __builtin_amdgcn_permlane32_swap(__float_as_uint(d[q]), __float_as_uint(d[q + 2]), false, false); s2[q] = __uint_as_float(rr[0]) + __uint_as_float(rr[1]); }
    auto rr = __builtin_amdgcn_permlane16_swap(__float_as_uint(s2[0]), __float_as_uint(s2[1]), false, false); act = __uint_as_float(rr[0]) + __uint_as_float(rr[1]);
  } else {
    auto r1 = __builtin_amdgcn_permlane32_swap(__float_as_uint(d[0]), __float_as_uint(d[1]), false, false);
    const float t = __uint_as_float(r1[0]) + __uint_as_float(r1[1]);
    auto r2 = __builtin_amdgcn_permlane16_swap(__float_as_uint(t), __float_as_uint(t), false, false); act = __uint_as_float(r2[0]) + __uint_as_float(r2[1]);
  }
  act = row16_sum(act) * xscale;
  const float wl = gl * gelu_tanh_fast(act);
  const unsigned whl = pk_h2(wl, wl);
#pragma unroll
  for (int q = 0; q < NP; ++q) {
    const h2_t wq = __builtin_bit_cast(h2_t, (unsigned)__builtin_amdgcn_readlane((int)whl, NP == 4 ? q * 16 : q * 32));
    const unsigned vw[4] = {V[q].x, V[q].y, V[q].z, V[q].w};
#pragma unroll
    for (int j = 0; j < 4; ++j) {
      acc[2 * j] = __builtin_amdgcn_cvt_scalef32_pk_f16_fp8((int)vw[j], 0.015625f, false) * wq + acc[2 * j];
      acc[2 * j + 1] = __builtin_amdgcn_cvt_scalef32_pk_f16_fp8((int)vw[j], 0.015625f, true) * wq + acc[2 * j + 1];
    }
  }
}
__device__ __forceinline__ void peer_load_hraw(const P& p, int t, int lane, uint4 (&raw)[2]) {
  const uint4* hr = (const uint4*)((const bfu*)(p.ws + OFF_HB) + (size_t)t * 1024) + lane * 2;
  raw[0] = hr[0]; raw[1] = hr[1];
}
__device__ __forceinline__ void peer_dec_h(const uint4 (&raw)[2], float (&hv)[16]) {
#pragma unroll
  for (int q = 0; q < 2; ++q) { const unsigned w[4] = {raw[q].x, raw[q].y, raw[q].z, raw[q].w};
#pragma unroll
    for (int e = 0; e < 4; ++e) { hv[8 * q + 2 * e] = __uint_as_float(w[e] << 16); hv[8 * q + 2 * e + 1] = __uint_as_float(w[e] & 0xffff0000u); } }
}
__device__ __forceinline__ void peer_gather_wave8(const P& p, int t0, int* pidx_w, float* pgate_w, int* starts_w, char* ring) {
  const int lane = tidx() & 63;
  t0 = __builtin_amdgcn_readfirstlane(t0);
  const char* UTb = p.ws + OFF_UT; const char* VTb = p.ws + OFF_VT;
  int xq[8][4]; float xsc[8]; h2_t acc[8][8];
  uint4 hraw[2][2];
  peer_load_hraw(p, t0, lane, hraw[0]);
#pragma unroll
  for (int i = 0; i < 8; ++i) {
    if (i < 7) peer_load_hraw(p, t0 + i + 1, lane, hraw[(i + 1) & 1]);
    peer_sort_picks(pidx_w + i * 128, pgate_w + i * 128, starts_w + i * 20);
    float hv[16]; peer_dec_h(hraw[i & 1], hv);
    float ss = 0, am = 0;
#pragma unroll
    for (int e = 0; e < 16; ++e) { ss += hv[e] * hv[e]; am = fmaxf(am, fabsf(hv[e])); }
    ss = wave_sum(ss); am = wave_max(am);
    const float rstd = rsqrtf(ss * (1.f / 1024.f) + EPS);
    const float inv = am > 0.f ? 127.f / am : 0.f;
    xsc[i] = am * rstd * (1.f / (127.f * PE_SU));
#pragma unroll
    for (int q = 0; q < 4; ++q) {
      const int q0 = (int)rintf(hv[4 * q] * inv), q1 = (int)rintf(hv[4 * q + 1] * inv), q2 = (int)rintf(hv[4 * q + 2] * inv), q3 = (int)rintf(hv[4 * q + 3] * inv);
      xq[i][q] = (int)((unsigned)(q0 & 255) | ((unsigned)(q1 & 255) << 8) | ((unsigned)(q2 & 255) << 16) | ((unsigned)(q3 & 255) << 24));
    }
#pragma unroll
    for (int j = 0; j < 8; ++j) acc[i][j] = h2_t{(_Float16)0.f, (_Float16)0.f};
    __builtin_amdgcn_sched_barrier(0);
  }
  bool pf = false;
  for (int r = 0; r < PE_NR; ++r) {
#pragma unroll
    for (int i = 0; i < 8; ++i) {
      const int s = __builtin_amdgcn_readfirstlane(starts_w[i * 20 + r]), e = __builtin_amdgcn_readfirstlane(starts_w[i * 20 + r + 1]);
      const int ni = (i + 1) & 7, nr = (i == 7) ? r + 1 : r;
      const int ns = (nr < PE_NR) ? __builtin_amdgcn_readfirstlane(starts_w[ni * 20 + nr]) : 0;
      const int ne = (nr < PE_NR) ? __builtin_amdgcn_readfirstlane(starts_w[ni * 20 + nr + 1]) : 0;
      for (int k = s; k < e;) {
        const bool four = (e - k) > 2;
        const int k2 = k + (four ? 4 : 2);
        const bool same = k2 < e, hasn = same || (ns < ne);
        const int* nlist = pidx_w + (same ? i : ni) * 128; const int nk = same ? k2 : ns, nend = same ? e : ne;
        if (!pf) { const int ev = peer_idx4(pidx_w + i * 128, k, e, lane); if (four) peer_issue<4>(UTb, VTb, ev, ring, lane); else peer_issue<2>(UTb, VTb, ev, ring, lane); }
        asm volatile("s_waitcnt vmcnt(0)" ::: "memory");
        uint4 U[4], V[4];
#pragma unroll
        for (int q = 0; q < 4; ++q) if (q < 2 || four) { U[q] = *(const uint4*)(ring + q * 2048 + lane * 16); V[q] = *(const uint4*)(ring + q * 2048 + 1024 + lane * 16); }
        const int kg = k + (four ? (lane >> 4) : (lane >> 5));
        const float gl = (kg < e) ? pgate_w[i * 128 + min(kg, e - 1)] : 0.f;
        const int evn = hasn ? peer_idx4(nlist, nk, nend, lane) : 0;
        asm volatile("s_waitcnt lgkmcnt(0)" ::: "memory");
        if (hasn) { if (nend - nk > 2) peer_issue<4>(UTb, VTb, evn, ring, lane); else peer_issue<2>(UTb, VTb, evn, ring, lane); }
        pf = hasn;
        if (four) peer_compute<4>(U, V, gl, xq[i], xsc[i], acc[i], lane); else peer_compute<2>(U, V, gl, xq[i], xsc[i], acc[i], lane);
        k = k2;
      }
    }
  }
  { int te0 = t0; asm volatile("" : "+s"(te0)); peer_load_hraw(p, te0, lane, hraw[0]); }
#pragma unroll
  for (int i = 0; i < 8; ++i) {
    int te = t0 + i; asm volatile("" : "+s"(te));
    if (i < 7) peer_load_hraw(p, te + 1, lane, hraw[(i + 1) & 1]);
    float hv[16]; peer_dec_h(hraw[i & 1], hv);
    float y[16]; float ss = 0;
#pragma unroll
    for (int j = 0; j < 8; ++j) { y[2 * j] = hv[2 * j] + (float)acc[i][j][0]; y[2 * j + 1] = hv[2 * j + 1] + (float)acc[i][j][1]; }
#pragma unroll
    for (int e = 0; e < 16; ++e) ss += y[e] * y[e];
    ss = wave_sum(ss);
    const float rf = rsqrtf(ss * (1.f / 1024.f) + EPS);
    const float4* gr = (const float4*)p.fin_g + lane * 4;
    float4* o4 = (float4*)(p.out + (size_t)te * 1024) + lane * 4;
#pragma unroll
    for (int q = 0; q < 4; ++q) { const float4 g = gr[q]; o4[q] = make_float4(y[4 * q] * rf * g.x, y[4 * q + 1] * rf * g.y, y[4 * q + 2] * rf * g.z, y[4 * q + 3] * rf * g.w); }
    __builtin_amdgcn_sched_barrier(0);
  }
}
__device__ __forceinline__ void peer_phase(const P& p, char* lds, int bid, int nb) {
  unsigned* top1 = (unsigned*)lds; int* pidx = (int*)(lds + PE_LDS_TOP1); float* pgate = (float*)(lds + PE_LDS_TOP1 + PE_TOK * 128 * 4);
  int* starts = (int*)lds;
  const int wid = __builtin_amdgcn_readfirstlane(tidx() >> 6);
  for (int tile = bid; tile < T / PE_TOK; tile += nb) {
    const int tok0 = tile * PE_TOK;
    __syncthreads();
    for (int g = wid; g < 16; g += 8) peer_topk1(p, tok0, g, top1);
    __syncthreads();
    peer_topk2(p, tok0, top1, pidx, pgate);
    __syncthreads();
    peer_gather_wave8(p, tok0 + wid * 8, pidx + wid * 8 * 128, pgate + wid * 8 * 128, starts + wid * 8 * 20, lds + PE_STARTS_B + wid * 8192);
  }
}

#define XB_TMO      128
#define XB_XCNT(j)  (256  + 64 * (j))
#define XB_XSUB(j)  (1280 + 64 * (j))
#define XB_XGEN(j)  (2304 + 64 * (j))
#define XB_TOP      3328
#define XB_TOPGEN   3392
#define XCD_BAR_WORDS 3456
#define XB_SPIN_CAP (1u << 18)
#define LAS __attribute__((address_space(3)))

__device__ __forceinline__ unsigned xb_ld(unsigned* p)              { return __hip_atomic_load(p, __ATOMIC_RELAXED, __HIP_MEMORY_SCOPE_AGENT); }
__device__ __forceinline__ unsigned xb_add(unsigned* p, unsigned v) { return __hip_atomic_fetch_add(p, v, __ATOMIC_RELAXED, __HIP_MEMORY_SCOPE_AGENT); }
__device__ __forceinline__ unsigned xb_xcc_id() { return (unsigned)__builtin_amdgcn_s_getreg((3 << 11) | 20) & 0xFu; }
#define XB_SPIN(cond, bar) do { unsigned _sp = 0; while (cond) { __builtin_amdgcn_s_sleep(1); \
    if ((++_sp & 255u) == 0u) { if (xb_ld(&(bar)[XB_TMO])) break; if (_sp > XB_SPIN_CAP) { atomicAdd(&(bar)[XB_TMO], 1u); break; } } } } while (0)

struct XcdBarrier {
    unsigned* bar; unsigned x;
    volatile LAS unsigned* st;
};

__device__ __forceinline__ XcdBarrier xcd_barrier_post(unsigned* bar, volatile LAS unsigned* st) {
    XcdBarrier b; b.bar = bar; b.x = xb_xcc_id(); b.st = st;
    if (tidx() == 0) (void)xb_add(&bar[XB_XCNT(b.x)], 1u);
    return b;
}
__device__ __forceinline__ void xcd_barrier_complete(unsigned* bar, unsigned x, unsigned& nloc, unsigned& nx) {
    const unsigned G = gridDim.x * gridDim.y * gridDim.z;
    unsigned sum, cnt, mine, sp = 0u;
    for (;;) {
        sum = 0u; cnt = 0u; mine = 0u;
#pragma unroll
        for (unsigned j = 0; j < 16; ++j) { const unsigned c = xb_ld(&bar[XB_XCNT(j)]); sum += c; cnt += (c > 0u) ? 1u : 0u; mine = (j == x) ? c : mine; }
        if (sum == G) break;
        __builtin_amdgcn_s_sleep(1);
        if ((++sp & 255u) == 0u) { if (xb_ld(&bar[XB_TMO])) break; if (sp > XB_SPIN_CAP) { atomicAdd(&bar[XB_TMO], 1u); break; } }
    }
    nloc = mine > 0u ? mine : 1u; nx = cnt > 0u ? cnt : 1u;
}

__device__ __forceinline__ void xcd_barrier(const XcdBarrier& b) {
    asm volatile("s_waitcnt vmcnt(0)" ::: "memory");
    __syncthreads();
    if (tidx() == 0) {
        unsigned* bar = b.bar;
        __builtin_amdgcn_s_waitcnt(0);
        unsigned nloc = b.st[0], nx = b.st[1];
        if (nloc == 0u) { xcd_barrier_complete(bar, b.x, nloc, nx); b.st[0] = nloc; b.st[1] = nx; }
        const unsigned old = xb_add(&bar[XB_XSUB(b.x)], 1u);
        const unsigned gen = old / nloc;
        if (old + 1u == (gen + 1u) * nloc) {
            __builtin_amdgcn_fence(__ATOMIC_RELEASE, "agent");
            asm volatile("s_waitcnt vmcnt(0)" ::: "memory");
            const unsigned og = xb_add(&bar[XB_TOP], 1u);
            const unsigned tg = og / nx;
            if (og + 1u == (tg + 1u) * nx) xb_add(&bar[XB_TOPGEN], 1u);
            else XB_SPIN(xb_ld(&bar[XB_TOPGEN]) == tg, bar);
            __builtin_amdgcn_fence(__ATOMIC_ACQUIRE, "agent");
            xb_add(&bar[XB_XGEN(b.x)], 1u);
            asm volatile("s_waitcnt vmcnt(0)" ::: "memory");
        } else {
            XB_SPIN(xb_ld(&bar[XB_XGEN(b.x)]) == gen, bar);
            __builtin_amdgcn_fence(__ATOMIC_ACQUIRE, "agent");
            asm volatile("s_waitcnt vmcnt(0)" ::: "memory");
        }
    }
    __syncthreads();
}

constexpr int cmax(int a, int b) { return a > b ? a : b; }
constexpr int MEGA_LDS = cmax(cmax(pg8::STAGE_BYTES, ATT_LDS), cmax(PE_LDS, cmax(GLA_LDS, FOLD_LDS)));
static_assert(MEGA_LDS + 16 <= WIDTAB_OFF, "the wave-index table must sit behind every phase's LDS image and the barrier words");
__global__ __launch_bounds__(512) void mega(P p) {
  char* lds = (char*)lds_u;
  tidx_init();
  cg::grid_group grid = cg::this_grid();
  const int bid = blockIdx.x, nb = gridDim.x;
  volatile LAS unsigned* xst = (volatile LAS unsigned*)(lds_u + MEGA_LDS);
  { const int t0 = tidx(); if (t0 < 4) xst[t0] = 0u; prep_phase(p, (long)bid * 512 + t0, (long)nb * 512); }
  prep_foldkeys(p, lds, bid, nb);
  grid.sync();
  (void)xcd_barrier_post((unsigned*)(p.ws + OFF_XBAR), xst);
#define GRID_BARRIER() do { XcdBarrier _b; _b.bar = (unsigned*)(p.ws + OFF_XBAR); _b.x = xb_xcc_id(); _b.st = (volatile LAS unsigned*)(lds_u + MEGA_LDS); xcd_barrier(_b); } while (0)
  PG8_LAS unsigned char* glds = (PG8_LAS unsigned char*)lds;
  { EpiG1 e; e.ws = p.ws; run_gemm(glds, (const bfu*)(p.ws + OFF_XB), (const bfu*)(p.ws + OFF_WIN), T, 2048, 1024, e, bid, nb); }
  GRID_BARRIER();
  { EpiG2 e; e.ws = p.ws; run_gemm(glds, (const bfu*)(p.ws + OFF_CQKV), (const bfu*)(p.ws + OFF_WQKV), T, 1792, 384, e, bid, nb); }
  GRID_BARRIER();
#if PROBE == 6
  for (int rep = 0; rep < 3; ++rep) { gla_phase(p, lds, bid, nb); attn_phase(p, lds, bid, nb); GRID_BARRIER(); }
#elif PROBE == 7
  for (int rep = 0; rep < 3; ++rep) { attn_phase(p, lds, bid, nb); GRID_BARRIER(); }
#elif PROBE == 8
  for (int rep = 0; rep < 3; ++rep) { gla_phase(p, lds, bid, nb); GRID_BARRIER(); }
#endif
  gla_phase(p, lds, bid, nb);
  attn_phase(p, lds, bid, nb);
  GRID_BARRIER();
  { EpiG4 e; e.pp = &p; run_gemm(glds, (const bfu*)(p.ws + OFF_MIX), (const bfu*)(p.ws + OFF_WO), T, 1024, 1024, e, bid, nb); }
  GRID_BARRIER();
  { EpiG5 e; e.ws = p.ws; run_gemm(glds, (const bfu*)(p.ws + OFF_HB), (const bfu*)(p.ws + OFF_WPQ), T, 2048, 1024, e, bid, nb); }
  GRID_BARRIER();
#if PROBE == 5
  peer_phase(p, lds, bid, nb);
  GRID_BARRIER();
#endif
  peer_phase(p, lds, bid, nb);
}

extern "C" void kernel_launch(void* const* d_in, const int* in_sizes, int n_in, void* d_out, int out_size, void* d_ws, size_t ws_size,
                              hipStream_t stream) {
  if (ws_size < WS_NEED) { fprintf(stderr, "kernel_launch: ws too small: %zu < %zu\n", ws_size, WS_NEED); return; }
  P p{};
  p.xp = (const float*)d_in[0]; p.xs = (const float*)d_in[1]; p.norm1_g = (const float*)d_in[2]; p.w_in = (const float*)d_in[3];
  p.q_norm_g = (const float*)d_in[4]; p.w_uq = (const float*)d_in[5]; p.kv_norm_g = (const float*)d_in[6]; p.w_ukv = (const float*)d_in[7];
  p.gfw = (const float*)d_in[8]; p.gfb = (const float*)d_in[9]; p.gbw = (const float*)d_in[10]; p.gbb = (const float*)d_in[11];
  p.gla_g = (const float*)d_in[12]; p.w_o = (const float*)d_in[13]; p.norm2_g = (const float*)d_in[14]; p.wq = (const float*)d_in[15];
  p.subk = (const float*)d_in[16]; p.ut = (const float*)d_in[17]; p.vt = (const float*)d_in[18]; p.fin_g = (const float*)d_in[19];
  p.out = (float*)d_out; p.ws = (char*)d_ws;
  for (int i = 0; i < 16; ++i) p.freq[i] = (float)pow(10000.0, -(double)i * 2.0 / 32.0);
  static int grid_blocks = 0;
  if (!grid_blocks) {
    (void)hipFuncSetAttribute((const void*)mega, hipFuncAttributeMaxDynamicSharedMemorySize, LDS_TOTAL);
    int dev = 0, cus = 0, per_cu = 0;
    (void)hipGetDevice(&dev);
    (void)hipDeviceGetAttribute(&cus, hipDeviceAttributeMultiprocessorCount, dev);
    (void)hipOccupancyMaxActiveBlocksPerMultiprocessor(&per_cu, mega, 512, LDS_TOTAL);
    if (per_cu > 1) per_cu = 1;
    grid_blocks = cus * per_cu;
    if (grid_blocks <= 0) { fprintf(stderr, "kernel_launch: occupancy query gave %d x %d\n", cus, per_cu); grid_blocks = 0; return; }
  }
  void* args[] = {&p};
  hipError_t e = hipLaunchCooperativeKernel((void*)mega, dim3(grid_blocks), dim3(512), args, LDS_TOTAL, stream);
  if (e != hipSuccess) fprintf(stderr, "cooperative launch failed: %s (grid %d)\n", hipGetErrorString(e), grid_blocks);
}
```

```cpp
#include <hip/hip_runtime.h>
#include <hip/hip_bf16.h>
#include <hip/hip_fp16.h>
#include <hip/hip_cooperative_groups.h>
namespace cg = cooperative_groups;
#include <cstdio>
#include <cmath>

#define PROBE 0
__device__ __forceinline__ int tidx() { int t = (int)threadIdx.x; asm volatile("" : "+v"(t)); return t; }
constexpr int T = 81920, TP = 65536, DM = 1024, SEQ = 2048, NSEQ = 40;
constexpr int INW = 1984;
constexpr float EPS = 1e-6f;
constexpr float ATT_QSCALE = 0.10206207261596577f * 1.4426950408889634f;
constexpr float PE_SU = 896.f;

typedef unsigned short bfu;
using bf16x8 = __attribute__((ext_vector_type(8))) short;
using f32x4 = __attribute__((ext_vector_type(4))) float;
using f32x16 = __attribute__((ext_vector_type(16))) float;
__device__ __forceinline__ bfu f2bf(float f) { unsigned u = __float_as_uint(f); u += 0x7fffu + ((u >> 16) & 1u); return (bfu)(u >> 16); }
__device__ __forceinline__ float bf2f(bfu h) { return __uint_as_float(((unsigned)h) << 16); }
__device__ __forceinline__ unsigned cvtpk(float lo, float hi) {
  unsigned r; asm volatile("v_cvt_pk_bf16_f32 %0, %1, %2" : "=v"(r) : "v"(lo), "v"(hi)); return r;
}

__device__ __forceinline__ uint4 pack8(const float (&v)[8]) { return make_uint4(cvtpk(v[0], v[1]), cvtpk(v[2], v[3]), cvtpk(v[4], v[5]), cvtpk(v[6], v[7])); }

constexpr size_t al256(size_t x) { return (x + 255) / 256 * 256; }
constexpr size_t OFF_XBAR  = 0;
constexpr size_t OFF_ROPE  = 16384;
constexpr size_t OFF_WIN   = al256(OFF_ROPE + (size_t)2048 * 16 * 8);
constexpr size_t OFF_WQKV  = al256(OFF_WIN + (size_t)2048 * 1024 * 2);
constexpr size_t OFF_WO    = al256(OFF_WQKV + (size_t)1792 * 384 * 2);
constexpr size_t OFF_WPQ   = al256(OFF_WO + (size_t)1024 * 1024 * 2);
constexpr size_t OFF_SK    = al256(OFF_WPQ + (size_t)2048 * 1024 * 2);
constexpr size_t OFF_UT    = al256(OFF_SK + (size_t)2048 * 128 * 2);
constexpr size_t OFF_VT    = al256(OFF_UT + (size_t)16384 * 1024);
constexpr size_t OFF_RSTD1 = al256(OFF_VT + (size_t)16384 * 1024);
constexpr size_t OFF_SSQ   = al256(OFF_RSTD1 + (size_t)T * 4);
constexpr size_t OFF_SSKV  = al256(OFF_SSQ + (size_t)T * 4 * 4);
constexpr size_t OFF_SS2   = al256(OFF_SSKV + (size_t)T * 4 * 4);
constexpr size_t OFF_XB    = al256(OFF_SS2 + (size_t)T * 16 * 4);
constexpr size_t OFF_KR    = al256(OFF_XB + (size_t)T * 1024 * 2);
constexpr size_t OFF_GQ    = al256(OFF_KR + (size_t)T * 32 * 2);
constexpr size_t OFF_GK    = al256(OFF_GQ + (size_t)T * 256 * 2);
constexpr size_t OFF_GV    = al256(OFF_GK + (size_t)T * 256 * 2);
constexpr size_t OFF_GLR   = al256(OFF_GV + (size_t)T * 512 * 2);
constexpr size_t OFF_GOUT  = al256(OFF_GLR + (size_t)T * 32 * 4);
constexpr size_t OFF_QF    = al256(OFF_GOUT + (size_t)T * 512 * 2);
constexpr size_t OFF_KV    = al256(OFF_QF + (size_t)T * 768 * 2);
constexpr size_t OFF_MIX   = al256(OFF_KV + (size_t)T * 1024 * 2);
constexpr size_t OFF_CQKV  = al256(OFF_MIX + (size_t)T * 1024 * 2);
constexpr size_t OFF_OTMP  = OFF_CQKV;
constexpr size_t WS_NEED   = al256(OFF_OTMP + (size_t)T * 512 * 2);
constexpr size_t OFF_HB    = OFF_XB;
constexpr size_t OFF_PQ    = OFF_KR;
static_assert(OFF_PQ + (size_t)T * 2048 * 2 <= OFF_MIX, "PQ alias overlaps live data");
static_assert(WS_NEED <= (size_t)1073741824, "workspace budget");

struct P {
  const float *xp, *xs, *norm1_g, *w_in, *q_norm_g, *w_uq, *kv_norm_g, *w_ukv, *gfw, *gfb, *gbw, *gbb, *gla_g, *w_o, *norm2_g, *wq,
      *subk, *ut, *vt, *fin_g;
  float* out;
  char* ws;
  float freq[16];
};
__device__ __forceinline__ const float* xrow(const P& p, int t) { return t < TP ? p.xp + (size_t)t * DM : p.xs + (size_t)(t - TP) * DM; }

__device__ __forceinline__ float wave_sum(float v) {
  for (int o = 32; o > 0; o >>= 1) v += __shfl_xor(v, o);
  return v;
}
__device__ __forceinline__ float wave_max(float v) {
  for (int o = 32; o > 0; o >>= 1) v = fmaxf(v, __shfl_xor(v, o));
  return v;
}
template <int CTRL> __device__ __forceinline__ float dpp_f(float v) {
  return __builtin_bit_cast(float, __builtin_amdgcn_update_dpp(0, __builtin_bit_cast(int, v), CTRL, 0xf, 0xf, true));
}
__device__ __forceinline__ float row16_sum(float v) {
  v += dpp_f<0xB1>(v);
  v += dpp_f<0x4E>(v);
  v += dpp_f<0x141>(v);
  v += dpp_f<0x140>(v);
  return v;
}

__device__ __forceinline__ int win_src_col(int n) {
  if (n < 384) return n;
  if (n < 416) return 384 + (n - 384);
  if (n < 448) return 1440 + (n - 416);
  if (n < 512) return -1;
  if (n < 768) return 416 + (n - 512);
  if (n < 1024) return 672 + (n - 768);
  if (n < 1536) return 928 + (n - 1024);
  return 1472 + (n - 1536);
}
__device__ __forceinline__ void cvt_t8(bfu* dst, const float* src, int K, int ldsrc, int n, int srccol, int k0, const float* gain, float scale) {
  unsigned w[4];
  float v[8];
#pragma unroll
  for (int i = 0; i < 8; ++i) {
    float g = gain ? gain[k0 + i] : 1.f;
    v[i] = (srccol >= 0) ? src[(size_t)(k0 + i) * ldsrc + srccol] * g * scale : 0.f;
  }
#pragma unroll
  for (int i = 0; i < 4; ++i) w[i] = cvtpk(v[2 * i], v[2 * i + 1]);
  *(uint4*)(dst + (size_t)n * K + k0) = make_uint4(w[0], w[1], w[2], w[3]);
}
__device__ __forceinline__ void prep_phase(const P& p, long gtid, long gthreads) {
  if (gtid < 4096) ((unsigned*)(p.ws + OFF_XBAR))[gtid] = 0u;
  for (long i = gtid; i < 2048 * 16; i += gthreads) {
    int pos = (int)(i >> 4), f = (int)(i & 15);
    float ang = (float)pos * p.freq[f];
    double rev = (double)ang * 0.15915494309189535;
    rev -= rint(rev);
    float r = (float)rev;
    float2 cs; cs.x = __builtin_amdgcn_cosf(r); cs.y = __builtin_amdgcn_sinf(r);
    ((float2*)(p.ws + OFF_ROPE))[i] = cs;
  }
  for (long i = gtid; i < 2048L * 128; i += gthreads) {
    int n = (int)(i & 2047), kc = (int)(i >> 11);
    cvt_t8((bfu*)(p.ws + OFF_WIN), p.w_in, 1024, INW, n, win_src_col(n), kc * 8, p.norm1_g, (n >= 512 && n < 768) ? 0.125f : 1.f);
  }
  for (long i = gtid; i < 1792L * 48; i += gthreads) {
    const int n = (int)(i % 1792), k0 = (int)(i / 1792) * 8;
    float v[8];
#pragma unroll
    for (int e = 0; e < 8; ++e) {
      const int k = k0 + e;
      v[e] = (n < 768) ? (k < 256 ? p.w_uq[(size_t)k * 768 + n] * p.q_norm_g[k] : 0.f)
                       : (k >= 256 ? p.w_ukv[(size_t)(k - 256) * 1024 + (n - 768)] * p.kv_norm_g[k - 256] : 0.f);
    }
    *(uint4*)((bfu*)(p.ws + OFF_WQKV) + (size_t)n * 384 + k0) = pack8(v);
  }
  for (long i = gtid; i < 1024L * 128; i += gthreads) {
    int n = (int)(i & 1023), kc = (int)(i >> 10);
    cvt_t8((bfu*)(p.ws + OFF_WO), p.w_o, 1024, 1024, n, n, kc * 8, nullptr, 1.f);
  }
  for (long i0 = gtid; i0 < 2L * 16384 * 1024 / 16; i0 += 2 * gthreads) {
    const long half = 16384L * 1024 / 16;
    float4 a[2][4];
#pragma unroll
    for (int u = 0; u < 2; ++u) { const long i = i0 + u * gthreads; if (i >= 2 * half) continue; const bool isv = i >= half; const long j = isv ? i - half : i;
      const float4* s4 = (const float4*)((isv ? p.vt : p.ut) + j * 16);
#pragma unroll
      for (int q = 0; q < 4; ++q) a[u][q] = s4[q]; }
#pragma unroll
    for (int u = 0; u < 2; ++u) { const long i = i0 + u * gthreads; if (i >= 2 * half) continue; const bool isv = i >= half; const long j = isv ? i - half : i;
      unsigned w[4];
#pragma unroll
      for (int q = 0; q < 4; ++q) {
        const float4 av = a[u][q];
        if (isv) {
          int pk = __builtin_amdgcn_cvt_pk_fp8_f32(av.x * 64.f, av.y * 64.f, 0, false);
          pk = __builtin_amdgcn_cvt_pk_fp8_f32(av.z * 64.f, av.w * 64.f, pk, true);
          w[q] = (unsigned)pk;
        } else {
          const float4 g = *(const float4*)(p.norm2_g + ((j * 16) & 1023) + q * 4);
          const int q0 = (int)fminf(fmaxf(rintf(av.x * g.x * PE_SU), -127.f), 127.f), q1 = (int)fminf(fmaxf(rintf(av.y * g.y * PE_SU), -127.f), 127.f);
          const int q2 = (int)fminf(fmaxf(rintf(av.z * g.z * PE_SU), -127.f), 127.f), q3 = (int)fminf(fmaxf(rintf(av.w * g.w * PE_SU), -127.f), 127.f);
          w[q] = (unsigned)(q0 & 255) | ((unsigned)(q1 & 255) << 8) | ((unsigned)(q2 & 255) << 16) | ((unsigned)(q3 & 255) << 24);
        }
      }
      *(uint4*)(p.ws + (isv ? OFF_VT : OFF_UT) + j * 16) = make_uint4(w[0], w[1], w[2], w[3]); }
  }
  const long gw = gtid >> 6, nw = gthreads >> 6; const int lane = (int)(gtid & 63);
  for (long t = gw; t < T; t += 2 * nw) {
    const long t2 = t + nw; const bool has2 = t2 < T;
    const float4* x = (const float4*)xrow(p, (int)t); const float4* y = (const float4*)xrow(p, (int)(has2 ? t2 : t));
    float4 v[4], w[4]; float ss = 0, s2 = 0;
#pragma unroll
    for (int i = 0; i < 4; ++i) { v[i] = x[lane + 64 * i]; w[i] = y[lane + 64 * i]; }
#pragma unroll
    for (int i = 0; i < 4; ++i) { ss += v[i].x * v[i].x + v[i].y * v[i].y + v[i].z * v[i].z + v[i].w * v[i].w; s2 += w[i].x * w[i].x + w[i].y * w[i].y + w[i].z * w[i].z + w[i].w * w[i].w; }
    ss = wave_sum(ss); s2 = wave_sum(s2);
    if (lane == 0) { ((float*)(p.ws + OFF_RSTD1))[t] = rsqrtf(ss * (1.f / 1024.f) + EPS); if (has2) ((float*)(p.ws + OFF_RSTD1))[t2] = rsqrtf(s2 * (1.f / 1024.f) + EPS); }
    bfu* xb = (bfu*)(p.ws + OFF_XB) + t * 1024; bfu* yb = (bfu*)(p.ws + OFF_XB) + t2 * 1024;
#pragma unroll
    for (int i = 0; i < 4; ++i) *(uint2*)(xb + (lane + 64 * i) * 4) = make_uint2(cvtpk(v[i].x, v[i].y), cvtpk(v[i].z, v[i].w));
    if (has2) {
#pragma unroll
      for (int i = 0; i < 4; ++i) *(uint2*)(yb + (lane + 64 * i) * 4) = make_uint2(cvtpk(w[i].x, w[i].y), cvtpk(w[i].z, w[i].w));
    }
  }
}

constexpr int FOLD_LDS = (128 * 129 + 64 * 128) * 4;
__device__ __forceinline__ void prep_foldkeys(const P& p, char* lds, int bid, int nb) {
  float* sk = (float*)lds; float* wqs = sk + 128 * 129;
  const int tid = tidx(), key = tid & 127, kkg = tid >> 7;
  for (int tile = bid; tile < 256; tile += nb) {
    const int g = tile >> 4, kk0 = (tile & 15) * 64;
    __syncthreads();
#pragma unroll
    for (int i = 0; i < 8; ++i) { const int e = tid + 512 * i, row = e >> 5, c4 = e & 31;
      const float4 v = *(const float4*)(p.subk + ((size_t)(g * 128 + row) * 128 + c4 * 4));
      float* d = sk + row * 129 + c4 * 4; d[0] = v.x; d[1] = v.y; d[2] = v.z; d[3] = v.w; }
#pragma unroll
    for (int i = 0; i < 4; ++i) { const int e = tid + 512 * i, row = e >> 5, c4 = e & 31;
      *(float4*)(wqs + row * 128 + c4 * 4) = *(const float4*)(p.wq + ((size_t)(kk0 + row) * 2048 + g * 128 + c4 * 4)); }
    __syncthreads();
    float acc[16];
#pragma unroll
    for (int i = 0; i < 16; ++i) acc[i] = 0.f;
    for (int d4 = 0; d4 < 32; ++d4) {
      const float a0 = sk[key * 129 + d4 * 4], a1 = sk[key * 129 + d4 * 4 + 1], a2 = sk[key * 129 + d4 * 4 + 2], a3 = sk[key * 129 + d4 * 4 + 3];
#pragma unroll
      for (int i = 0; i < 16; ++i) { const float4 w = *(const float4*)(wqs + (kkg * 16 + i) * 128 + d4 * 4); acc[i] += a0 * w.x + a1 * w.y + a2 * w.z + a3 * w.w; }
    }
    float v[8], w8[8];
#pragma unroll
    for (int i = 0; i < 8; ++i) { v[i] = acc[i] * p.norm2_g[kk0 + kkg * 16 + i]; w8[i] = acc[8 + i] * p.norm2_g[kk0 + kkg * 16 + 8 + i]; }
    uint4* dst = (uint4*)((bfu*)(p.ws + OFF_WPQ) + (size_t)(g * 128 + key) * 1024 + kk0 + kkg * 16);
    dst[0] = pack8(v); dst[1] = pack8(w8);
  }
}

namespace pg8 {
#define PG8_LAS __attribute__((address_space(3)))
typedef unsigned short bf16_t;
typedef short bf16x8 __attribute__((ext_vector_type(8)));
typedef float f32x4 __attribute__((ext_vector_type(4)));
typedef unsigned u32x4 __attribute__((ext_vector_type(4)));
constexpr int BM = 256, BK = 64, HALF = 128, HTB = HALF * BK * 2  , STAGE_BYTES = 8 * HTB, NXCD = 8, WGM = 8;

__host__ __device__ __forceinline__ int lds_byte(int r, int c) { const int st = (r >> 4) * 2 + (c >> 5), rr = r & 15, cc = c & 31, ob = rr * 64 + cc * 2; return st * 1024 + (ob ^ (((ob >> 9) & 1) << 5)); }
__host__ __device__ __forceinline__ void stage_rc(int b, int& R, int& C) { const int st = b / 1024, sb = b % 1024, swz = sb ^ (((sb >> 9) & 1) << 5); R = (st >> 1) * 16 + swz / 64; C = (st & 1) * 32 + (swz % 64) / 2; }
__host__ __device__ __forceinline__ int perm32(int rho) { const int n = rho >> 4, i = rho & 15; return 8 * (i >> 2) + 4 * n + (i & 3); }

struct Unit { int pm, pn; };
struct Gemm { const bf16_t* A; const bf16_t* Bt; int M, N, K; };

struct StaticOrder {
    int nM, nN, nwg, G, c;
    __host__ __device__ void init(int M, int N, int G_, int c_) { nM = M / BM; nN = N / BM; nwg = nM * nN; G = G_; c = c_; }
    __host__ __device__ bool next(int i, Unit& u) const {
        const long L = (long)i * G + c; if (L >= nwg) return false;
        int wgid = (int)L; { const int q = nwg / NXCD, r = nwg % NXCD, xcd = wgid % NXCD, off = wgid / NXCD; wgid = (xcd < r ? xcd * (q + 1) : r * (q + 1) + (xcd - r) * q) + off; }
        const int nig = WGM * nN, gid = wgid / nig, fm = gid * WGM, gsz = (nM - fm) < WGM ? (nM - fm) : WGM;
        u.pm = fm + ((wgid % nig) % gsz); u.pn = (wgid % nig) / gsz; return true;
    }
    __device__ __forceinline__ void a_ready(const Unit&) const {}
    __device__ __forceinline__ void done(const Unit&) const {}
};
template <class Epi, class Sched, bool STAMP = false>
__device__ __forceinline__ void gemm_phase(PG8_LAS unsigned char* lds, const Gemm g, const Sched& S, const Epi& E, unsigned long long* stamps) {
    const int tid = tidx(), wid = __builtin_amdgcn_readfirstlane(tid >> 6), lane = tid & 63, wr = wid >> 2, wc = wid & 3, fr = lane & 15, fq = lane >> 4;
    const int K = g.K, nt = K / BK;
    int ts_lo = 0, ts_hi = 0, nts = 0; const unsigned long long rt_entry = STAMP ? (unsigned long long)wall_clock64() : 0ull;
#define PG8_STAMP() do { if (STAMP && wid == 0 && nts < 64) { const unsigned long long _c = (unsigned long long)clock64(); \
        ts_lo = (lane == nts) ? (int)(unsigned)_c : ts_lo; ts_hi = (lane == nts) ? (int)(unsigned)(_c >> 32) : ts_hi; ++nts; } } while (0)
    PG8_STAMP();
    unsigned voffA[2], voffB[2];
#pragma unroll
    for (int i = 0; i < 2; ++i) { int R, C; stage_rc(tid * 16 + i * 8192, R, C); const int Rb = Epi::PERM ? ((R & ~31) + perm32(R & 31)) : R;
        voffA[i] = (unsigned)(R * K + C) * 2u; voffB[i] = (unsigned)(Rb * K + C) * 2u; }
    const size_t kstep = (size_t)(BK * 2);
    const size_t hstep = (size_t)HALF * K * 2;
    const size_t tstep = 2 * hstep;
    const unsigned ldsw = (unsigned)wid * 1024u;
    const int aoff = lds_byte(wr * 64 + fr, fq * 8), boff = lds_byte(wc * 32 + fr, fq * 8);
#define PG8_SA(b, h) (((b) * 2 + (h)) * HTB)
#define PG8_SB(b, h) ((4 + (b) * 2 + (h)) * HTB)
#define PG8_STAGE(bufoff, gbase, voff) do { _Pragma("unroll") for (int _i = 0; _i < 2; ++_i) \
        __builtin_amdgcn_global_load_lds((const unsigned*)((const char*)(gbase) + (voff)[_i]), (PG8_LAS unsigned*)(lds + (bufoff) + ldsw + _i * 8192), 16, 0, 0); } while (0)
#define PG8_LDA(dst, b, h) do { _Pragma("unroll") for (int m = 0; m < 4; ++m) _Pragma("unroll") for (int k = 0; k < 2; ++k) dst[m][k] = *(const PG8_LAS bf16x8*)(lds + PG8_SA(b, h) + aoff + m * 2048 + k * 1024); } while (0)
#define PG8_LDB(dst, b, h) do { _Pragma("unroll") for (int n = 0; n < 2; ++n) _Pragma("unroll") for (int k = 0; k < 2; ++k) dst[n][k] = *(const PG8_LAS bf16x8*)(lds + PG8_SB(b, h) + boff + n * 2048 + k * 1024); } while (0)
#define PG8_MMA(ai, bj, At, Bt) do { __builtin_amdgcn_s_setprio(1); _Pragma("unroll") for (int m = 0; m < 4; ++m) _Pragma("unroll") for (int n = 0; n < 2; ++n) _Pragma("unroll") for (int k = 0; k < 2; ++k) \
        acc[ai][bj][m][n] = __builtin_amdgcn_mfma_f32_16x16x32_bf16(Bt[n][k], At[m][k], acc[ai][bj][m][n], 0, 0, 0); __builtin_amdgcn_s_setprio(0); } while (0)
#define PG8_WAIT_V(n) asm volatile("s_waitcnt vmcnt(" #n ")" ::: "memory")
#define PG8_WAIT_L(n) asm volatile("s_waitcnt lgkmcnt(" #n ")" ::: "memory")
#define PG8_BAR __builtin_amdgcn_s_barrier()
#define PG8_SCHED __builtin_amdgcn_sched_barrier(0)
    Unit cur, nxt; int ui = 0;
    if (!S.next(0, cur)) return;
    f32x4 acc[2][2][4][2];
#pragma unroll
    for (int a = 0; a < 2; ++a)
#pragma unroll
        for (int b = 0; b < 2; ++b)
#pragma unroll
            for (int m = 0; m < 4; ++m)
#pragma unroll
                for (int n = 0; n < 2; ++n) acc[a][b][m][n] = (f32x4){0.f, 0.f, 0.f, 0.f};
    bf16x8 At[4][2], B0[2][2], B1[2][2];
    const char* cA = (const char*)g.A + (size_t)cur.pm * tstep; const char* cB = (const char*)g.Bt + (size_t)cur.pn * tstep;
    S.a_ready(cur);
    PG8_STAGE(PG8_SB(0, 0), cB, voffB); PG8_STAGE(PG8_SA(0, 0), cA, voffA); PG8_STAGE(PG8_SB(0, 1), cB + hstep, voffB); PG8_STAGE(PG8_SA(0, 1), cA + hstep, voffA);
    if (wr == 1) PG8_BAR;
    PG8_WAIT_V(4); PG8_BAR;
    PG8_STAGE(PG8_SB(1, 0), cB + kstep, voffB); PG8_STAGE(PG8_SA(1, 0), cA + kstep, voffA); PG8_STAGE(PG8_SB(1, 1), cB + hstep + kstep, voffB);
    PG8_WAIT_V(6); PG8_BAR;
    PG8_STAMP();
    for (;;) {
        const bool has_next = S.next(ui + 1, nxt);
        const char* nA = has_next ? (const char*)g.A + (size_t)nxt.pm * tstep : cA; const char* nB = has_next ? (const char*)g.Bt + (size_t)nxt.pn * tstep : cB;
        for (int t = 0; t < nt; t += 2) {
            const bool last = (t == nt - 2);
            const char* a1 = cA + (size_t)(t + 1) * kstep;
            const char* a2 = last ? nA : cA + (size_t)(t + 2) * kstep; const char* b2 = last ? nB : cB + (size_t)(t + 2) * kstep;
            const char* a3 = a2 + kstep; const char* b3 = b2 + kstep;
            if (last && has_next) S.a_ready(nxt);
            PG8_LDB(B0, 0, 0); PG8_SCHED; PG8_LDA(At, 0, 0); PG8_STAGE(PG8_SA(1, 1), a1 + hstep, voffA);
            PG8_WAIT_L(8); PG8_BAR; PG8_WAIT_L(0); PG8_MMA(0, 0, At, B0); PG8_BAR; PG8_SCHED;
            PG8_LDB(B1, 0, 1); PG8_STAGE(PG8_SB(0, 0), b2, voffB);
            PG8_BAR; PG8_WAIT_L(0); PG8_MMA(0, 1, At, B1); PG8_BAR;
            PG8_LDA(At, 0, 1); PG8_STAGE(PG8_SA(0, 0), a2, voffA);
            PG8_BAR; PG8_WAIT_L(0); PG8_MMA(1, 0, At, B0); PG8_BAR; PG8_SCHED;
            PG8_STAGE(PG8_SB(0, 1), b2 + hstep, voffB);
            PG8_WAIT_V(6); PG8_BAR; PG8_MMA(1, 1, At, B1); PG8_BAR;
            PG8_LDB(B0, 1, 0); PG8_SCHED; PG8_LDA(At, 1, 0); PG8_STAGE(PG8_SA(0, 1), a2 + hstep, voffA);
            PG8_WAIT_L(8); PG8_BAR; PG8_WAIT_L(0); PG8_MMA(0, 0, At, B0); PG8_BAR; PG8_SCHED;
            PG8_LDB(B1, 1, 1); PG8_STAGE(PG8_SB(1, 0), b3, voffB);
            PG8_BAR; PG8_WAIT_L(0); PG8_MMA(0, 1, At, B1); PG8_BAR;
            PG8_LDA(At, 1, 1); PG8_STAGE(PG8_SA(1, 0), a3, voffA);
            PG8_BAR; PG8_WAIT_L(0); PG8_MMA(1, 0, At, B0); PG8_BAR; PG8_SCHED;
            PG8_STAGE(PG8_SB(1, 1), b3 + hstep, voffB);
            PG8_WAIT_V(6); PG8_BAR; PG8_MMA(1, 1, At, B1); PG8_BAR;
        }
        PG8_STAMP();
        if constexpr (!Epi::AFTER_DRAIN) { E(acc, cur, wr, wc, fr, fq); S.done(cur); }
        PG8_STAMP();
        if (!has_next) break;
#pragma unroll
        for (int a = 0; a < 2; ++a)
#pragma unroll
            for (int b = 0; b < 2; ++b)
#pragma unroll
                for (int m = 0; m < 4; ++m)
#pragma unroll
                    for (int n = 0; n < 2; ++n) acc[a][b][m][n] = (f32x4){0.f, 0.f, 0.f, 0.f};
        cur = nxt; cA = nA; cB = nB; ++ui;
    }
    PG8_WAIT_V(0);
    if (wr == 0) PG8_BAR;
    PG8_BAR;
    if constexpr (Epi::AFTER_DRAIN) { E.fused(acc, cur, wr, wc, fr, fq, lds, wid, lane); S.done(cur); }
    PG8_STAMP();
    if (STAMP && wid == 0) { stamps[lane] = lane < nts ? (((unsigned long long)(unsigned)ts_hi << 32) | (unsigned)ts_lo) : 0ull;
        if (lane == 62) stamps[62] = rt_entry; if (lane == 63) stamps[63] = (unsigned long long)wall_clock64(); }
#undef PG8_STAMP
#undef PG8_SA
#undef PG8_SB
#undef PG8_STAGE
#undef PG8_LDA
#undef PG8_LDB
#undef PG8_MMA
#undef PG8_WAIT_V
#undef PG8_WAIT_L
#undef PG8_BAR
#undef PG8_SCHED
}
}
__device__ __forceinline__ float x4sum(float v) {
  auto r1 = __builtin_amdgcn_permlane16_swap(__float_as_uint(v), __float_as_uint(v), false, false);
  const float s = __uint_as_float(r1[0]) + __uint_as_float(r1[1]);
  auto r2 = __builtin_amdgcn_permlane32_swap(__float_as_uint(s), __float_as_uint(s), false, false);
  return __uint_as_float(r2[0]) + __uint_as_float(r2[1]);
}
__device__ __forceinline__ float other32(float v, bool upper) {
  auto rr = __builtin_amdgcn_permlane32_swap(__float_as_uint(v), __float_as_uint(v), false, false);
  return __uint_as_float(upper ? rr[0] : rr[1]);
}
__device__ __forceinline__ void rope8(float (&v)[8], const float2* rope, int pos, int fq) {
  const bool upper = fq >= 2;
  const float4* cs4 = (const float4*)(rope + pos * 16 + (fq & 1) * 8);
#pragma unroll
  for (int q = 0; q < 4; ++q) {
    const float4 c2 = cs4[q];
    const float o0 = other32(v[2 * q], upper), o1 = other32(v[2 * q + 1], upper);
    v[2 * q] = upper ? (v[2 * q] * c2.x + o0 * c2.y) : (v[2 * q] * c2.x - o0 * c2.y);
    v[2 * q + 1] = upper ? (v[2 * q + 1] * c2.z + o1 * c2.w) : (v[2 * q + 1] * c2.z - o1 * c2.w);
  }
}
typedef unsigned ntu4 __attribute__((ext_vector_type(4)));
__device__ __forceinline__ void st_nt(void* d, const uint4 v) { const ntu4 w = {v.x, v.y, v.z, v.w}; __builtin_nontemporal_store(w, (ntu4*)d); }
struct EpiG1 {
  static constexpr bool PERM = true, AFTER_DRAIN = false;
  char* ws;
  __device__ __forceinline__ void operator()(const pg8::f32x4 (&acc)[2][2][4][2], const pg8::Unit& u, int wr, int wc, int fr, int fq) const {
    const float* rstd1 = (const float*)(ws + OFF_RSTD1);
    const int pn = u.pn, colh = wc * 32 + fq * 8;
    float rs8[8];
#pragma unroll
    for (int i = 0; i < 8; ++i) rs8[i] = rstd1[u.pm * 256 + (i >> 2) * 128 + wr * 64 + (i & 3) * 16 + fr];
#pragma unroll
    for (int ai = 0; ai < 2; ++ai)
#pragma unroll
      for (int m = 0; m < 4; ++m) {
        __builtin_amdgcn_sched_barrier(0);
        const int r = u.pm * 256 + ai * 128 + wr * 64 + m * 16 + fr;
        const float rs = rs8[ai * 4 + m];
        float ss = 0.f;
#pragma unroll
        for (int bj = 0; bj < 2; ++bj) {
          float v[8];
#pragma unroll
          for (int e = 0; e < 4; ++e) { v[e] = acc[ai][bj][m][0][e] * rs; v[4 + e] = acc[ai][bj][m][1][e] * rs; }
          if (pn == 1 && bj == 1) {
            if (wc == 0) { rope8(v, (const float2*)(ws + OFF_ROPE), r & (SEQ - 1), fq); *(uint4*)((bfu*)(ws + OFF_KR) + (size_t)r * 32 + fq * 8) = pack8(v); }
            else if (wc == 1) { float4* g = (float4*)((float*)(ws + OFF_GLR) + (size_t)r * 32 + fq * 8); g[0] = make_float4(v[0], v[1], v[2], v[3]); g[1] = make_float4(v[4], v[5], v[6], v[7]); }
          } else {
            unsigned base, ld, cb;
            if (pn == 0) { base = (unsigned)OFF_CQKV; ld = 384; cb = bj * 128; }
            else if (pn == 1) { base = (unsigned)OFF_CQKV; ld = 384; cb = 256; }
            else if (pn == 2) { base = (unsigned)OFF_GQ; ld = 256; cb = bj * 128; }
            else if (pn == 3) { base = (unsigned)OFF_GK; ld = 256; cb = bj * 128; }
            else if (pn < 6) { base = (unsigned)OFF_GV; ld = 512; cb = (pn - 4) * 256 + bj * 128; }
            else { base = (unsigned)OFF_GOUT; ld = 512; cb = (pn - 6) * 256 + bj * 128; }
            st_nt(ws + (base + ((unsigned)r * ld + cb + (unsigned)colh) * 2u), pack8(v));
#pragma unroll
            for (int e = 0; e < 8; ++e) ss += v[e] * v[e];
          }
        }
        if (pn <= 1) {
          ss = x4sum(ss);
          if (fq == 0) ((float*)(ws + (pn == 0 ? OFF_SSQ : OFF_SSKV)))[(size_t)r * 4 + wc] = ss;
        }
      }
  }
};
struct EpiG2 {
  static constexpr bool PERM = true, AFTER_DRAIN = false;
  char* ws;
  __device__ __forceinline__ void operator()(const pg8::f32x4 (&acc)[2][2][4][2], const pg8::Unit& u, int wr, int wc, int fr, int fq) const {
    const int pn = u.pn;
    float rs8[8];
    {
      float4 s8[8];
#pragma unroll
      for (int i = 0; i < 8; ++i) s8[i] = ((const float4*)(ws + (pn < 3 ? OFF_SSQ : OFF_SSKV)))[u.pm * 256 + (i >> 2) * 128 + wr * 64 + (i & 3) * 16 + fr];
#pragma unroll
      for (int i = 0; i < 8; ++i) rs8[i] = rsqrtf((s8[i].x + s8[i].y + s8[i].z + s8[i].w) * (pn < 3 ? (1.f / 256.f) : (1.f / 128.f)) + EPS);
    }
#pragma unroll
    for (int ai = 0; ai < 2; ++ai)
#pragma unroll
      for (int m = 0; m < 4; ++m) {
        __builtin_amdgcn_sched_barrier(0);
        const int r = u.pm * 256 + ai * 128 + wr * 64 + m * 16 + fr;
        const float rs = rs8[ai * 4 + m];
#pragma unroll
        for (int bj = 0; bj < 2; ++bj) {
          float v[8];
#pragma unroll
          for (int e = 0; e < 4; ++e) { v[e] = acc[ai][bj][m][0][e] * rs; v[4 + e] = acc[ai][bj][m][1][e] * rs; }
          if (pn < 3) {
            const int g0 = pn * 256 + bj * 128 + wc * 32;
#pragma unroll
            for (int e = 0; e < 8; ++e) v[e] *= ATT_QSCALE;
            if (g0 % 96 == 64) rope8(v, (const float2*)(ws + OFF_ROPE), r & (SEQ - 1), fq);
            st_nt((bfu*)(ws + OFF_QF) + (size_t)r * 768 + g0 + fq * 8, pack8(v));
          } else {
            st_nt((bfu*)(ws + OFF_KV) + (size_t)r * 1024 + (pn - 3) * 256 + bj * 128 + wc * 32 + fq * 8, pack8(v));
          }
        }
      }
  }
};
struct EpiG4 {
  static constexpr bool PERM = true, AFTER_DRAIN = false;
  const P* pp;
  __device__ __forceinline__ void operator()(const pg8::f32x4 (&acc)[2][2][4][2], const pg8::Unit& u, int wr, int wc, int fr, int fq) const {
    const P& p = *pp;
    pg8::u32x4 xin[8];
#define G4_LOADX(IT) _Pragma("unroll") for (int bj = 0; bj < 2; ++bj) \
      xin[((IT) & 3) * 2 + bj] = *(const pg8::u32x4*)(p.ws + ((unsigned)OFF_HB + ((unsigned)(u.pm * 256 + ((IT) >> 2) * 128 + wr * 64 + ((IT) & 3) * 16 + fr) * 1024u + (unsigned)(u.pn * 256 + bj * 128 + wc * 32 + fq * 8)) * 2u));
    G4_LOADX(0) G4_LOADX(1) G4_LOADX(2) G4_LOADX(3)
#pragma unroll
    for (int ai = 0; ai < 2; ++ai) {
#pragma unroll
      for (int m = 0; m < 4; ++m) {
        __builtin_amdgcn_sched_barrier(0);
        const int r = u.pm * 256 + ai * 128 + wr * 64 + m * 16 + fr;
        float ss = 0.f;
#pragma unroll
        for (int bj = 0; bj < 2; ++bj) {
          const int c = u.pn * 256 + bj * 128 + wc * 32 + fq * 8;
          uint4* hx = (uint4*)(p.ws + ((unsigned)OFF_HB + ((unsigned)r * 1024u + (unsigned)c) * 2u));
          const pg8::u32x4 xw = xin[((ai * 4 + m) & 3) * 2 + bj]; const unsigned xs[4] = {xw[0], xw[1], xw[2], xw[3]};
          float v[8];
#pragma unroll
          for (int e = 0; e < 4; ++e) { v[2 * e] = __uint_as_float(xs[e] << 16) + acc[ai][bj][m][e >> 1][(2 * e) & 3]; v[2 * e + 1] = __uint_as_float(xs[e] & 0xffff0000u) + acc[ai][bj][m][e >> 1][(2 * e + 1) & 3]; }
          *hx = pack8(v);
#pragma unroll
          for (int e = 0; e < 8; ++e) ss += v[e] * v[e];
        }
        ss = x4sum(ss);
        if (fq == 0) ((float*)(p.ws + OFF_SS2))[(size_t)r * 16 + u.pn * 4 + wc] = ss;
        if (ai == 0) { G4_LOADX(4 + m) }
      }
    }
#undef G4_LOADX
  }
};
__device__ __forceinline__ unsigned pkf16(float a, float b) { typedef _Float16 hh2 __attribute__((ext_vector_type(2))); const hh2 h = {(_Float16)a, (_Float16)b}; return __builtin_bit_cast(unsigned, h); }
struct EpiG5 {
  static constexpr bool PERM = true, AFTER_DRAIN = false;
  char* ws;
  __device__ __forceinline__ void operator()(const pg8::f32x4 (&acc)[2][2][4][2], const pg8::Unit& u, int wr, int wc, int fr, int fq) const {
#pragma unroll
    for (int ai = 0; ai < 2; ++ai)
#pragma unroll
      for (int m = 0; m < 4; ++m) {
        const int r = u.pm * 256 + ai * 128 + wr * 64 + m * 16 + fr;
#pragma unroll
        for (int bj = 0; bj < 2; ++bj) {
          float v[8];
#pragma unroll
          for (int e = 0; e < 4; ++e) { v[e] = acc[ai][bj][m][0][e]; v[4 + e] = acc[ai][bj][m][1][e]; }
          st_nt(ws + ((unsigned)OFF_PQ + ((unsigned)r * 2048u + (unsigned)(u.pn * 256 + bj * 128 + wc * 32 + fq * 8)) * 2u), make_uint4(pkf16(v[0], v[1]), pkf16(v[2], v[3]), pkf16(v[4], v[5]), pkf16(v[6], v[7])));
        }
      }
  }
};
template <class Epi>
__device__ __forceinline__ void run_gemm(PG8_LAS unsigned char* lds, const bfu* A, const bfu* Bt, int M, int N, int K, const Epi& E, int bid, int nb) {
  asm volatile("" : "+s"(K));
  pg8::Gemm g; g.A = A; g.Bt = Bt; g.M = M; g.N = N; g.K = K;
  pg8::StaticOrder S; S.init(M, N, nb, bid);
  pg8::gemm_phase<Epi, pg8::StaticOrder, false>(lds, g, S, E, nullptr);
}

using s16x4  = __attribute__((ext_vector_type(4))) short;
using u32x4  = __attribute__((ext_vector_type(4))) unsigned;
constexpr float ATT_SCALE = 0.10206207261596577f;
constexpr float ATT_THR = 8.f;
constexpr int ATT_SHM_V = 64 * 64 * 2, ATT_SHM_K = 64 * 256, ATT_LDS = 2 * ATT_SHM_V + 2 * ATT_SHM_K + 8 * 64 * 4;
#define KSWZ(row, colB) ((row) * 256 + ((colB) ^ (((row) & 7) << 4)))
#define SBAR() __builtin_amdgcn_sched_barrier(0)
__device__ __forceinline__ int crow(int r, int hi) { return (r & 3) + 8 * (r >> 2) + 4 * hi; }
__device__ __forceinline__ void att_partialSM(f32x16& p0, f32x16& p1, float& m_run, float& alpha, bool first) {
  constexpr float THR2 = ATT_THR * 1.4426950408889634f;
  float pmax = fmaxf(fmaxf(p0[0], p0[1]), p0[2]);
#pragma unroll
  for (int r = 3; r < 15; r += 2) pmax = fmaxf(fmaxf(pmax, p0[r]), p0[r + 1]);
  pmax = fmaxf(pmax, p0[15]);
#pragma unroll
  for (int r = 0; r < 16; r += 2) pmax = fmaxf(fmaxf(pmax, p1[r]), p1[r + 1]);
  { auto rr = __builtin_amdgcn_permlane32_swap(__float_as_uint(pmax), __float_as_uint(pmax), false, false);
    pmax = fmaxf(__uint_as_float(rr[0]), __uint_as_float(rr[1])); }
  if (__builtin_expect(!first && __all(pmax <= THR2), 1)) { alpha = 1.f; }
  else {
    const float dlt = first ? pmax : fmaxf(pmax, 0.f);
    alpha = first ? 1.f : __builtin_amdgcn_exp2f(-dlt); m_run += dlt;
#pragma unroll
    for (int r = 0; r < 16; ++r) { p0[r] -= dlt; p1[r] -= dlt; }
  }
#pragma unroll
  for (int r = 0; r < 16; ++r) p0[r] = __builtin_amdgcn_exp2f(p0[r]);
}
__device__ __forceinline__ void att_finishSM(f32x16& p0, f32x16& p1, float alpha, float& l_reg, bf16x8& pa0, bf16x8& pa1, bf16x8& pa2, bf16x8& pa3) {
#pragma unroll
  for (int r = 0; r < 16; ++r) p1[r] = __builtin_amdgcn_exp2f(p1[r]);
  float ps = 0;
#pragma unroll
  for (int r = 0; r < 16; ++r) ps += p0[r];
#pragma unroll
  for (int r = 0; r < 16; ++r) ps += p1[r];
  { auto rr = __builtin_amdgcn_permlane32_swap(__float_as_uint(ps), __float_as_uint(ps), false, false);
    ps = __uint_as_float(rr[0]) + __uint_as_float(rr[1]); }
  l_reg = l_reg * alpha + ps;
#define PK4(PP, BASE, OUT) do { unsigned a0 = cvtpk(PP[BASE + 0], PP[BASE + 1]), a1 = cvtpk(PP[BASE + 2], PP[BASE + 3]);   \
    unsigned b0 = cvtpk(PP[BASE + 4], PP[BASE + 5]), b1 = cvtpk(PP[BASE + 6], PP[BASE + 7]);                              \
    auto r0 = __builtin_amdgcn_permlane32_swap(a0, b0, false, false); auto r1 = __builtin_amdgcn_permlane32_swap(a1, b1, false, false); \
    u32x4 w = {r0[0], r1[0], r0[1], r1[1]}; OUT = *reinterpret_cast<bf16x8*>(&w); } while (0)
  PK4(p0, 0, pa0); PK4(p0, 8, pa1); PK4(p1, 0, pa2); PK4(p1, 8, pa3);
#undef PK4
}
__device__ __forceinline__ void att_qkt(f32x16& p0, f32x16& p1, const char* Ks, const bf16x8* qr, int r32, int hi, float init) {
#pragma unroll
  for (int r = 0; r < 16; ++r) { p0[r] = init; p1[r] = init; }
#pragma unroll
  for (int d0 = 0; d0 < 6; ++d0) { int cb = (d0 * 16 + hi * 8) * 2;
    bf16x8 b0 = *reinterpret_cast<const bf16x8*>(Ks + KSWZ(r32, cb));
    bf16x8 b1 = *reinterpret_cast<const bf16x8*>(Ks + KSWZ(32 + r32, cb));
    p0 = __builtin_amdgcn_mfma_f32_32x32x16_bf16(b0, qr[d0], p0, 0, 0, 0);
    p1 = __builtin_amdgcn_mfma_f32_32x32x16_bf16(b1, qr[d0], p1, 0, 0, 0); }
}
__device__ __forceinline__ int att_v_st(int k, int c) { const int kk = (k & ~0xC) | ((k & 4) << 1) | ((k & 8) >> 1); return ((kk >> 3) * 2 + (c >> 5)) * 512 + ((kk & 7) * 32 + (c & 31)) * 2; }
__device__ __forceinline__ int att_v_rd_base(int lane) { return ((lane & 3) << 3) | (((lane >> 2) & 3) << 6) | (((lane >> 4) & 1) << 5) | (((lane >> 5) & 1) << 8); }
constexpr int att_v_rd_off(int d0, int ks, int half) { return d0 * 512 + ks * 2048 + half * 1024; }
template <int OFF> __device__ __forceinline__ s16x4 att_tr_read(int vb) {
  s16x4 r; asm volatile("ds_read_b64_tr_b16 %0, %1 offset:%2" : "=&v"(r) : "v"(vb), "i"(OFF) : "memory"); return r;
}
template <int D0> __device__ __forceinline__ void att_pv_one(f32x16& od, int vb, bf16x8 pa0, bf16x8 pa1, bf16x8 pa2, bf16x8 pa3) {
  const s16x4 l0 = att_tr_read<att_v_rd_off(D0, 0, 0)>(vb), h0 = att_tr_read<att_v_rd_off(D0, 0, 1)>(vb), l1 = att_tr_read<att_v_rd_off(D0, 1, 0)>(vb), h1 = att_tr_read<att_v_rd_off(D0, 1, 1)>(vb);
  const s16x4 l2 = att_tr_read<att_v_rd_off(D0, 2, 0)>(vb), h2 = att_tr_read<att_v_rd_off(D0, 2, 1)>(vb), l3 = att_tr_read<att_v_rd_off(D0, 3, 0)>(vb), h3 = att_tr_read<att_v_rd_off(D0, 3, 1)>(vb);
  asm volatile("s_waitcnt lgkmcnt(0)" ::: "memory"); SBAR();
#define PK(L, H) (bf16x8){L[0], L[1], L[2], L[3], H[0], H[1], H[2], H[3]}
  od = __builtin_amdgcn_mfma_f32_32x32x16_bf16(pa0, PK(l0, h0), od, 0, 0, 0);
  od = __builtin_amdgcn_mfma_f32_32x32x16_bf16(pa1, PK(l1, h1), od, 0, 0, 0);
  od = __builtin_amdgcn_mfma_f32_32x32x16_bf16(pa2, PK(l2, h2), od, 0, 0, 0);
  od = __builtin_amdgcn_mfma_f32_32x32x16_bf16(pa3, PK(l3, h3), od, 0, 0, 0);
#undef PK
}
__device__ __forceinline__ void att_pv_both(f32x16& o0, f32x16& o1, int vb, bf16x8 pa0, bf16x8 pa1, bf16x8 pa2, bf16x8 pa3) {
  const s16x4 al0 = att_tr_read<att_v_rd_off(0, 0, 0)>(vb), ah0 = att_tr_read<att_v_rd_off(0, 0, 1)>(vb), bl0 = att_tr_read<att_v_rd_off(1, 0, 0)>(vb), bh0 = att_tr_read<att_v_rd_off(1, 0, 1)>(vb);
  const s16x4 al1 = att_tr_read<att_v_rd_off(0, 1, 0)>(vb), ah1 = att_tr_read<att_v_rd_off(0, 1, 1)>(vb), bl1 = att_tr_read<att_v_rd_off(1, 1, 0)>(vb), bh1 = att_tr_read<att_v_rd_off(1, 1, 1)>(vb);
  const s16x4 al2 = att_tr_read<att_v_rd_off(0, 2, 0)>(vb), ah2 = att_tr_read<att_v_rd_off(0, 2, 1)>(vb), bl2 = att_tr_read<att_v_rd_off(1, 2, 0)>(vb), bh2 = att_tr_read<att_v_rd_off(1, 2, 1)>(vb);
  const s16x4 al3 = att_tr_read<att_v_rd_off(0, 3, 0)>(vb), ah3 = att_tr_read<att_v_rd_off(0, 3, 1)>(vb), bl3 = att_tr_read<att_v_rd_off(1, 3, 0)>(vb), bh3 = att_tr_read<att_v_rd_off(1, 3, 1)>(vb);
  asm volatile("s_waitcnt lgkmcnt(0)" ::: "memory"); SBAR();
#define PK(L, H) (bf16x8){L[0], L[1], L[2], L[3], H[0], H[1], H[2], H[3]}
  o0 = __builtin_amdgcn_mfma_f32_32x32x16_bf16(pa0, PK(al0, ah0), o0, 0, 0, 0);
  o1 = __builtin_amdgcn_mfma_f32_32x32x16_bf16(pa0, PK(bl0, bh0), o1, 0, 0, 0);
  o0 = __builtin_amdgcn_mfma_f32_32x32x16_bf16(pa1, PK(al1, ah1), o0, 0, 0, 0);
  o1 = __builtin_amdgcn_mfma_f32_32x32x16_bf16(pa1, PK(bl1, bh1), o1, 0, 0, 0);
  o0 = __builtin_amdgcn_mfma_f32_32x32x16_bf16(pa2, PK(al2, ah2), o0, 0, 0, 0);
  o1 = __builtin_amdgcn_mfma_f32_32x32x16_bf16(pa2, PK(bl2, bh2), o1, 0, 0, 0);
  o0 = __builtin_amdgcn_mfma_f32_32x32x16_bf16(pa3, PK(al3, ah3), o0, 0, 0, 0);
  o1 = __builtin_amdgcn_mfma_f32_32x32x16_bf16(pa3, PK(bl3, bh3), o1, 0, 0, 0);
#undef PK
}
__device__ __forceinline__ void attn_item(const P& p, char* lds, int seq, int h, int qb) {
  const int tid = tidx(), wid = tid >> 6, lane = tid & 63, r32 = lane & 31, hi = lane >> 5;
  char* V_lds = lds; char* K_lds = lds + 2 * ATT_SHM_V;
  float* wsl = (float*)(lds + 2 * ATT_SHM_V + 2 * ATT_SHM_K) + wid * 64; float* li_l = wsl; float* al_l = wsl + 32;
  const size_t tb = (size_t)seq * SEQ;
  const bfu* QF = (const bfu*)(p.ws + OFF_QF); const bfu* KVg = (const bfu*)(p.ws + OFF_KV) + tb * 1024 + h * 128; const bfu* KRg = (const bfu*)(p.ws + OFF_KR) + tb * 32;
  float m_run = 0.f, l_reg = 0; f32x16 o[2] = {}; bf16x8 qr[6];
  const bfu* Qw = QF + (tb + qb * 256 + wid * 32 + r32) * 768 + h * 96 + hi * 8;
#pragma unroll
  for (int d0 = 0; d0 < 6; ++d0) qr[d0] = *reinterpret_cast<const bf16x8*>(Qw + d0 * 16);
  const int sk = tid >> 3, sch = tid & 7, rk = (tid >> 2) & 63, rch = tid & 3;
  const int vst = att_v_st(sk, sch * 8), kst = KSWZ(sk, sch * 16), rst = KSWZ(rk, 128 + rch * 16);
  const int vb0 = (int)(uintptr_t)V_lds + att_v_rd_base(lane);
  struct { bf16x8 v, k, r; } sr_[2];
#define SLOAD(i, k0) do { sr_[i].v = *reinterpret_cast<const bf16x8*>(KVg + (size_t)((k0) + sk) * 1024 + 64 + sch * 8); \
    sr_[i].k = *reinterpret_cast<const bf16x8*>(KVg + (size_t)((k0) + sk) * 1024 + sch * 8);                              \
    if (tid < 256) sr_[i].r = *reinterpret_cast<const bf16x8*>(KRg + (size_t)((k0) + rk) * 32 + rch * 8); } while (0)
#define SWRITE(b, i) do { *(bf16x8*)(V_lds + (b) * ATT_SHM_V + vst) = sr_[i].v; *(bf16x8*)(K_lds + (b) * ATT_SHM_K + kst) = sr_[i].k; \
    if (tid < 256) *(bf16x8*)(K_lds + (b) * ATT_SHM_K + rst) = sr_[i].r; } while (0)
#define RESC(a) do { if (__any((a) < 1.f)) { if (hi == 0) al_l[r32] = (a); asm volatile("s_waitcnt lgkmcnt(0)" ::: "memory"); \
    for (int d = 0; d < 2; ++d) for (int r = 0; r < 16; ++r) o[d][r] *= al_l[crow(r, hi)]; } } while (0)
  f32x16 pA0, pA1, pB0, pB1; float alA, alB; bf16x8 pa0, pa1, pa2, pa3; constexpr int NT = SEQ / 64;
  constexpr int SE = 0, SO = 1;
  __syncthreads();
  SLOAD(SE, 0); asm volatile("s_waitcnt vmcnt(0)" ::: "memory"); SWRITE(0, SE); __syncthreads();
  att_qkt(pA0, pA1, K_lds, qr, r32, hi, 0.f); att_partialSM(pA0, pA1, m_run, alA, true);
  SLOAD(SO, 64); SLOAD(SE, 128);
  asm volatile("s_waitcnt vmcnt(3)" ::: "memory"); SWRITE(1, SO); __syncthreads();
  for (int j = 1; j + 1 < NT; j += 2) {
    SBAR(); att_qkt(pB0, pB1, K_lds + ATT_SHM_K, qr, r32, hi, -m_run);
    att_finishSM(pA0, pA1, alA, l_reg, pa0, pa1, pa2, pa3); SBAR();
    SLOAD(SO, (j + 2) * 64); SBAR();
    att_pv_both(o[0], o[1], vb0, pa0, pa1, pa2, pa3); att_partialSM(pB0, pB1, m_run, alB, false);
    __syncthreads(); asm volatile("s_waitcnt vmcnt(3)" ::: "memory"); SWRITE(0, SE);
    RESC(alB); __syncthreads();
    SBAR(); att_qkt(pA0, pA1, K_lds, qr, r32, hi, -m_run);
    att_finishSM(pB0, pB1, alB, l_reg, pa0, pa1, pa2, pa3); SBAR();
    if (j + 3 < NT) SLOAD(SE, (j + 3) * 64); SBAR();
    att_pv_both(o[0], o[1], vb0 + ATT_SHM_V, pa0, pa1, pa2, pa3); att_partialSM(pA0, pA1, m_run, alA, false);
    __syncthreads(); asm volatile("s_waitcnt vmcnt(3)" ::: "memory"); SWRITE(1, SO);
    RESC(alA); __syncthreads();
  }
  SBAR(); att_qkt(pB0, pB1, K_lds + ATT_SHM_K, qr, r32, hi, -m_run);
  att_finishSM(pA0, pA1, alA, l_reg, pa0, pa1, pa2, pa3); SBAR();
  att_pv_both(o[0], o[1], vb0, pa0, pa1, pa2, pa3); att_partialSM(pB0, pB1, m_run, alB, false);
  __syncthreads(); RESC(alB);
  att_finishSM(pB0, pB1, alB, l_reg, pa0, pa1, pa2, pa3); SBAR();
  att_pv_both(o[0], o[1], vb0 + ATT_SHM_V, pa0, pa1, pa2, pa3);
  if (hi == 0) li_l[r32] = l_reg; asm volatile("s_waitcnt lgkmcnt(0)" ::: "memory");
  float rli[16];
#pragma unroll
  for (int r = 0; r < 16; ++r) rli[r] = __builtin_amdgcn_rcpf(li_l[crow(r, hi)]);
  bfu* Ow = (bfu*)(p.ws + OFF_MIX) + (tb + qb * 256 + wid * 32) * 1024 + h * 64;
#pragma unroll
  for (int r = 0; r < 16; ++r) { int orow = crow(r, hi);
#pragma unroll
    for (int d0 = 0; d0 < 2; ++d0) Ow[(size_t)orow * 1024 + d0 * 32 + r32] = f2bf(o[d0][r] * rli[r]); }
#undef SLOAD
#undef SWRITE
#undef RESC
}
constexpr int ATT_S0 = 6;
__device__ __forceinline__ void attn_phase(const P& p, char* lds, int bid, int nb) {
  const int x = bid & 7, i = bid >> 3, per = nb >> 3;
  if (per == 32) {
    const bool glab = i < 20;
    for (int sl = glab ? ATT_S0 : 0; ; ++sl) {
      const int k = sl < ATT_S0 ? sl * 12 + (i - 20) : ATT_S0 * 12 + (sl - ATT_S0) * 32 + (i + 12) % 32;
      if (k >= 320) break;
      const int pair = (k >> 3) * 8 + x;
      attn_item(p, lds, pair >> 3, pair & 7, k & 7);
    }
  } else {
    for (int j = i; j < 320; j += per) {
      const int pair = (j >> 3) * 8 + x, qb = j & 7;
      attn_item(p, lds, pair >> 3, pair & 7, qb);
    }
  }
}

constexpr int GL_QD = 0, GL_KI = 8192, GL_KDT = 16384, GL_QR = 24576, GL_KR = 32768, GL_VI = 40960, GL_GLR = 57344  , GL_SEG = 65536, GL_BL = 66560, GL_RSS = 66816, GL_DIR = 67840;
constexpr int GL_OLS = 132;
constexpr int GLA_LDS = 2 * GL_DIR;
static_assert(64 * GL_OLS * 4 <= GL_VI, "output tile must fit over the operand images (not over the V image: the next chunk's V lands there during the output stage)");
__device__ __forceinline__ int gl_sw(int row, int col) { return row * 128 + ((((col >> 3) ^ (row & 7))) << 4) + (col & 7) * 2; }
__device__ __forceinline__ int gl_v_st(int k, int c) { const int kk = (k & ~0xC) | ((k & 4) << 1) | ((k & 8) >> 1); return ((kk >> 3) * 4 + (c >> 5)) * 512 + ((kk & 7) * 32 + (c & 31)) * 2; }
template <int KS, int HALF> __device__ __forceinline__ s16x4 gl_tr(int vb) { return att_tr_read<KS * 4096 + HALF * 2048>(vb); }
#define GL_PK(L, H) (bf16x8){L[0], L[1], L[2], L[3], H[0], H[1], H[2], H[3]}
__device__ __forceinline__ void gl_pk4(const f32x16& P, int BASE_is8, bf16x8& OUT) {
  unsigned a0, a1, b0, b1;
  if (BASE_is8 == 0) { a0 = cvtpk(P[0], P[1]); a1 = cvtpk(P[2], P[3]); b0 = cvtpk(P[4], P[5]); b1 = cvtpk(P[6], P[7]); }
  else { a0 = cvtpk(P[8], P[9]); a1 = cvtpk(P[10], P[11]); b0 = cvtpk(P[12], P[13]); b1 = cvtpk(P[14], P[15]); }
  auto r0 = __builtin_amdgcn_permlane32_swap(a0, b0, false, false); auto r1 = __builtin_amdgcn_permlane32_swap(a1, b1, false, false);
  u32x4 w = {r0[0], r1[0], r0[1], r1[1]}; OUT = *reinterpret_cast<bf16x8*>(&w);
}
__device__ __forceinline__ float half32_sum(float v) {
  v = row16_sum(v);
  auto rr = __builtin_amdgcn_permlane16_swap(__float_as_uint(v), __float_as_uint(v), false, false);
  return __uint_as_float(rr[0]) + __uint_as_float(rr[1]);
}
__device__ __forceinline__ void gla_item(const P& p, char* lds, int seq, int h) {
  const int tid = tidx(), wid = tid >> 6, lane = tid & 63, r32 = lane & 31, hi = lane >> 5;
  const int dir = wid >> 2, wv = wid & 3, td_ = tid & 255;
  char* L = lds + dir * GL_DIR;
  float* GLRS = (float*)(L + GL_GLR); float* SEG = (float*)(L + GL_SEG); float* BL = (float*)(L + GL_BL); float* RSS = (float*)(L + GL_RSS);
  const unsigned tb = (unsigned)seq * SEQ;
  const bfu* GQ = (const bfu*)(p.ws + OFF_GQ); const bfu* GK = (const bfu*)(p.ws + OFF_GK); const bfu* GV = (const bfu*)(p.ws + OFF_GV);
  const float* GLR = (const float*)(p.ws + OFF_GLR); const bfu* GOUT = (const bfu*)(p.ws + OFF_GOUT);
  bfu* OTMP = (bfu*)(p.ws + OFF_OTMP); bfu* MIX = (bfu*)(p.ws + OFF_MIX);
  const int d_ = td_ & 63, seg_ = td_ >> 6;
  float gwr[16]; float gbias;
  { const int d = d_;
  {
    const float* gw = dir ? p.gbw : p.gfw;
#pragma unroll
    for (int q = 0; q < 16; ++q) gwr[q] = gw[q * 256 + h * 64 + d];
  }
  gbias = (dir ? p.gbb : p.gfb)[h * 64 + d]; }
  f32x16 S0 = {}, S1 = {};
  const int vb = (int)(uintptr_t)(L + GL_VI) + att_v_rd_base(lane) + wv * 512;
  u32x4 pq0, pq1, pk0, pk1;
#define GL_PREFETCH(CCN, TD) do { const unsigned t0n = tb + (unsigned)(CCN) * 64u; \
    { const int sp = (TD) >> 2, q4 = (TD) & 3; const unsigned t = t0n + (unsigned)(dir ? 63 - sp : sp); \
      const u32x4* qs = (const u32x4*)(GQ + (t * 256u + (unsigned)(h * 64 + q4 * 16))); pq0 = qs[0]; pq1 = qs[1]; \
      const u32x4* ks = (const u32x4*)(GK + (t * 256u + (unsigned)(h * 64 + q4 * 16))); pk0 = ks[0]; pk1 = ks[1]; } } while (0)
#define GL_VDMA(CCN, LANE) do { const unsigned t0n = tb + (unsigned)(CCN) * 64u; \
    _Pragma("unroll") for (int i = 0; i < 4; ++i) { const int off = (i * 4 + wv) * 1024 + (LANE) * 16, blk = off >> 9, in = off & 511; \
      const int kk = (blk >> 2) * 8 + (in >> 6), k = (kk & ~0xC) | ((kk & 4) << 1) | ((kk & 8) >> 1), cv = (blk & 3) * 32 + ((in & 63) >> 1); \
      const unsigned t = t0n + (unsigned)(dir ? 63 - k : k); \
      __builtin_amdgcn_global_load_lds((const unsigned*)(GV + (t * 512u + (unsigned)(h * 128 + cv))), (unsigned*)(L + GL_VI + (i * 4 + wv) * 1024), 16, 0, 0); } } while (0)
#define GL_GDMA(CCN, TD, BUF) do { const unsigned t0n = tb + (unsigned)(CCN) * 64u; const int sp = (TD) >> 2, q4 = (TD) & 3; const unsigned t = t0n + (unsigned)(dir ? 63 - sp : sp); \
    __builtin_amdgcn_global_load_lds((const unsigned*)(GLR + (t * 32u + (unsigned)(dir * 16 + q4 * 4))), (unsigned*)(GLRS + (BUF) * 1024 + wv * 256), 16, 0, 0); } while (0)
  GL_GDMA(dir ? 31 : 0, td_, 0);
  GL_PREFETCH(dir ? 31 : 0, td_);
  GL_VDMA(dir ? 31 : 0, lane);
  if (td_ < 128) RSS[td_] = p.gla_g[td_];
  u32x4 ogv[4], ggv[4];
  for (int c = 0; c < 32; ++c) {
    const int cc = dir ? 31 - c : c;
    const unsigned t0 = tb + (unsigned)cc * 64u;
#define GL_TOK(sp) (t0 + (unsigned)(dir ? 63 - (sp) : (sp)))
    asm volatile("s_waitcnt vmcnt(3)" ::: "memory");
    __syncthreads();
    int d = d_, seg = seg_, td = td_;
    asm volatile("" : "+v"(d), "+v"(seg), "+v"(td));
    { const int sp = td >> 2, q4 = td & 3;
      u32x4* qd = (u32x4*)(L + GL_QR + sp * 128 + q4 * 32); qd[0] = pq0; qd[1] = pq1;
      u32x4* kd2 = (u32x4*)(L + GL_KR + sp * 128 + q4 * 32); kd2[0] = pk0; kd2[1] = pk1; }
    const float* GLC = GLRS + (c & 1) * 1024;
    float bcum[16]; float run = 0.f;
#pragma unroll
    for (int rb = 0; rb < 8; ++rb) {
      float4 g[2][4];
#pragma unroll
      for (int r = 0; r < 2; ++r)
#pragma unroll
        for (int q = 0; q < 4; ++q) g[r][q] = *(const float4*)(GLC + (seg * 16 + rb * 2 + r) * 16 + q * 4);
      __builtin_amdgcn_sched_barrier(0);
#pragma unroll
      for (int r = 0; r < 2; ++r) {
        float z = gbias;
#pragma unroll
        for (int q = 0; q < 4; ++q) { const float4 v = g[r][q]; z += v.x * gwr[4 * q] + v.y * gwr[4 * q + 1] + v.z * gwr[4 * q + 2] + v.w * gwr[4 * q + 3]; }
        const float ls = fminf(z, 0.f) - 0.6931471805599453f * __builtin_amdgcn_logf(1.f + __expf(-fabsf(z)));
        run += ls * (1.f / 16.f); bcum[rb * 2 + r] = run;
      }
      __builtin_amdgcn_sched_barrier(0);
    }
    SEG[seg * 64 + d] = run;
    __syncthreads();
    {
      float qv[16], kv[16];
#pragma unroll
      for (int r = 0; r < 16; ++r) { qv[r] = bf2f(*(const bfu*)(L + GL_QR + (seg * 16 + r) * 128 + d * 2)); kv[r] = bf2f(*(const bfu*)(L + GL_KR + (seg * 16 + r) * 128 + d * 2)); }
      const float s0 = SEG[d], s1 = SEG[64 + d], s2 = SEG[128 + d], s3 = SEG[192 + d];
      const float off = (seg > 0 ? s0 : 0.f) + (seg > 1 ? s1 : 0.f) + (seg > 2 ? s2 : 0.f);
      const float total = s0 + s1 + s2 + s3;
      unsigned kd[8];
#pragma unroll
      for (int r = 0; r < 16; ++r) {
        const float b = bcum[r] + off;
        const float e1 = __expf(b), e2 = __expf(-b), e3 = __expf(total - b);
        const int sp = seg * 16 + r;
        *(bfu*)(L + GL_QD + gl_sw(sp, d)) = f2bf(qv[r] * e1);
        *(bfu*)(L + GL_KI + gl_sw(sp, d)) = f2bf(kv[r] * e2);
        const float kdv = kv[r] * e3;
        if (r & 1) kd[r >> 1] = cvtpk(__uint_as_float(kd[r >> 1]), kdv); else kd[r >> 1] = __float_as_uint(kdv);
      }
      *(uint4*)(L + GL_KDT + gl_sw(d, seg * 16)) = make_uint4(kd[0], kd[1], kd[2], kd[3]);
      *(uint4*)(L + GL_KDT + gl_sw(d, seg * 16 + 8)) = make_uint4(kd[4], kd[5], kd[6], kd[7]);
      if (seg == 0) BL[d] = __expf(total);
    }
    asm volatile("s_waitcnt vmcnt(0)" ::: "memory");
    __syncthreads();
    f32x16 X00 = {}, X01 = {}, X11 = {};
    {
      const char* KI = L + GL_KI; const char* QD = L + GL_QD;
#pragma unroll
      for (int ks = 0; ks < 4; ++ks) {
        const int col = ks * 16 + hi * 8;
        const bf16x8 a0 = *(const bf16x8*)(KI + gl_sw(r32, col)), a1 = *(const bf16x8*)(KI + gl_sw(32 + r32, col));
        const bf16x8 b0 = *(const bf16x8*)(QD + gl_sw(r32, col)), b1 = *(const bf16x8*)(QD + gl_sw(32 + r32, col));
        X00 = __builtin_amdgcn_mfma_f32_32x32x16_bf16(a0, b0, X00, 0, 0, 0);
        X01 = __builtin_amdgcn_mfma_f32_32x32x16_bf16(a0, b1, X01, 0, 0, 0);
        X11 = __builtin_amdgcn_mfma_f32_32x32x16_bf16(a1, b1, X11, 0, 0, 0);
      }
    }
#pragma unroll
    for (int r = 0; r < 16; ++r) { const bool keep = crow(r, hi) <= r32; X00[r] = keep ? X00[r] : 0.f; X11[r] = keep ? X11[r] : 0.f; }
    const s16x4 l0 = gl_tr<0, 0>(vb), h0 = gl_tr<0, 1>(vb), l1 = gl_tr<1, 0>(vb), h1 = gl_tr<1, 1>(vb);
    const s16x4 l2 = gl_tr<2, 0>(vb), h2 = gl_tr<2, 1>(vb), l3 = gl_tr<3, 0>(vb), h3 = gl_tr<3, 1>(vb);
    asm volatile("s_waitcnt lgkmcnt(0)" ::: "memory"); SBAR();
    const bf16x8 V0 = GL_PK(l0, h0), V1 = GL_PK(l1, h1), V2 = GL_PK(l2, h2), V3 = GL_PK(l3, h3);
    f32x16 o0 = {}, o1 = {};
    { bf16x8 pa0, pa1, pa2, pa3;
      gl_pk4(X00, 0, pa0); gl_pk4(X00, 1, pa1);
      o0 = __builtin_amdgcn_mfma_f32_32x32x16_bf16(pa0, V0, o0, 0, 0, 0);
      o0 = __builtin_amdgcn_mfma_f32_32x32x16_bf16(pa1, V1, o0, 0, 0, 0);
      gl_pk4(X01, 0, pa0); gl_pk4(X01, 1, pa1); gl_pk4(X11, 0, pa2); gl_pk4(X11, 1, pa3);
      o1 = __builtin_amdgcn_mfma_f32_32x32x16_bf16(pa0, V0, o1, 0, 0, 0);
      o1 = __builtin_amdgcn_mfma_f32_32x32x16_bf16(pa1, V1, o1, 0, 0, 0);
      o1 = __builtin_amdgcn_mfma_f32_32x32x16_bf16(pa2, V2, o1, 0, 0, 0);
      o1 = __builtin_amdgcn_mfma_f32_32x32x16_bf16(pa3, V3, o1, 0, 0, 0);
    }
    {
      const char* QD = L + GL_QD;
#pragma unroll
      for (int dt = 0; dt < 2; ++dt) {
        const f32x16& Sx = dt ? S1 : S0;
#pragma unroll
        for (int ks = 0; ks < 2; ++ks) {
          u32x4 sb = {cvtpk(Sx[8 * ks + 0], Sx[8 * ks + 1]), cvtpk(Sx[8 * ks + 2], Sx[8 * ks + 3]), cvtpk(Sx[8 * ks + 4], Sx[8 * ks + 5]), cvtpk(Sx[8 * ks + 6], Sx[8 * ks + 7])};
          const bf16x8 sbf = *reinterpret_cast<bf16x8*>(&sb);
          const int dcol = dt * 32 + ks * 16 + hi * 4;
          const uint2 a0l = *(const uint2*)(QD + gl_sw(r32, dcol)), a0h = *(const uint2*)(QD + gl_sw(r32, dcol + 8));
          const uint2 a1l = *(const uint2*)(QD + gl_sw(32 + r32, dcol)), a1h = *(const uint2*)(QD + gl_sw(32 + r32, dcol + 8));
          u32x4 A0 = {a0l.x, a0l.y, a0h.x, a0h.y}, A1 = {a1l.x, a1l.y, a1h.x, a1h.y};
          o0 = __builtin_amdgcn_mfma_f32_32x32x16_bf16(*reinterpret_cast<bf16x8*>(&A0), sbf, o0, 0, 0, 0);
          o1 = __builtin_amdgcn_mfma_f32_32x32x16_bf16(*reinterpret_cast<bf16x8*>(&A1), sbf, o1, 0, 0, 0);
        }
      }
    }
    {
      const char* KDT = L + GL_KDT;
#pragma unroll
      for (int r = 0; r < 16; ++r) { S0[r] *= BL[crow(r, hi)]; S1[r] *= BL[32 + crow(r, hi)]; }
#pragma unroll
      for (int s = 0; s < 4; ++s) {
        const bf16x8 Vs = s == 0 ? V0 : s == 1 ? V1 : s == 2 ? V2 : V3;
        const bf16x8 a0 = *(const bf16x8*)(KDT + gl_sw(r32, s * 16 + hi * 8)), a1 = *(const bf16x8*)(KDT + gl_sw(32 + r32, s * 16 + hi * 8));
        S0 = __builtin_amdgcn_mfma_f32_32x32x16_bf16(a0, Vs, S0, 0, 0, 0);
        S1 = __builtin_amdgcn_mfma_f32_32x32x16_bf16(a1, Vs, S1, 0, 0, 0);
      }
    }
    __syncthreads();
    if (c < 31) { int tdp = td; asm volatile("" : "+v"(tdp)); GL_PREFETCH(dir ? 30 - c : c + 1, tdp); int lp = tdp & 63; GL_VDMA(dir ? 30 - c : c + 1, lp); GL_GDMA(dir ? 30 - c : c + 1, tdp, (c + 1) & 1); }
    if (c >= 16) { int tdq = td; asm volatile("" : "+v"(tdq)); const int row = tdq >> 2, sg = tdq & 3; const unsigned t = GL_TOK(row);
      const u32x4* og = (const u32x4*)(OTMP + (t * 512u + (unsigned)(h * 128 + sg * 32))); const u32x4* gg = (const u32x4*)(GOUT + (t * 512u + (unsigned)(h * 128 + sg * 32)));
#pragma unroll
      for (int q = 0; q < 4; ++q) { ogv[q] = og[q]; ggv[q] = gg[q]; } }
    {
      float* OL = (float*)L;
#pragma unroll
      for (int r = 0; r < 16; ++r) {
        OL[crow(r, hi) * GL_OLS + wv * 32 + r32] = o0[r];
        OL[(32 + crow(r, hi)) * GL_OLS + wv * 32 + r32] = o1[r];
      }
    }
    __syncthreads();
    {
      const float* OL = (const float*)L;
      const int row = td >> 2, sg = td & 3;
      const unsigned t = GL_TOK(row);
      float4 v[8];
#pragma unroll
      for (int q = 0; q < 8; ++q) v[q] = *(const float4*)(OL + row * GL_OLS + sg * 32 + q * 4);
      uint4* og = (uint4*)(OTMP + (t * 512u + (unsigned)(h * 128 + sg * 32)));
      if (c < 16) {
#pragma unroll
        for (int q = 0; q < 4; ++q) og[q] = make_uint4(cvtpk(v[2 * q].x, v[2 * q].y), cvtpk(v[2 * q].z, v[2 * q].w), cvtpk(v[2 * q + 1].x, v[2 * q + 1].y), cvtpk(v[2 * q + 1].z, v[2 * q + 1].w));
      } else {
        float ss = 0.f;
#pragma unroll
        for (int q = 0; q < 4; ++q) { const uint4 w = make_uint4(ogv[q][0], ogv[q][1], ogv[q][2], ogv[q][3]);
          v[2 * q].x += __uint_as_float(w.x << 16); v[2 * q].y += __uint_as_float(w.x & 0xffff0000u); v[2 * q].z += __uint_as_float(w.y << 16); v[2 * q].w += __uint_as_float(w.y & 0xffff0000u);
          v[2 * q + 1].x += __uint_as_float(w.z << 16); v[2 * q + 1].y += __uint_as_float(w.z & 0xffff0000u); v[2 * q + 1].z += __uint_as_float(w.w << 16); v[2 * q + 1].w += __uint_as_float(w.w & 0xffff0000u); }
#pragma unroll
        for (int q = 0; q < 8; ++q) ss += v[q].x * v[q].x + v[q].y * v[q].y + v[q].z * v[q].z + v[q].w * v[q].w;
        ss += dpp_f<0xB1>(ss); ss += dpp_f<0x4E>(ss);
        const float rstd = rsqrtf(ss * (1.f / 128.f) + EPS);
        const float4* gn = (const float4*)(RSS + sg * 32);
        uint4* mo = (uint4*)(MIX + (t * 1024u + 512u + (unsigned)(h * 128 + sg * 32)));
#pragma unroll
        for (int q = 0; q < 4; ++q) {
          const float4 n0 = gn[2 * q], n1 = gn[2 * q + 1];
          const unsigned gws[4] = {ggv[q][0], ggv[q][1], ggv[q][2], ggv[q][3]};
          const float ov[8] = {v[2 * q].x, v[2 * q].y, v[2 * q].z, v[2 * q].w, v[2 * q + 1].x, v[2 * q + 1].y, v[2 * q + 1].z, v[2 * q + 1].w};
          const float nn[8] = {n0.x, n0.y, n0.z, n0.w, n1.x, n1.y, n1.z, n1.w};
          unsigned ow[4];
#pragma unroll
          for (int e = 0; e < 4; ++e) {
            const float g0 = __uint_as_float(gws[e] << 16), g1 = __uint_as_float(gws[e] & 0xffff0000u);
            const float r0 = ov[2 * e] * rstd * nn[2 * e] * (g0 / (1.f + __expf(-g0)));
            const float r1 = ov[2 * e + 1] * rstd * nn[2 * e + 1] * (g1 / (1.f + __expf(-g1)));
            ow[e] = cvtpk(r0, r1);
          }
          mo[q] = make_uint4(ow[0], ow[1], ow[2], ow[3]);
        }
      }
    }
#undef GL_TOK
  }
#undef GL_PREFETCH
#undef GL_GDMA
#undef GL_VDMA
}
__device__ __forceinline__ void gla_phase(const P& p, char* lds, int bid, int nb) {
  for (int item = bid; item < NSEQ * 4; item += nb) gla_item(p, lds, item >> 2, item & 3);
}

typedef _Float16 h2_t __attribute__((ext_vector_type(2)));
__device__ __forceinline__ unsigned enc_key(float f, unsigned idx, unsigned lowmask) {
  unsigned u = __float_as_uint(f);
  unsigned k = u ^ ((unsigned)((int)u >> 31) | 0x80000000u);
  return (k & ~lowmask) | idx;
}
__device__ __forceinline__ float dec_key(unsigned k, unsigned lowmask) {
  k &= ~lowmask;
  unsigned u = (k & 0x80000000u) ? (k & 0x7fffffffu) : ~k;
  return __uint_as_float(u);
}
__device__ __forceinline__ void ce_desc(unsigned& a, unsigned& b) { unsigned mx = a > b ? a : b, mn = a > b ? b : a; a = mx; b = mn; }
__device__ __forceinline__ void sort16_desc(unsigned (&k)[16]) {
#pragma unroll
  for (int size = 2; size <= 16; size <<= 1)
#pragma unroll
    for (int stride = size >> 1; stride > 0; stride >>= 1)
#pragma unroll
      for (int i = 0; i < 16; ++i) {
        const int l = i ^ stride;
        if (l > i) { if ((i & size) == 0) ce_desc(k[i], k[l]); else ce_desc(k[l], k[i]); }
      }
}
__device__ __forceinline__ void bmerge16_desc(unsigned (&k)[16]) {
#pragma unroll
  for (int stride = 8; stride > 0; stride >>= 1)
#pragma unroll
    for (int i = 0; i < 16; ++i) { const int l = i ^ stride; if (l > i) ce_desc(k[i], k[l]); }
}
__device__ __forceinline__ void merge_top16(unsigned (&top)[16], const unsigned (&nw)[16]) {
#pragma unroll
  for (int i = 0; i < 16; ++i) top[i] = top[i] > nw[15 - i] ? top[i] : nw[15 - i];
  bmerge16_desc(top);
}
constexpr int cand_a(int c) { return c < 16 ? 0 : c < 24 ? 1 : c < 29 ? 2 : c < 33 ? 3 : c < 36 ? 4 : c < 38 ? 5 : c < 40 ? 6 : c < 42 ? 7 : c < 50 ? c - 34 : -1; }
constexpr int cand_b(int c) { return c < 16 ? c : c < 24 ? c - 16 : c < 29 ? c - 24 : c < 33 ? c - 29 : c < 36 ? c - 33 : c < 38 ? c - 36 : c < 40 ? c - 38 : c < 42 ? c - 40 : 0; }

constexpr int PE_TOK = 64;
constexpr int PE_T1_STRIDE = 260;
constexpr int PE_STARTS_B = PE_TOK * 20 * 4;
constexpr int PE_RING_B = 8 * 8192;
constexpr int PE_LDS_TOP1 = PE_STARTS_B + PE_RING_B;
static_assert(PE_TOK * PE_T1_STRIDE * 4 <= PE_LDS_TOP1, "top1 image must fit region 0");
constexpr int PE_LDS = PE_LDS_TOP1 + PE_TOK * 128 * 8;

__device__ __forceinline__ void peer_topk1_fin(const unsigned (&top)[16], int tl, int g, int hi, unsigned* top1) {
  unsigned m[16];
#pragma unroll
  for (int i = 0; i < 16; ++i) {
    const unsigned mine = hi ? top[15 - i] : top[i];
    auto rr = __builtin_amdgcn_permlane32_swap(mine, mine, false, false);
    m[i] = rr[0] > rr[1] ? rr[0] : rr[1];
  }
  bmerge16_desc(m);
  if (hi == 0) {
    uint4* dst = (uint4*)(top1 + tl * PE_T1_STRIDE + g * 16);
#pragma unroll
    for (int q = 0; q < 4; ++q) dst[q] = make_uint4(m[4 * q], m[4 * q + 1], m[4 * q + 2], m[4 * q + 3]);
  }
}
__device__ __forceinline__ void peer_topk1(const P& p, int tok0, int g, unsigned* top1) {
  const int lane = tidx() & 63, r32 = lane & 31, hi = lane >> 5;
  const uint4* S0 = (const uint4*)((const _Float16*)(p.ws + OFF_PQ) + (size_t)(tok0 + r32) * 2048 + g * 128 + hi * 64);
  const uint4* S1 = S0 + (size_t)32 * 2048 * 2 / 16;
  uint4 sa[8], sb[8];
#pragma unroll
  for (int q = 0; q < 8; ++q) { sa[q] = S0[q]; sb[q] = S1[q]; }
  unsigned top0[16], top1r[16];
#pragma unroll
  for (int kt = 0; kt < 4; ++kt) {
    unsigned key0[16], key1[16];
#pragma unroll
    for (int q = 0; q < 2; ++q) {
      const unsigned wa[4] = {sa[2 * kt + q].x, sa[2 * kt + q].y, sa[2 * kt + q].z, sa[2 * kt + q].w};
      const unsigned wb[4] = {sb[2 * kt + q].x, sb[2 * kt + q].y, sb[2 * kt + q].z, sb[2 * kt + q].w};
#pragma unroll
      for (int e = 0; e < 4; ++e) {
        const unsigned idx = (unsigned)(hi * 64 + kt * 16 + q * 8 + 2 * e);
        const h2_t ha = __builtin_bit_cast(h2_t, wa[e]), hb = __builtin_bit_cast(h2_t, wb[e]);
        key0[q * 8 + 2 * e] = enc_key((float)ha[0], idx, 127u); key0[q * 8 + 2 * e + 1] = enc_key((float)ha[1], idx + 1u, 127u);
        key1[q * 8 + 2 * e] = enc_key((float)hb[0], idx, 127u); key1[q * 8 + 2 * e + 1] = enc_key((float)hb[1], idx + 1u, 127u);
      }
    }
    sort16_desc(key0); sort16_desc(key1);
    if (kt == 0) {
#pragma unroll
      for (int r = 0; r < 16; ++r) { top0[r] = key0[r]; top1r[r] = key1[r]; }
    } else { merge_top16(top0, key0); merge_top16(top1r, key1); }
  }
  peer_topk1_fin(top0, r32, g, hi, top1);
  peer_topk1_fin(top1r, 32 + r32, g, hi, top1);
}
__device__ __forceinline__ void peer_topk2(const P& p, int tok0, const unsigned* top1, int* pidx, float* pgate) {
  const int tid = tidx(), tl = tid >> 3, hh = tid & 7;
  float rs2;
  { const float4* s4 = (const float4*)(p.ws + OFF_SS2) + (size_t)(tok0 + tl) * 4; float sq = 0.f;
#pragma unroll
    for (int q = 0; q < 4; ++q) { const float4 t = s4[q]; sq += t.x + t.y + t.z + t.w; }
    rs2 = rsqrtf(sq * (1.f / 1024.f) + EPS); }
  const unsigned* l1 = top1 + tl * PE_T1_STRIDE + hh * 32;
  unsigned k1[16], k2[16];
#pragma unroll
  for (int q = 0; q < 4; ++q) {
    uint4 a = ((const uint4*)l1)[q], b = ((const uint4*)l1)[4 + q];
    k1[4 * q] = a.x; k1[4 * q + 1] = a.y; k1[4 * q + 2] = a.z; k1[4 * q + 3] = a.w;
    k2[4 * q] = b.x; k2[4 * q + 1] = b.y; k2[4 * q + 2] = b.z; k2[4 * q + 3] = b.w;
  }
  float f1[16], f2[16];
#pragma unroll
  for (int i = 0; i < 16; ++i) { f1[i] = dec_key(k1[i], 127u) * rs2; f2[i] = dec_key(k2[i], 127u) * rs2; }
  unsigned top[16];
#pragma unroll
  for (int bt = 0; bt < 4; ++bt) {
    unsigned key[16];
#pragma unroll
    for (int c = 0; c < 16; ++c) {
      const int cc = bt * 16 + c;
      const int a = cand_a(cc), b = cand_b(cc);
      key[c] = (a >= 0) ? enc_key(f1[a >= 0 ? a : 0] + f2[b], (unsigned)((a >= 0 ? a : 0) * 16 + b), 255u) : 0u;
    }
    sort16_desc(key);
    if (bt == 0) {
#pragma unroll
      for (int r = 0; r < 16; ++r) top[r] = key[r];
    } else merge_top16(top, key);
  }
  float s[16]; float sum = 0;
  const float m0 = dec_key(top[0], 255u);
#pragma unroll
  for (int r = 0; r < 16; ++r) { s[r] = __expf(dec_key(top[r], 255u) - m0); sum += s[r]; }
  const float inv = 1.f / sum;
#pragma unroll
  for (int r = 0; r < 16; ++r) {
    const unsigned ab = top[r] & 255u;
    const int i1 = (int)(l1[ab >> 4] & 127u), i2 = (int)(l1[16 + (ab & 15u)] & 127u);
    pidx[tl * 128 + hh * 16 + r] = i1 * 128 + i2;
    pgate[tl * 128 + hh * 16 + r] = s[r] * inv;
  }
}
__device__ __forceinline__ float gelu_tanh_f(float x) {
  float u = 0.7978845608028654f * (x + 0.044715f * x * x * x);
  float th = 1.f - 2.f / (1.f + __expf(2.f * u));
  return 0.5f * x * (1.f + th);
}
__device__ __forceinline__ unsigned pk_h2(float a, float b) { h2_t h = {(_Float16)a, (_Float16)b}; return __builtin_bit_cast(unsigned, h); }
constexpr int PE_NR = 16;
__device__ __forceinline__ void peer_sort_picks(int* pidx_t, float* pgate_t, int* starts_t) {
  const int lane = tidx() & 63;
  const int i0 = pidx_t[lane], i1 = pidx_t[64 + lane];
  const float g0 = pgate_t[lane], g1 = pgate_t[64 + lane];
  const int r0 = i0 >> 10, r1 = i1 >> 10;
  int pos0 = 0, pos1 = 0, base = 0, sv = 128;
#pragma unroll
  for (int r = 0; r < PE_NR; ++r) {
    const unsigned long long m0 = __ballot(r0 == r), m1 = __ballot(r1 == r);
    const int c0 = __popcll(m0), c1 = __popcll(m1);
    const int b0 = (int)__builtin_amdgcn_mbcnt_hi((unsigned)(m0 >> 32), __builtin_amdgcn_mbcnt_lo((unsigned)m0, 0u));
    const int b1 = (int)__builtin_amdgcn_mbcnt_hi((unsigned)(m1 >> 32), __builtin_amdgcn_mbcnt_lo((unsigned)m1, 0u));
    pos0 = (r0 == r) ? base + b0 : pos0;
    pos1 = (r1 == r) ? base + c0 + b1 : pos1;
    sv = (lane == r) ? base : sv;
    base += c0 + c1;
  }
  pidx_t[pos0] = i0; pgate_t[pos0] = g0; pidx_t[pos1] = i1; pgate_t[pos1] = g1;
  if (lane <= PE_NR) starts_t[lane] = sv;
}
__device__ __forceinline__ int peer_idx4(const int* pidx_t, int k, int e, int lane) { return pidx_t[min(k + (lane & 3), e - 1)]; }
template <int NP>
__device__ __forceinline__ void peer_issue(const char* UTb, const char* VTb, int ev, char* ring, int lane) {
  const unsigned l16 = (unsigned)lane * 16u;
#pragma unroll
  for (int q = 0; q < NP; ++q) {
    const size_t rowoff = (size_t)(unsigned)__builtin_amdgcn_readlane(ev, q) << 10;
    __builtin_amdgcn_global_load_lds((const unsigned*)(UTb + rowoff + l16), (unsigned*)(ring + q * 2048), 16, 0, 0);
    __builtin_amdgcn_global_load_lds((const unsigned*)(VTb + rowoff + l16), (unsigned*)(ring + q * 2048 + 1024), 16, 0, 0);
  }
}
__device__ __forceinline__ float gelu_tanh_fast(float x) {
  const float u = 0.7978845608028654f * (x + 0.044715f * x * x * x);
  return x * __builtin_amdgcn_rcpf(1.f + __expf(-2.f * u));
}
template <int NP>
__device__ __forceinline__ void peer_compute(const uint4 (&U)[4], const uint4 (&V)[4], float gl, const int (&xq)[4], float xscale, h2_t (&acc)[8], int lane) {
  float d[4];
#pragma unroll
  for (int q = 0; q < 4; ++q) {
    if (q < NP) {
      int s = __builtin_amdgcn_sdot4((int)U[q].x, xq[0], 0, false);
      s = __builtin_amdgcn_sdot4((int)U[q].y, xq[1], s, false);
      s = __builtin_amdgcn_sdot4((int)U[q].z, xq[2], s, false);
      s = __builtin_amdgcn_sdot4((int)U[q].w, xq[3], s, false);
      d[q] = (float)s;
    } else d[q] = 0.f;
  }
  float act;
  if (NP == 4) {
    float s2[2];
#pragma unroll
    for (int q = 0; q < 2; ++q) { auto rr = __builtin_amdgcn_permlane32_swap(__float_as_uint(d[q]), __float_as_uint(d[q + 2]), false, false); s2[q] = __uint_as_float(rr[0]) + __uint_as_float(rr[1]); }
    auto rr = __builtin_amdgcn_permlane16_swap(__float_as_uint(s2[0]), __float_as_uint(s2[1]), false, false); act = __uint_as_float(rr[0]) + __uint_as_float(rr[1]);
  } else {
    auto r1 = __builtin_amdgcn_permlane32_swap(__float_as_uint(d[0]), __float_as_uint(d[1]), false, false);
    const float t = __uint_as_float(r1[0]) + __uint_as_float(r1[1]);
    auto r2 = __builtin_amdgcn_permlane16_swap(__float_as_uint(t), __float_as_uint(t), false, false); act = __uint_as_float(r2[0]) + __uint_as_float(r2[1]);
  }
  act = row16_sum(act) * xscale;
  const float wl = gl * gelu_tanh_fast(act);
  const unsigned whl = pk_h2(wl, wl);
#pragma unroll
  for (int q = 0; q < NP; ++q) {
    const h2_t wq = __builtin_bit_cast(h2_t, (unsigned)__builtin_amdgcn_readlane((int)whl, NP == 4 ? q * 16 : q * 32));
    const unsigned vw[4] = {V[q].x, V[q].y, V[q].z, V[q].w};
#pragma unroll
    for (int j = 0; j < 4; ++j) {
      acc[2 * j] = __builtin_amdgcn_cvt_scalef32_pk_f16_fp8((int)vw[j], 0.015625f, false) * wq + acc[2 * j];
      acc[2 * j + 1] = __builtin_amdgcn_cvt_scalef32_pk_f16_fp8((int)vw[j], 0.015625f, true) * wq + acc[2 * j + 1];
    }
  }
}
__device__ __forceinline__ void peer_load_hraw(const P& p, int t, int lane, uint4 (&raw)[2]) {
  const uint4* hr = (const uint4*)((const bfu*)(p.ws + OFF_HB) + (size_t)t * 1024) + lane * 2;
  raw[0] = hr[0]; raw[1] = hr[1];
}
__device__ __forceinline__ void peer_dec_h(const uint4 (&raw)[2], float (&hv)[16]) {
#pragma unroll
  for (int q = 0; q < 2; ++q) { const unsigned w[4] = {raw[q].x, raw[q].y, raw[q].z, raw[q].w};
#pragma unroll
    for (int e = 0; e < 4; ++e) { hv[8 * q + 2 * e] = __uint_as_float(w[e] << 16); hv[8 * q + 2 * e + 1] = __uint_as_float(w[e] & 0xffff0000u); } }
}
__device__ __forceinline__ void peer_gather_wave8(const P& p, int t0, int* pidx_w, float* pgate_w, int* starts_w, char* ring) {
  const int lane = tidx() & 63;
  t0 = __builtin_amdgcn_readfirstlane(t0);
  const char* UTb = p.ws + OFF_UT; const char* VTb = p.ws + OFF_VT;
  int xq[8][4]; float xsc[8]; h2_t acc[8][8];
  uint4 hraw[2][2];
  peer_load_hraw(p, t0, lane, hraw[0]);
#pragma unroll
  for (int i = 0; i < 8; ++i) {
    if (i < 7) peer_load_hraw(p, t0 + i + 1, lane, hraw[(i + 1) & 1]);
    peer_sort_picks(pidx_w + i * 128, pgate_w + i * 128, starts_w + i * 20);
    float hv[16]; peer_dec_h(hraw[i & 1], hv);
    float ss = 0, am = 0;
#pragma unroll
    for (int e = 0; e < 16; ++e) { ss += hv[e] * hv[e]; am = fmaxf(am, fabsf(hv[e])); }
    ss = wave_sum(ss); am = wave_max(am);
    const float rstd = rsqrtf(ss * (1.f / 1024.f) + EPS);
    const float inv = am > 0.f ? 127.f / am : 0.f;
    xsc[i] = am * rstd * (1.f / (127.f * PE_SU));
#pragma unroll
    for (int q = 0; q < 4; ++q) {
      const int q0 = (int)rintf(hv[4 * q] * inv), q1 = (int)rintf(hv[4 * q + 1] * inv), q2 = (int)rintf(hv[4 * q + 2] * inv), q3 = (int)rintf(hv[4 * q + 3] * inv);
      xq[i][q] = (int)((unsigned)(q0 & 255) | ((unsigned)(q1 & 255) << 8) | ((unsigned)(q2 & 255) << 16) | ((unsigned)(q3 & 255) << 24));
    }
#pragma unroll
    for (int j = 0; j < 8; ++j) acc[i][j] = h2_t{(_Float16)0.f, (_Float16)0.f};
    __builtin_amdgcn_sched_barrier(0);
  }
  bool pf = false;
  for (int r = 0; r < PE_NR; ++r) {
#pragma unroll
    for (int i = 0; i < 8; ++i) {
      const int s = __builtin_amdgcn_readfirstlane(starts_w[i * 20 + r]), e = __builtin_amdgcn_readfirstlane(starts_w[i * 20 + r + 1]);
      const int ni = (i + 1) & 7, nr = (i == 7) ? r + 1 : r;
      const int ns = (nr < PE_NR) ? __builtin_amdgcn_readfirstlane(starts_w[ni * 20 + nr]) : 0;
      const int ne = (nr < PE_NR) ? __builtin_amdgcn_readfirstlane(starts_w[ni * 20 + nr + 1]) : 0;
      for (int k = s; k < e;) {
        const bool four = (e - k) > 2;
        const int k2 = k + (four ? 4 : 2);
        const bool same = k2 < e, hasn = same || (ns < ne);
        const int* nlist = pidx_w + (same ? i : ni) * 128; const int nk = same ? k2 : ns, nend = same ? e : ne;
        if (!pf) { const int ev = peer_idx4(pidx_w + i * 128, k, e, lane); if (four) peer_issue<4>(UTb, VTb, ev, ring, lane); else peer_issue<2>(UTb, VTb, ev, ring, lane); }
        asm volatile("s_waitcnt vmcnt(0)" ::: "memory");
        uint4 U[4], V[4];
#pragma unroll
        for (int q = 0; q < 4; ++q) if (q < 2 || four) { U[q] = *(const uint4*)(ring + q * 2048 + lane * 16); V[q] = *(const uint4*)(ring + q * 2048 + 1024 + lane * 16); }
        const int kg = k + (four ? (lane >> 4) : (lane >> 5));
        const float gl = (kg < e) ? pgate_w[i * 128 + min(kg, e - 1)] : 0.f;
        const int evn = hasn ? peer_idx4(nlist, nk, nend, lane) : 0;
        asm volatile("s_waitcnt lgkmcnt(0)" ::: "memory");
        if (hasn) { if (nend - nk > 2) peer_issue<4>(UTb, VTb, evn, ring, lane); else peer_issue<2>(UTb, VTb, evn, ring, lane); }
        pf = hasn;
        if (four) peer_compute<4>(U, V, gl, xq[i], xsc[i], acc[i], lane); else peer_compute<2>(U, V, gl, xq[i], xsc[i], acc[i], lane);
        k = k2;
      }
    }
  }
  { int te0 = t0; asm volatile("" : "+s"(te0)); peer_load_hraw(p, te0, lane, hraw[0]); }
#pragma unroll
  for (int i = 0; i < 8; ++i) {
    int te = t0 + i; asm volatile("" : "+s"(te));
    if (i < 7) peer_load_hraw(p, te + 1, lane, hraw[(i + 1) & 1]);
    float hv[16]; peer_dec_h(hraw[i & 1], hv);
    float y[16]; float ss = 0;
#pragma unroll
    for (int j = 0; j < 8; ++j) { y[2 * j] = hv[2 * j] + (float)acc[i][j][0]; y[2 * j + 1] = hv[2 * j + 1] + (float)acc[i][j][1]; }
#pragma unroll
    for (int e = 0; e < 16; ++e) ss += y[e] * y[e];
    ss = wave_sum(ss);
    const float rf = rsqrtf(ss * (1.f / 1024.f) + EPS);
    const float4* gr = (const float4*)p.fin_g + lane * 4;
    float4* o4 = (float4*)(p.out + (size_t)te * 1024) + lane * 4;
#pragma unroll
    for (int q = 0; q < 4; ++q) { const float4 g = gr[q]; o4[q] = make_float4(y[4 * q] * rf * g.x, y[4 * q + 1] * rf * g.y, y[4 * q + 2] * rf * g.z, y[4 * q + 3] * rf * g.w); }
    __builtin_amdgcn_sched_barrier(0);
  }
}
__device__ __forceinline__ void peer_phase(const P& p, char* lds, int bid, int nb) {
  unsigned* top1 = (unsigned*)lds; int* pidx = (int*)(lds + PE_LDS_TOP1); float* pgate = (float*)(lds + PE_LDS_TOP1 + PE_TOK * 128 * 4);
  int* starts = (int*)lds;
  const int wid = __builtin_amdgcn_readfirstlane(tidx() >> 6);
  for (int tile = bid; tile < T / PE_TOK; tile += nb) {
    const int tok0 = tile * PE_TOK;
    __syncthreads();
    for (int g = wid; g < 16; g += 8) peer_topk1(p, tok0, g, top1);
    __syncthreads();
    peer_topk2(p, tok0, top1, pidx, pgate);
    __syncthreads();
    peer_gather_wave8(p, tok0 + wid * 8, pidx + wid * 8 * 128, pgate + wid * 8 * 128, starts + wid * 8 * 20, lds + PE_STARTS_B + wid * 8192);
  }
}

#define XB_TMO      128
#define XB_XCNT(j)  (256  + 64 * (j))
#define XB_XSUB(j)  (1280 + 64 * (j))
#define XB_XGEN(j)  (2304 + 64 * (j))
#define XB_TOP      3328
#define XB_TOPGEN   3392
#define XCD_BAR_WORDS 3456
#define XB_SPIN_CAP (1u << 18)
#define LAS __attribute__((address_space(3)))

__device__ __forceinline__ unsigned xb_ld(unsigned* p)              { return __hip_atomic_load(p, __ATOMIC_RELAXED, __HIP_MEMORY_SCOPE_AGENT); }
__device__ __forceinline__ unsigned xb_add(unsigned* p, unsigned v) { return __hip_atomic_fetch_add(p, v, __ATOMIC_RELAXED, __HIP_MEMORY_SCOPE_AGENT); }
__device__ __forceinline__ unsigned xb_xcc_id() { return (unsigned)__builtin_amdgcn_s_getreg((3 << 11) | 20) & 0xFu; }
#define XB_SPIN(cond, bar) do { unsigned _sp = 0; while (cond) { __builtin_amdgcn_s_sleep(1); \
    if ((++_sp & 255u) == 0u) { if (xb_ld(&(bar)[XB_TMO])) break; if (_sp > XB_SPIN_CAP) { atomicAdd(&(bar)[XB_TMO], 1u); break; } } } } while (0)

struct XcdBarrier {
    unsigned* bar; unsigned x;
    volatile LAS unsigned* st;
};

__device__ __forceinline__ XcdBarrier xcd_barrier_post(unsigned* bar, volatile LAS unsigned* st) {
    XcdBarrier b; b.bar = bar; b.x = xb_xcc_id(); b.st = st;
    if (tidx() == 0) (void)xb_add(&bar[XB_XCNT(b.x)], 1u);
    return b;
}
__device__ __forceinline__ void xcd_barrier_complete(unsigned* bar, unsigned x, unsigned& nloc, unsigned& nx) {
    const unsigned G = gridDim.x * gridDim.y * gridDim.z;
    unsigned sum, cnt, mine, sp = 0u;
    for (;;) {
        sum = 0u; cnt = 0u; mine = 0u;
#pragma unroll
        for (unsigned j = 0; j < 16; ++j) { const unsigned c = xb_ld(&bar[XB_XCNT(j)]); sum += c; cnt += (c > 0u) ? 1u : 0u; mine = (j == x) ? c : mine; }
        if (sum == G) break;
        __builtin_amdgcn_s_sleep(1);
        if ((++sp & 255u) == 0u) { if (xb_ld(&bar[XB_TMO])) break; if (sp > XB_SPIN_CAP) { atomicAdd(&bar[XB_TMO], 1u); break; } }
    }
    nloc = mine > 0u ? mine : 1u; nx = cnt > 0u ? cnt : 1u;
}

__device__ __forceinline__ void xcd_barrier(const XcdBarrier& b) {
    asm volatile("s_waitcnt vmcnt(0)" ::: "memory");
    __syncthreads();
    if (tidx() == 0) {
        unsigned* bar = b.bar;
        __builtin_amdgcn_s_waitcnt(0);
        unsigned nloc = b.st[0], nx = b.st[1];
        if (nloc == 0u) { xcd_barrier_complete(bar, b.x, nloc, nx); b.st[0] = nloc; b.st[1] = nx; }
        const unsigned old = xb_add(&bar[XB_XSUB(b.x)], 1u);
        const unsigned gen = old / nloc;
        if (old + 1u == (gen + 1u) * nloc) {
            __builtin_amdgcn_fence(__ATOMIC_RELEASE, "agent");
            asm volatile("s_waitcnt vmcnt(0)" ::: "memory");
            const unsigned og = xb_add(&bar[XB_TOP], 1u);
            const unsigned tg = og / nx;
            if (og + 1u == (tg + 1u) * nx) xb_add(&bar[XB_TOPGEN], 1u);
            else XB_SPIN(xb_ld(&bar[XB_TOPGEN]) == tg, bar);
            __builtin_amdgcn_fence(__ATOMIC_ACQUIRE, "agent");
            xb_add(&bar[XB_XGEN(b.x)], 1u);
            asm volatile("s_waitcnt vmcnt(0)" ::: "memory");
        } else {
            XB_SPIN(xb_ld(&bar[XB_XGEN(b.x)]) == gen, bar);
            __builtin_amdgcn_fence(__ATOMIC_ACQUIRE, "agent");
            asm volatile("s_waitcnt vmcnt(0)" ::: "memory");
        }
    }
    __syncthreads();
}

constexpr int cmax(int a, int b) { return a > b ? a : b; }
constexpr int MEGA_LDS = cmax(cmax(pg8::STAGE_BYTES, ATT_LDS), cmax(PE_LDS, cmax(GLA_LDS, FOLD_LDS)));
__global__ __launch_bounds__(512) void mega(P p) {
  extern __shared__ __attribute__((aligned(16))) unsigned char lds_u[];
  char* lds = (char*)lds_u;
  cg::grid_group grid = cg::this_grid();
  const int bid = blockIdx.x, nb = gridDim.x;
  volatile LAS unsigned* xst = (volatile LAS unsigned*)(lds_u + MEGA_LDS);
  { const int t0 = tidx(); if (t0 < 4) xst[t0] = 0u; prep_phase(p, (long)bid * 512 + t0, (long)nb * 512); }
  prep_foldkeys(p, lds, bid, nb);
  grid.sync();
  (void)xcd_barrier_post((unsigned*)(p.ws + OFF_XBAR), xst);
#define GRID_BARRIER() do { XcdBarrier _b; _b.bar = (unsigned*)(p.ws + OFF_XBAR); _b.x = xb_xcc_id(); _b.st = (volatile LAS unsigned*)(lds_u + MEGA_LDS); xcd_barrier(_b); } while (0)
  PG8_LAS unsigned char* glds = (PG8_LAS unsigned char*)lds;
  { EpiG1 e; e.ws = p.ws; run_gemm(glds, (const bfu*)(p.ws + OFF_XB), (const bfu*)(p.ws + OFF_WIN), T, 2048, 1024, e, bid, nb); }
  GRID_BARRIER();
  { EpiG2 e; e.ws = p.ws; run_gemm(glds, (const bfu*)(p.ws + OFF_CQKV), (const bfu*)(p.ws + OFF_WQKV), T, 1792, 384, e, bid, nb); }
  GRID_BARRIER();
#if PROBE == 6
  for (int rep = 0; rep < 3; ++rep) { gla_phase(p, lds, bid, nb); attn_phase(p, lds, bid, nb); GRID_BARRIER(); }
#elif PROBE == 7
  for (int rep = 0; rep < 3; ++rep) { attn_phase(p, lds, bid, nb); GRID_BARRIER(); }
#elif PROBE == 8
  for (int rep = 0; rep < 3; ++rep) { gla_phase(p, lds, bid, nb); GRID_BARRIER(); }
#endif
  gla_phase(p, lds, bid, nb);
  attn_phase(p, lds, bid, nb);
  GRID_BARRIER();
  { EpiG4 e; e.pp = &p; run_gemm(glds, (const bfu*)(p.ws + OFF_MIX), (const bfu*)(p.ws + OFF_WO), T, 1024, 1024, e, bid, nb); }
  GRID_BARRIER();
  { EpiG5 e; e.ws = p.ws; run_gemm(glds, (const bfu*)(p.ws + OFF_HB), (const bfu*)(p.ws + OFF_WPQ), T, 2048, 1024, e, bid, nb); }
  GRID_BARRIER();
#if PROBE == 5
  peer_phase(p, lds, bid, nb);
  GRID_BARRIER();
#endif
  peer_phase(p, lds, bid, nb);
}

extern "C" void kernel_launch(void* const* d_in, const int* in_sizes, int n_in, void* d_out, int out_size, void* d_ws, size_t ws_size,
                              hipStream_t stream) {
  if (ws_size < WS_NEED) { fprintf(stderr, "kernel_launch: ws too small: %zu < %zu\n", ws_size, WS_NEED); return; }
  P p{};
  p.xp = (const float*)d_in[0]; p.xs = (const float*)d_in[1]; p.norm1_g = (const float*)d_in[2]; p.w_in = (const float*)d_in[3];
  p.q_norm_g = (const float*)d_in[4]; p.w_uq = (const float*)d_in[5]; p.kv_norm_g = (const float*)d_in[6]; p.w_ukv = (const float*)d_in[7];
  p.gfw = (const float*)d_in[8]; p.gfb = (const float*)d_in[9]; p.gbw = (const float*)d_in[10]; p.gbb = (const float*)d_in[11];
  p.gla_g = (const float*)d_in[12]; p.w_o = (const float*)d_in[13]; p.norm2_g = (const float*)d_in[14]; p.wq = (const float*)d_in[15];
  p.subk = (const float*)d_in[16]; p.ut = (const float*)d_in[17]; p.vt = (const float*)d_in[18]; p.fin_g = (const float*)d_in[19];
  p.out = (float*)d_out; p.ws = (char*)d_ws;
  for (int i = 0; i < 16; ++i) p.freq[i] = (float)pow(10000.0, -(double)i * 2.0 / 32.0);
  static int grid_blocks = 0;
  if (!grid_blocks) {
    (void)hipFuncSetAttribute((const void*)mega, hipFuncAttributeMaxDynamicSharedMemorySize, MEGA_LDS + 16);
    int dev = 0, cus = 0, per_cu = 0;
    (void)hipGetDevice(&dev);
    (void)hipDeviceGetAttribute(&cus, hipDeviceAttributeMultiprocessorCount, dev);
    (void)hipOccupancyMaxActiveBlocksPerMultiprocessor(&per_cu, mega, 512, MEGA_LDS + 16);
    if (per_cu > 1) per_cu = 1;
    grid_blocks = cus * per_cu;
    if (grid_blocks <= 0) { fprintf(stderr, "kernel_launch: occupancy query gave %d x %d\n", cus, per_cu); grid_blocks = 0; return; }
  }
  void* args[] = {&p};
  hipError_t e = hipLaunchCooperativeKernel((void*)mega, dim3(grid_blocks), dim3(512), args, MEGA_LDS + 16, stream);
  if (e != hipSuccess) fprintf(stderr, "cooperative launch failed: %s (grid %d)\n", hipGetErrorString(e), grid_blocks);
}
```

```cpp
#include <hip/hip_runtime.h>
#include <hip/hip_bf16.h>
#include <hip/hip_fp16.h>
#include <hip/hip_cooperative_groups.h>
namespace cg = cooperative_groups;
#include <cstdio>
#include <cmath>

#define PROBE 0
extern __shared__ __attribute__((aligned(16))) unsigned char lds_u[];
constexpr int WIDTAB_OFF = 140 * 1024, LDS_TOTAL = WIDTAB_OFF + 256;
__device__ __forceinline__ unsigned hw_slot() { return (unsigned)__builtin_amdgcn_s_getreg((5 << 11) | 4) & 63u; }
__device__ __forceinline__ int lane_id() { return (int)__builtin_amdgcn_mbcnt_hi(~0u, __builtin_amdgcn_mbcnt_lo(~0u, 0u)); }
__device__ __forceinline__ void tidx_init() { if (lane_id() == 0) ((volatile unsigned*)(lds_u + WIDTAB_OFF))[hw_slot()] = threadIdx.x >> 6; asm volatile("s_waitcnt lgkmcnt(0)" ::: "memory"); }
__device__ __forceinline__ int lanex() { int l = lane_id(); asm volatile("" : "+v"(l)); return l; }
__device__ __forceinline__ int tidx() {
  const unsigned w = ((volatile unsigned*)(lds_u + WIDTAB_OFF))[hw_slot()];
  int t = (int)(w * 64u) + lane_id(); asm volatile("" : "+v"(t)); return t;
}
constexpr int T = 81920, TP = 65536, DM = 1024, SEQ = 2048, NSEQ = 40;
constexpr int INW = 1984;
constexpr float EPS = 1e-6f;
constexpr float ATT_QSCALE = 0.10206207261596577f * 1.4426950408889634f;
constexpr float PE_SU = 896.f;

typedef unsigned short bfu;
using bf16x8 = __attribute__((ext_vector_type(8))) short;
using f32x4 = __attribute__((ext_vector_type(4))) float;
using f32x16 = __attribute__((ext_vector_type(16))) float;
__device__ __forceinline__ bfu f2bf(float f) { unsigned u = __float_as_uint(f); u += 0x7fffu + ((u >> 16) & 1u); return (bfu)(u >> 16); }
__device__ __forceinline__ float bf2f(bfu h) { return __uint_as_float(((unsigned)h) << 16); }
__device__ __forceinline__ unsigned cvtpk(float lo, float hi) {
  unsigned r; asm volatile("v_cvt_pk_bf16_f32 %0, %1, %2" : "=v"(r) : "v"(lo), "v"(hi)); return r;
}

__device__ __forceinline__ uint4 pack8(const float (&v)[8]) { return make_uint4(cvtpk(v[0], v[1]), cvtpk(v[2], v[3]), cvtpk(v[4], v[5]), cvtpk(v[6], v[7])); }

constexpr size_t al256(size_t x) { return (x + 255) / 256 * 256; }
constexpr size_t OFF_XBAR  = 0;
constexpr size_t OFF_ROPE  = 16384;
constexpr size_t OFF_WIN   = al256(OFF_ROPE + (size_t)2048 * 16 * 8);
constexpr size_t OFF_WQKV  = al256(OFF_WIN + (size_t)2048 * 1024 * 2);
constexpr size_t OFF_WO    = al256(OFF_WQKV + (size_t)1792 * 384 * 2);
constexpr size_t OFF_WPQ   = al256(OFF_WO + (size_t)1024 * 1024 * 2);
constexpr size_t OFF_SK    = al256(OFF_WPQ + (size_t)2048 * 1024 * 2);
constexpr size_t OFF_UT    = al256(OFF_SK + (size_t)2048 * 128 * 2);
constexpr size_t OFF_VT    = al256(OFF_UT + (size_t)16384 * 1024);
constexpr size_t OFF_RSTD1 = al256(OFF_VT + (size_t)16384 * 1024);
constexpr size_t OFF_SSQ   = al256(OFF_RSTD1 + (size_t)T * 4);
constexpr size_t OFF_SSKV  = al256(OFF_SSQ + (size_t)T * 4 * 4);
constexpr size_t OFF_SS2   = al256(OFF_SSKV + (size_t)T * 4 * 4);
constexpr size_t OFF_XB    = al256(OFF_SS2 + (size_t)T * 16 * 4);
constexpr size_t OFF_KR    = al256(OFF_XB + (size_t)T * 1024 * 2);
constexpr size_t OFF_GQ    = al256(OFF_KR + (size_t)T * 32 * 2);
constexpr size_t OFF_GK    = al256(OFF_GQ + (size_t)T * 256 * 2);
constexpr size_t OFF_GV    = al256(OFF_GK + (size_t)T * 256 * 2);
constexpr size_t OFF_GLR   = al256(OFF_GV + (size_t)T * 512 * 2);
constexpr size_t OFF_GOUT  = al256(OFF_GLR + (size_t)T * 32 * 4);
constexpr size_t OFF_QF    = al256(OFF_GOUT + (size_t)T * 512 * 2);
constexpr size_t OFF_KV    = al256(OFF_QF + (size_t)T * 768 * 2);
constexpr size_t OFF_MIX   = al256(OFF_KV + (size_t)T * 1024 * 2);
constexpr size_t OFF_CQKV  = al256(OFF_MIX + (size_t)T * 1024 * 2);
constexpr size_t OFF_OTMP  = OFF_CQKV;
constexpr size_t WS_NEED   = al256(OFF_OTMP + (size_t)T * 512 * 2);
constexpr size_t OFF_HB    = OFF_XB;
constexpr size_t OFF_PQ    = OFF_KR;
static_assert(OFF_PQ + (size_t)T * 2048 * 2 <= OFF_MIX, "PQ alias overlaps live data");
static_assert(WS_NEED <= (size_t)1073741824, "workspace budget");

struct P {
  const float *xp, *xs, *norm1_g, *w_in, *q_norm_g, *w_uq, *kv_norm_g, *w_ukv, *gfw, *gfb, *gbw, *gbb, *gla_g, *w_o, *norm2_g, *wq,
      *subk, *ut, *vt, *fin_g;
  float* out;
  char* ws;
  float freq[16];
};
__device__ __forceinline__ const float* xrow(const P& p, int t) { return t < TP ? p.xp + (size_t)t * DM : p.xs + (size_t)(t - TP) * DM; }

__device__ __forceinline__ float wave_sum(float v) {
  for (int o = 32; o > 0; o >>= 1) v += __shfl_xor(v, o);
  return v;
}
__device__ __forceinline__ float wave_max(float v) {
  for (int o = 32; o > 0; o >>= 1) v = fmaxf(v, __shfl_xor(v, o));
  return v;
}
template <int CTRL> __device__ __forceinline__ float dpp_f(float v) {
  return __builtin_bit_cast(float, __builtin_amdgcn_update_dpp(0, __builtin_bit_cast(int, v), CTRL, 0xf, 0xf, true));
}
__device__ __forceinline__ float row16_sum(float v) {
  v += dpp_f<0xB1>(v);
  v += dpp_f<0x4E>(v);
  v += dpp_f<0x141>(v);
  v += dpp_f<0x140>(v);
  return v;
}

template <int CTRL> __device__ __forceinline__ int dpp_i(int v) { return __builtin_amdgcn_update_dpp(0, v, CTRL, 0xf, 0xf, true); }
__device__ __forceinline__ int row16_sum_i(int v) { v += dpp_i<0xB1>(v); v += dpp_i<0x4E>(v); v += dpp_i<0x141>(v); v += dpp_i<0x140>(v); return v; }

__device__ __forceinline__ int win_src_col(int n) {
  if (n < 384) return n;
  if (n < 416) return 384 + (n - 384);
  if (n < 448) return 1440 + (n - 416);
  if (n < 512) return -1;
  if (n < 768) return 416 + (n - 512);
  if (n < 1024) return 672 + (n - 768);
  if (n < 1536) return 928 + (n - 1024);
  return 1472 + (n - 1536);
}
__device__ __forceinline__ void cvt_t8(bfu* dst, const float* src, int K, int ldsrc, int n, int srccol, int k0, const float* gain, float scale) {
  unsigned w[4];
  float v[8];
#pragma unroll
  for (int i = 0; i < 8; ++i) {
    float g = gain ? gain[k0 + i] : 1.f;
    v[i] = (srccol >= 0) ? src[(size_t)(k0 + i) * ldsrc + srccol] * g * scale : 0.f;
  }
#pragma unroll
  for (int i = 0; i < 4; ++i) w[i] = cvtpk(v[2 * i], v[2 * i + 1]);
  *(uint4*)(dst + (size_t)n * K + k0) = make_uint4(w[0], w[1], w[2], w[3]);
}
__device__ __forceinline__ void prep_phase(const P& p, long gtid, long gthreads) {
  if (gtid < 4096) ((unsigned*)(p.ws + OFF_XBAR))[gtid] = 0u;
  for (long i = gtid; i < 2048 * 16; i += gthreads) {
    int pos = (int)(i >> 4), f = (int)(i & 15);
    float ang = (float)pos * p.freq[f];
    double rev = (double)ang * 0.15915494309189535;
    rev -= rint(rev);
    float r = (float)rev;
    float2 cs; cs.x = __builtin_amdgcn_cosf(r); cs.y = __builtin_amdgcn_sinf(r);
    ((float2*)(p.ws + OFF_ROPE))[i] = cs;
  }
  for (long i = gtid; i < 2048L * 128; i += gthreads) {
    int n = (int)(i & 2047), kc = (int)(i >> 11);
    cvt_t8((bfu*)(p.ws + OFF_WIN), p.w_in, 1024, INW, n, win_src_col(n), kc * 8, p.norm1_g, (n >= 512 && n < 768) ? 0.125f : 1.f);
  }
  for (long i = gtid; i < 1792L * 48; i += gthreads) {
    const int n = (int)(i % 1792), k0 = (int)(i / 1792) * 8;
    float v[8];
#pragma unroll
    for (int e = 0; e < 8; ++e) {
      const int k = k0 + e;
      v[e] = (n < 768) ? (k < 256 ? p.w_uq[(size_t)k * 768 + n] * p.q_norm_g[k] : 0.f)
                       : (k >= 256 ? p.w_ukv[(size_t)(k - 256) * 1024 + (n - 768)] * p.kv_norm_g[k - 256] : 0.f);
    }
    *(uint4*)((bfu*)(p.ws + OFF_WQKV) + (size_t)n * 384 + k0) = pack8(v);
  }
  for (long i = gtid; i < 1024L * 128; i += gthreads) {
    int n = (int)(i & 1023), kc = (int)(i >> 10);
    cvt_t8((bfu*)(p.ws + OFF_WO), p.w_o, 1024, 1024, n, n, kc * 8, nullptr, 1.f);
  }
  for (long i0 = gtid; i0 < 2L * 16384 * 1024 / 16; i0 += 2 * gthreads) {
    const long half = 16384L * 1024 / 16;
    float4 a[2][4];
#pragma unroll
    for (int u = 0; u < 2; ++u) { const long i = i0 + u * gthreads; if (i >= 2 * half) continue; const bool isv = i >= half; const long j = isv ? i - half : i;
      const float* rowp = (isv ? p.vt : p.ut) + (j >> 6) * 1024 + (j & 63) * 4;
#pragma unroll
      for (int q = 0; q < 4; ++q) a[u][q] = *(const float4*)(rowp + q * 256); }
#pragma unroll
    for (int u = 0; u < 2; ++u) { const long i = i0 + u * gthreads; if (i >= 2 * half) continue; const bool isv = i >= half; const long j = isv ? i - half : i;
      unsigned w[4];
#pragma unroll
      for (int q = 0; q < 4; ++q) {
        const float4 av = a[u][q];
        if (isv) {
          int pk = __builtin_amdgcn_cvt_pk_fp8_f32(av.x * 64.f, av.y * 64.f, 0, false);
          pk = __builtin_amdgcn_cvt_pk_fp8_f32(av.z * 64.f, av.w * 64.f, pk, true);
          w[q] = (unsigned)pk;
        } else {
          const float4 g = *(const float4*)(p.norm2_g + q * 256 + (j & 63) * 4);
          const int q0 = (int)fminf(fmaxf(rintf(av.x * g.x * PE_SU), -127.f), 127.f), q1 = (int)fminf(fmaxf(rintf(av.y * g.y * PE_SU), -127.f), 127.f);
          const int q2 = (int)fminf(fmaxf(rintf(av.z * g.z * PE_SU), -127.f), 127.f), q3 = (int)fminf(fmaxf(rintf(av.w * g.w * PE_SU), -127.f), 127.f);
          w[q] = (unsigned)(q0 & 255) | ((unsigned)(q1 & 255) << 8) | ((unsigned)(q2 & 255) << 16) | ((unsigned)(q3 & 255) << 24);
        }
      }
      *(uint4*)(p.ws + OFF_UT + (j >> 6) * 2048 + (isv ? 1024 : 0) + (j & 63) * 16) = make_uint4(w[0], w[1], w[2], w[3]); }
  }
  const long gw = gtid >> 6, nw = gthreads >> 6; const int lane = (int)(gtid & 63);
  for (long t = gw; t < T; t += 2 * nw) {
    const long t2 = t + nw; const bool has2 = t2 < T;
    const float4* x = (const float4*)xrow(p, (int)t); const float4* y = (const float4*)xrow(p, (int)(has2 ? t2 : t));
    float4 v[4], w[4]; float ss = 0, s2 = 0;
#pragma unroll
    for (int i = 0; i < 4; ++i) { v[i] = x[lane + 64 * i]; w[i] = y[lane + 64 * i]; }
#pragma unroll
    for (int i = 0; i < 4; ++i) { ss += v[i].x * v[i].x + v[i].y * v[i].y + v[i].z * v[i].z + v[i].w * v[i].w; s2 += w[i].x * w[i].x + w[i].y * w[i].y + w[i].z * w[i].z + w[i].w * w[i].w; }
    ss = wave_sum(ss); s2 = wave_sum(s2);
    if (lane == 0) { ((float*)(p.ws + OFF_RSTD1))[t] = rsqrtf(ss * (1.f / 1024.f) + EPS); if (has2) ((float*)(p.ws + OFF_RSTD1))[t2] = rsqrtf(s2 * (1.f / 1024.f) + EPS); }
    bfu* xb = (bfu*)(p.ws + OFF_XB) + t * 1024; bfu* yb = (bfu*)(p.ws + OFF_XB) + t2 * 1024;
#pragma unroll
    for (int i = 0; i < 4; ++i) *(uint2*)(xb + (lane + 64 * i) * 4) = make_uint2(cvtpk(v[i].x, v[i].y), cvtpk(v[i].z, v[i].w));
    if (has2) {
#pragma unroll
      for (int i = 0; i < 4; ++i) *(uint2*)(yb + (lane + 64 * i) * 4) = make_uint2(cvtpk(w[i].x, w[i].y), cvtpk(w[i].z, w[i].w));
    }
  }
}

constexpr int FOLD_LDS = (128 * 129 + 64 * 128) * 4;
__device__ __forceinline__ void prep_foldkeys(const P& p, char* lds, int bid, int nb) {
  float* sk = (float*)lds; float* wqs = sk + 128 * 129;
  const int tid = tidx(), key = tid & 127, kkg = tid >> 7;
  for (int tile = bid; tile < 256; tile += nb) {
    const int g = tile >> 4, kk0 = (tile & 15) * 64;
    __syncthreads();
#pragma unroll
    for (int i = 0; i < 8; ++i) { const int e = tid + 512 * i, row = e >> 5, c4 = e & 31;
      const float4 v = *(const float4*)(p.subk + ((size_t)(g * 128 + row) * 128 + c4 * 4));
      float* d = sk + row * 129 + c4 * 4; d[0] = v.x; d[1] = v.y; d[2] = v.z; d[3] = v.w; }
#pragma unroll
    for (int i = 0; i < 4; ++i) { const int e = tid + 512 * i, row = e >> 5, c4 = e & 31;
      *(float4*)(wqs + row * 128 + c4 * 4) = *(const float4*)(p.wq + ((size_t)(kk0 + row) * 2048 + g * 128 + c4 * 4)); }
    __syncthreads();
    float acc[16];
#pragma unroll
    for (int i = 0; i < 16; ++i) acc[i] = 0.f;
    for (int d4 = 0; d4 < 32; ++d4) {
      const float a0 = sk[key * 129 + d4 * 4], a1 = sk[key * 129 + d4 * 4 + 1], a2 = sk[key * 129 + d4 * 4 + 2], a3 = sk[key * 129 + d4 * 4 + 3];
#pragma unroll
      for (int i = 0; i < 16; ++i) { const float4 w = *(const float4*)(wqs + (kkg * 16 + i) * 128 + d4 * 4); acc[i] += a0 * w.x + a1 * w.y + a2 * w.z + a3 * w.w; }
    }
    float v[8], w8[8];
#pragma unroll
    for (int i = 0; i < 8; ++i) { v[i] = acc[i] * p.norm2_g[kk0 + kkg * 16 + i]; w8[i] = acc[8 + i] * p.norm2_g[kk0 + kkg * 16 + 8 + i]; }
    uint4* dst = (uint4*)((bfu*)(p.ws + OFF_WPQ) + (size_t)(g * 128 + key) * 1024 + kk0 + kkg * 16);
    dst[0] = pack8(v); dst[1] = pack8(w8);
  }
}

namespace pg8 {
#define PG8_LAS __attribute__((address_space(3)))
typedef unsigned short bf16_t;
typedef short bf16x8 __attribute__((ext_vector_type(8)));
typedef float f32x4 __attribute__((ext_vector_type(4)));
typedef unsigned u32x4 __attribute__((ext_vector_type(4)));
constexpr int BM = 256, BK = 64, HALF = 128, HTB = HALF * BK * 2  , STAGE_BYTES = 8 * HTB, NXCD = 8, WGM = 8;

__host__ __device__ __forceinline__ int lds_byte(int r, int c) { const int st = (r >> 4) * 2 + (c >> 5), rr = r & 15, cc = c & 31, ob = rr * 64 + cc * 2; return st * 1024 + (ob ^ (((ob >> 9) & 1) << 5)); }
__host__ __device__ __forceinline__ void stage_rc(int b, int& R, int& C) { const int st = b / 1024, sb = b % 1024, swz = sb ^ (((sb >> 9) & 1) << 5); R = (st >> 1) * 16 + swz / 64; C = (st & 1) * 32 + (swz % 64) / 2; }
__host__ __device__ __forceinline__ int perm32(int rho) { const int n = rho >> 4, i = rho & 15; return 8 * (i >> 2) + 4 * n + (i & 3); }

struct Unit { int pm, pn; };
struct Gemm { const bf16_t* A; const bf16_t* Bt; int M, N, K; };

struct StaticOrder {
    int nM, nN, nwg, G, c;
    __host__ __device__ void init(int M, int N, int G_, int c_) { nM = M / BM; nN = N / BM; nwg = nM * nN; G = G_; c = c_; }
    __host__ __device__ bool next(int i, Unit& u) const {
        const long L = (long)i * G + c; if (L >= nwg) return false;
        int wgid = (int)L; { const int q = nwg / NXCD, r = nwg % NXCD, xcd = wgid % NXCD, off = wgid / NXCD; wgid = (xcd < r ? xcd * (q + 1) : r * (q + 1) + (xcd - r) * q) + off; }
        const int nig = WGM * nN, gid = wgid / nig, fm = gid * WGM, gsz = (nM - fm) < WGM ? (nM - fm) : WGM;
        u.pm = fm + ((wgid % nig) % gsz); u.pn = (wgid % nig) / gsz; return true;
    }
    __device__ __forceinline__ void a_ready(const Unit&) const {}
    __device__ __forceinline__ void done(const Unit&) const {}
};
template <class Epi, class Sched, bool STAMP = false>
__device__ __forceinline__ void gemm_phase(PG8_LAS unsigned char* lds, const Gemm g, const Sched& S, const Epi& E, unsigned long long* stamps) {
    const int tid = tidx(), wid = __builtin_amdgcn_readfirstlane(tid >> 6), lane = tid & 63, wr = wid >> 2, wc = wid & 3, fr = lane & 15, fq = lane >> 4;
    const int K = g.K, nt = K / BK;
    int ts_lo = 0, ts_hi = 0, nts = 0; const unsigned long long rt_entry = STAMP ? (unsigned long long)wall_clock64() : 0ull;
#define PG8_STAMP() do { if (STAMP && wid == 0 && nts < 64) { const unsigned long long _c = (unsigned long long)clock64(); \
        ts_lo = (lane == nts) ? (int)(unsigned)_c : ts_lo; ts_hi = (lane == nts) ? (int)(unsigned)(_c >> 32) : ts_hi; ++nts; } } while (0)
    PG8_STAMP();
    unsigned voffA[2], voffB[2];
#pragma unroll
    for (int i = 0; i < 2; ++i) { int R, C; stage_rc(tid * 16 + i * 8192, R, C); const int Rb = Epi::PERM ? ((R & ~31) + perm32(R & 31)) : R;
        voffA[i] = (unsigned)(R * K + C) * 2u; voffB[i] = (unsigned)(Rb * K + C) * 2u; }
    const size_t kstep = (size_t)(BK * 2);
    const size_t hstep = (size_t)HALF * K * 2;
    const size_t tstep = 2 * hstep;
    const unsigned ldsw = (unsigned)wid * 1024u;
    const int aoff = lds_byte(wr * 64 + fr, fq * 8), boff = lds_byte(wc * 32 + fr, fq * 8);
#define PG8_SA(b, h) (((b) * 2 + (h)) * HTB)
#define PG8_SB(b, h) ((4 + (b) * 2 + (h)) * HTB)
#define PG8_STAGE(bufoff, gbase, voff) do { _Pragma("unroll") for (int _i = 0; _i < 2; ++_i) \
        __builtin_amdgcn_global_load_lds((const unsigned*)((const char*)(gbase) + (voff)[_i]), (PG8_LAS unsigned*)(lds + (bufoff) + ldsw + _i * 8192), 16, 0, 0); } while (0)
#define PG8_LDA(dst, b, h) do { _Pragma("unroll") for (int m = 0; m < 4; ++m) _Pragma("unroll") for (int k = 0; k < 2; ++k) dst[m][k] = *(const PG8_LAS bf16x8*)(lds + PG8_SA(b, h) + aoff + m * 2048 + k * 1024); } while (0)
#define PG8_LDB(dst, b, h) do { _Pragma("unroll") for (int n = 0; n < 2; ++n) _Pragma("unroll") for (int k = 0; k < 2; ++k) dst[n][k] = *(const PG8_LAS bf16x8*)(lds + PG8_SB(b, h) + boff + n * 2048 + k * 1024); } while (0)
#define PG8_MMA(ai, bj, At, Bt) do { __builtin_amdgcn_s_setprio(1); _Pragma("unroll") for (int m = 0; m < 4; ++m) _Pragma("unroll") for (int n = 0; n < 2; ++n) _Pragma("unroll") for (int k = 0; k < 2; ++k) \
        acc[ai][bj][m][n] = __builtin_amdgcn_mfma_f32_16x16x32_bf16(Bt[n][k], At[m][k], acc[ai][bj][m][n], 0, 0, 0); __builtin_amdgcn_s_setprio(0); } while (0)
#define PG8_WAIT_V(n) asm volatile("s_waitcnt vmcnt(" #n ")" ::: "memory")
#define PG8_WAIT_L(n) asm volatile("s_waitcnt lgkmcnt(" #n ")" ::: "memory")
#define PG8_BAR __builtin_amdgcn_s_barrier()
#define PG8_SCHED __builtin_amdgcn_sched_barrier(0)
    Unit cur, nxt; int ui = 0;
    if (!S.next(0, cur)) return;
    f32x4 acc[2][2][4][2];
#pragma unroll
    for (int a = 0; a < 2; ++a)
#pragma unroll
        for (int b = 0; b < 2; ++b)
#pragma unroll
            for (int m = 0; m < 4; ++m)
#pragma unroll
                for (int n = 0; n < 2; ++n) acc[a][b][m][n] = (f32x4){0.f, 0.f, 0.f, 0.f};
    bf16x8 At[4][2], B0[2][2], B1[2][2];
    const char* cA = (const char*)g.A + (size_t)cur.pm * tstep; const char* cB = (const char*)g.Bt + (size_t)cur.pn * tstep;
    S.a_ready(cur);
    PG8_STAGE(PG8_SB(0, 0), cB, voffB); PG8_STAGE(PG8_SA(0, 0), cA, voffA); PG8_STAGE(PG8_SB(0, 1), cB + hstep, voffB); PG8_STAGE(PG8_SA(0, 1), cA + hstep, voffA);
    if (wr == 1) PG8_BAR;
    PG8_WAIT_V(4); PG8_BAR;
    PG8_STAGE(PG8_SB(1, 0), cB + kstep, voffB); PG8_STAGE(PG8_SA(1, 0), cA + kstep, voffA); PG8_STAGE(PG8_SB(1, 1), cB + hstep + kstep, voffB);
    PG8_WAIT_V(6); PG8_BAR;
    PG8_STAMP();
    for (;;) {
        const bool has_next = S.next(ui + 1, nxt);
        const char* nA = has_next ? (const char*)g.A + (size_t)nxt.pm * tstep : cA; const char* nB = has_next ? (const char*)g.Bt + (size_t)nxt.pn * tstep : cB;
        for (int t = 0; t < nt; t += 2) {
            const bool last = (t == nt - 2);
            const char* a1 = cA + (size_t)(t + 1) * kstep;
            const char* a2 = last ? nA : cA + (size_t)(t + 2) * kstep; const char* b2 = last ? nB : cB + (size_t)(t + 2) * kstep;
            const char* a3 = a2 + kstep; const char* b3 = b2 + kstep;
            if (last && has_next) S.a_ready(nxt);
            PG8_LDB(B0, 0, 0); PG8_SCHED; PG8_LDA(At, 0, 0); PG8_STAGE(PG8_SA(1, 1), a1 + hstep, voffA);
            PG8_WAIT_L(8); PG8_BAR; PG8_WAIT_L(0); PG8_MMA(0, 0, At, B0); PG8_BAR; PG8_SCHED;
            PG8_LDB(B1, 0, 1); PG8_STAGE(PG8_SB(0, 0), b2, voffB);
            PG8_BAR; PG8_WAIT_L(0); PG8_MMA(0, 1, At, B1); PG8_BAR;
            PG8_LDA(At, 0, 1); PG8_STAGE(PG8_SA(0, 0), a2, voffA);
            PG8_BAR; PG8_WAIT_L(0); PG8_MMA(1, 0, At, B0); PG8_BAR; PG8_SCHED;
            PG8_STAGE(PG8_SB(0, 1), b2 + hstep, voffB);
            PG8_WAIT_V(6); PG8_BAR; PG8_MMA(1, 1, At, B1); PG8_BAR;
            PG8_LDB(B0, 1, 0); PG8_SCHED; PG8_LDA(At, 1, 0); PG8_STAGE(PG8_SA(0, 1), a2 + hstep, voffA);
            PG8_WAIT_L(8); PG8_BAR; PG8_WAIT_L(0); PG8_MMA(0, 0, At, B0); PG8_BAR; PG8_SCHED;
            PG8_LDB(B1, 1, 1); PG8_STAGE(PG8_SB(1, 0), b3, voffB);
            PG8_BAR; PG8_WAIT_L(0); PG8_MMA(0, 1, At, B1); PG8_BAR;
            PG8_LDA(At, 1, 1); PG8_STAGE(PG8_SA(1, 0), a3, voffA);
            PG8_BAR; PG8_WAIT_L(0); PG8_MMA(1, 0, At, B0); PG8_BAR; PG8_SCHED;
            PG8_STAGE(PG8_SB(1, 1), b3 + hstep, voffB);
            PG8_WAIT_V(6); PG8_BAR; PG8_MMA(1, 1, At, B1); PG8_BAR;
        }
        PG8_STAMP();
        if constexpr (!Epi::AFTER_DRAIN) { E(acc, cur, wr, wc, fr, fq); S.done(cur); }
        PG8_STAMP();
        if (!has_next) break;
#pragma unroll
        for (int a = 0; a < 2; ++a)
#pragma unroll
            for (int b = 0; b < 2; ++b)
#pragma unroll
                for (int m = 0; m < 4; ++m)
#pragma unroll
                    for (int n = 0; n < 2; ++n) acc[a][b][m][n] = (f32x4){0.f, 0.f, 0.f, 0.f};
        cur = nxt; cA = nA; cB = nB; ++ui;
    }
    PG8_WAIT_V(0);
    if (wr == 0) PG8_BAR;
    PG8_BAR;
    if constexpr (Epi::AFTER_DRAIN) { E.fused(acc, cur, wr, wc, fr, fq, lds, wid, lane); S.done(cur); }
    PG8_STAMP();
    if (STAMP && wid == 0) { stamps[lane] = lane < nts ? (((unsigned long long)(unsigned)ts_hi << 32) | (unsigned)ts_lo) : 0ull;
        if (lane == 62) stamps[62] = rt_entry; if (lane == 63) stamps[63] = (unsigned long long)wall_clock64(); }
#undef PG8_STAMP
#undef PG8_SA
#undef PG8_SB
#undef PG8_STAGE
#undef PG8_LDA
#undef PG8_LDB
#undef PG8_MMA
#undef PG8_WAIT_V
#undef PG8_WAIT_L
#undef PG8_BAR
#undef PG8_SCHED
}
}
__device__ __forceinline__ float x4sum(float v) {
  auto r1 = __builtin_amdgcn_permlane16_swap(__float_as_uint(v), __float_as_uint(v), false, false);
  const float s = __uint_as_float(r1[0]) + __uint_as_float(r1[1]);
  auto r2 = __builtin_amdgcn_permlane32_swap(__float_as_uint(s), __float_as_uint(s), false, false);
  return __uint_as_float(r2[0]) + __uint_as_float(r2[1]);
}
__device__ __forceinline__ float other32(float v, bool upper) {
  auto rr = __builtin_amdgcn_permlane32_swap(__float_as_uint(v), __float_as_uint(v), false, false);
  return __uint_as_float(upper ? rr[0] : rr[1]);
}
__device__ __forceinline__ void rope8(float (&v)[8], const float2* rope, int pos, int fq) {
  const bool upper = fq >= 2;
  const float4* cs4 = (const float4*)(rope + pos * 16 + (fq & 1) * 8);
#pragma unroll
  for (int q = 0; q < 4; ++q) {
    const float4 c2 = cs4[q];
    const float o0 = other32(v[2 * q], upper), o1 = other32(v[2 * q + 1], upper);
    v[2 * q] = upper ? (v[2 * q] * c2.x + o0 * c2.y) : (v[2 * q] * c2.x - o0 * c2.y);
    v[2 * q + 1] = upper ? (v[2 * q + 1] * c2.z + o1 * c2.w) : (v[2 * q + 1] * c2.z - o1 * c2.w);
  }
}
typedef unsigned ntu4 __attribute__((ext_vector_type(4)));
__device__ __forceinline__ void st_nt(void* d, const uint4 v) { const ntu4 w = {v.x, v.y, v.z, v.w}; __builtin_nontemporal_store(w, (ntu4*)d); }
struct EpiG1 {
  static constexpr bool PERM = true, AFTER_DRAIN = false;
  char* ws;
  __device__ __forceinline__ void operator()(const pg8::f32x4 (&acc)[2][2][4][2], const pg8::Unit& u, int wr, int wc, int fr, int fq) const {
    const float* rstd1 = (const float*)(ws + OFF_RSTD1);
    const int pn = u.pn, colh = wc * 32 + fq * 8;
    float rs8[8];
#pragma unroll
    for (int i = 0; i < 8; ++i) rs8[i] = rstd1[u.pm * 256 + (i >> 2) * 128 + wr * 64 + (i & 3) * 16 + fr];
#pragma unroll
    for (int ai = 0; ai < 2; ++ai)
#pragma unroll
      for (int m = 0; m < 4; ++m) {
        __builtin_amdgcn_sched_barrier(0);
        const int r = u.pm * 256 + ai * 128 + wr * 64 + m * 16 + fr;
        const float rs = rs8[ai * 4 + m];
        float ss = 0.f;
#pragma unroll
        for (int bj = 0; bj < 2; ++bj) {
          float v[8];
#pragma unroll
          for (int e = 0; e < 4; ++e) { v[e] = acc[ai][bj][m][0][e] * rs; v[4 + e] = acc[ai][bj][m][1][e] * rs; }
          if (pn == 1 && bj == 1) {
            if (wc == 0) { rope8(v, (const float2*)(ws + OFF_ROPE), r & (SEQ - 1), fq); *(uint4*)((bfu*)(ws + OFF_KR) + (size_t)r * 32 + fq * 8) = pack8(v); }
            else if (wc == 1) { float4* g = (float4*)((float*)(ws + OFF_GLR) + (size_t)r * 32 + fq * 8); g[0] = make_float4(v[0], v[1], v[2], v[3]); g[1] = make_float4(v[4], v[5], v[6], v[7]); }
          } else {
            unsigned base, ld, cb;
            if (pn == 0) { base = (unsigned)OFF_CQKV; ld = 384; cb = bj * 128; }
            else if (pn == 1) { base = (unsigned)OFF_CQKV; ld = 384; cb = 256; }
            else if (pn == 2) { base = (unsigned)OFF_GQ; ld = 256; cb = bj * 128; }
            else if (pn == 3) { base = (unsigned)OFF_GK; ld = 256; cb = bj * 128; }
            else if (pn < 6) { base = (unsigned)OFF_GV; ld = 512; cb = (pn - 4) * 256 + bj * 128; }
            else { base = (unsigned)OFF_GOUT; ld = 512; cb = (pn - 6) * 256 + bj * 128; }
            st_nt(ws + (base + ((unsigned)r * ld + cb + (unsigned)colh) * 2u), pack8(v));
#pragma unroll
            for (int e = 0; e < 8; ++e) ss += v[e] * v[e];
          }
        }
        if (pn <= 1) {
          ss = x4sum(ss);
          if (fq == 0) ((float*)(ws + (pn == 0 ? OFF_SSQ : OFF_SSKV)))[(size_t)r * 4 + wc] = ss;
        }
      }
  }
};
struct EpiG2 {
  static constexpr bool PERM = true, AFTER_DRAIN = false;
  char* ws;
  __device__ __forceinline__ void operator()(const pg8::f32x4 (&acc)[2][2][4][2], const pg8::Unit& u, int wr, int wc, int fr, int fq) const {
    const int pn = u.pn;
    float rs8[8];
    {
      float4 s8[8];
#pragma unroll
      for (int i = 0; i < 8; ++i) s8[i] = ((const float4*)(ws + (pn < 3 ? OFF_SSQ : OFF_SSKV)))[u.pm * 256 + (i >> 2) * 128 + wr * 64 + (i & 3) * 16 + fr];
#pragma unroll
      for (int i = 0; i < 8; ++i) rs8[i] = rsqrtf((s8[i].x + s8[i].y + s8[i].z + s8[i].w) * (pn < 3 ? (1.f / 256.f) : (1.f / 128.f)) + EPS);
    }
#pragma unroll
    for (int ai = 0; ai < 2; ++ai)
#pragma unroll
      for (int m = 0; m < 4; ++m) {
        __builtin_amdgcn_sched_barrier(0);
        const int r = u.pm * 256 + ai * 128 + wr * 64 + m * 16 + fr;
        const float rs = rs8[ai * 4 + m];
#pragma unroll
        for (int bj = 0; bj < 2; ++bj) {
          float v[8];
#pragma unroll
          for (int e = 0; e < 4; ++e) { v[e] = acc[ai][bj][m][0][e] * rs; v[4 + e] = acc[ai][bj][m][1][e] * rs; }
          if (pn < 3) {
            const int g0 = pn * 256 + bj * 128 + wc * 32;
#pragma unroll
            for (int e = 0; e < 8; ++e) v[e] *= ATT_QSCALE;
            if (g0 % 96 == 64) rope8(v, (const float2*)(ws + OFF_ROPE), r & (SEQ - 1), fq);
            st_nt((bfu*)(ws + OFF_QF) + ((size_t)(g0 >> 5) * T + r) * 32 + fq * 8, pack8(v));
          } else {
            st_nt((bfu*)(ws + OFF_KV) + ((size_t)(((r >> 11) * 8 + (pn - 3) * 2 + bj) * 4 + wc) * 2048 + (r & 2047)) * 32 + fq * 8, pack8(v));
          }
        }
      }
  }
};
struct EpiG4 {
  static constexpr bool PERM = true, AFTER_DRAIN = false;
  const P* pp;
  __device__ __forceinline__ void operator()(const pg8::f32x4 (&acc)[2][2][4][2], const pg8::Unit& u, int wr, int wc, int fr, int fq) const {
    const P& p = *pp;
    pg8::u32x4 xin[8];
#define G4_LOADX(IT) _Pragma("unroll") for (int bj = 0; bj < 2; ++bj) \
      xin[((IT) & 3) * 2 + bj] = *(const pg8::u32x4*)(p.ws + ((unsigned)OFF_HB + ((unsigned)(u.pm * 256 + ((IT) >> 2) * 128 + wr * 64 + ((IT) & 3) * 16 + fr) * 1024u + (unsigned)(u.pn * 256 + bj * 128 + wc * 32 + fq * 8)) * 2u));
    G4_LOADX(0) G4_LOADX(1) G4_LOADX(2) G4_LOADX(3)
#pragma unroll
    for (int ai = 0; ai < 2; ++ai) {
#pragma unroll
      for (int m = 0; m < 4; ++m) {
        __builtin_amdgcn_sched_barrier(0);
        const int r = u.pm * 256 + ai * 128 + wr * 64 + m * 16 + fr;
        float ss = 0.f;
#pragma unroll
        for (int bj = 0; bj < 2; ++bj) {
          const int c = u.pn * 256 + bj * 128 + wc * 32 + fq * 8;
          uint4* hx = (uint4*)(p.ws + ((unsigned)OFF_HB + ((unsigned)r * 1024u + (unsigned)c) * 2u));
          const pg8::u32x4 xw = xin[((ai * 4 + m) & 3) * 2 + bj]; const unsigned xs[4] = {xw[0], xw[1], xw[2], xw[3]};
          float v[8];
#pragma unroll
          for (int e = 0; e < 4; ++e) { v[2 * e] = __uint_as_float(xs[e] << 16) + acc[ai][bj][m][e >> 1][(2 * e) & 3]; v[2 * e + 1] = __uint_as_float(xs[e] & 0xffff0000u) + acc[ai][bj][m][e >> 1][(2 * e + 1) & 3]; }
          *hx = pack8(v);
#pragma unroll
          for (int e = 0; e < 8; ++e) ss += v[e] * v[e];
        }
        ss = x4sum(ss);
        if (fq == 0) ((float*)(p.ws + OFF_SS2))[(size_t)r * 16 + u.pn * 4 + wc] = ss;
        if (ai == 0) { G4_LOADX(4 + m) }
      }
    }
#undef G4_LOADX
  }
};
__device__ __forceinline__ unsigned pkf16(float a, float b) { typedef _Float16 hh2 __attribute__((ext_vector_type(2))); const hh2 h = {(_Float16)a, (_Float16)b}; return __builtin_bit_cast(unsigned, h); }
struct EpiG5 {
  static constexpr bool PERM = true, AFTER_DRAIN = false;
  char* ws;
  __device__ __forceinline__ void operator()(const pg8::f32x4 (&acc)[2][2][4][2], const pg8::Unit& u, int wr, int wc, int fr, int fq) const {
#pragma unroll
    for (int ai = 0; ai < 2; ++ai)
#pragma unroll
      for (int m = 0; m < 4; ++m) {
        const int r = u.pm * 256 + ai * 128 + wr * 64 + m * 16 + fr;
#pragma unroll
        for (int bj = 0; bj < 2; ++bj) {
          float v[8];
#pragma unroll
          for (int e = 0; e < 4; ++e) { v[e] = acc[ai][bj][m][0][e]; v[4 + e] = acc[ai][bj][m][1][e]; }
          st_nt(ws + ((unsigned)OFF_PQ + ((((((unsigned)r >> 6) * 16u + (unsigned)(u.pn * 2 + bj)) * 4u + (unsigned)wc) * 64u + ((unsigned)r & 63u)) * 32u + (unsigned)(fq * 8)) * 2u), make_uint4(pkf16(v[0], v[1]), pkf16(v[2], v[3]), pkf16(v[4], v[5]), pkf16(v[6], v[7])));
        }
      }
  }
};
template <class Epi>
__device__ __forceinline__ void run_gemm(PG8_LAS unsigned char* lds, const bfu* A, const bfu* Bt, int M, int N, int K, const Epi& E, int bid, int nb) {
  asm volatile("" : "+s"(K));
  pg8::Gemm g; g.A = A; g.Bt = Bt; g.M = M; g.N = N; g.K = K;
  pg8::StaticOrder S; S.init(M, N, nb, bid);
  pg8::gemm_phase<Epi, pg8::StaticOrder, false>(lds, g, S, E, nullptr);
}

using s16x4  = __attribute__((ext_vector_type(4))) short;
using u32x4  = __attribute__((ext_vector_type(4))) unsigned;
constexpr float ATT_SCALE = 0.10206207261596577f;
constexpr float ATT_THR = 8.f;
constexpr int ATT_SHM_V = 64 * 64 * 2, ATT_SHM_K = 64 * 256, ATT_LDS = 2 * ATT_SHM_V + 2 * ATT_SHM_K + 8 * 64 * 4;
#define KSWZ(row, colB) ((row) * 256 + ((colB) ^ (((row) & 7) << 4)))
#define SBAR() __builtin_amdgcn_sched_barrier(0)
__device__ __forceinline__ int crow(int r, int hi) { return (r & 3) + 8 * (r >> 2) + 4 * hi; }
__device__ __forceinline__ void att_partialSM(f32x16& p0, f32x16& p1, float& m_run, float& alpha, bool first) {
  constexpr float THR2 = ATT_THR * 1.4426950408889634f;
  float pmax = fmaxf(fmaxf(p0[0], p0[1]), p0[2]);
#pragma unroll
  for (int r = 3; r < 15; r += 2) pmax = fmaxf(fmaxf(pmax, p0[r]), p0[r + 1]);
  pmax = fmaxf(pmax, p0[15]);
#pragma unroll
  for (int r = 0; r < 16; r += 2) pmax = fmaxf(fmaxf(pmax, p1[r]), p1[r + 1]);
  { auto rr = __builtin_amdgcn_permlane32_swap(__float_as_uint(pmax), __float_as_uint(pmax), false, false);
    pmax = fmaxf(__uint_as_float(rr[0]), __uint_as_float(rr[1])); }
  if (__builtin_expect(!first && __all(pmax <= THR2), 1)) { alpha = 1.f; }
  else {
    const float dlt = first ? pmax : fmaxf(pmax, 0.f);
    alpha = first ? 1.f : __builtin_amdgcn_exp2f(-dlt); m_run += dlt;
#pragma unroll
    for (int r = 0; r < 16; ++r) { p0[r] -= dlt; p1[r] -= dlt; }
  }
#pragma unroll
  for (int r = 0; r < 16; ++r) p0[r] = __builtin_amdgcn_exp2f(p0[r]);
}
__device__ __forceinline__ void att_finishSM(f32x16& p0, f32x16& p1, float alpha, float& l_reg, bf16x8& pa0, bf16x8& pa1, bf16x8& pa2, bf16x8& pa3) {
#pragma unroll
  for (int r = 0; r < 16; ++r) p1[r] = __builtin_amdgcn_exp2f(p1[r]);
  float ps = 0;
#pragma unroll
  for (int r = 0; r < 16; ++r) ps += p0[r];
#pragma unroll
  for (int r = 0; r < 16; ++r) ps += p1[r];
  { auto rr = __builtin_amdgcn_permlane32_swap(__float_as_uint(ps), __float_as_uint(ps), false, false);
    ps = __uint_as_float(rr[0]) + __uint_as_float(rr[1]); }
  l_reg = l_reg * alpha + ps;
#define PK4(PP, BASE, OUT) do { unsigned a0 = cvtpk(PP[BASE + 0], PP[BASE + 1]), a1 = cvtpk(PP[BASE + 2], PP[BASE + 3]);   \
    unsigned b0 = cvtpk(PP[BASE + 4], PP[BASE + 5]), b1 = cvtpk(PP[BASE + 6], PP[BASE + 7]);                              \
    auto r0 = __builtin_amdgcn_permlane32_swap(a0, b0, false, false); auto r1 = __builtin_amdgcn_permlane32_swap(a1, b1, false, false); \
    u32x4 w = {r0[0], r1[0], r0[1], r1[1]}; OUT = *reinterpret_cast<bf16x8*>(&w); } while (0)
  PK4(p0, 0, pa0); PK4(p0, 8, pa1); PK4(p1, 0, pa2); PK4(p1, 8, pa3);
#undef PK4
}
__device__ __forceinline__ void att_qkt(f32x16& p0, f32x16& p1, const char* Ks, const bf16x8* qr, int r32, int hi, float init) {
#pragma unroll
  for (int r = 0; r < 16; ++r) { p0[r] = init; p1[r] = init; }
#pragma unroll
  for (int d0 = 0; d0 < 6; ++d0) { int cb = (d0 * 16 + hi * 8) * 2;
    bf16x8 b0 = *reinterpret_cast<const bf16x8*>(Ks + KSWZ(r32, cb));
    bf16x8 b1 = *reinterpret_cast<const bf16x8*>(Ks + KSWZ(32 + r32, cb));
    p0 = __builtin_amdgcn_mfma_f32_32x32x16_bf16(b0, qr[d0], p0, 0, 0, 0);
    p1 = __builtin_amdgcn_mfma_f32_32x32x16_bf16(b1, qr[d0], p1, 0, 0, 0); }
}
__device__ __forceinline__ int att_v_st(int k, int c) { const int kk = (k & ~0xC) | ((k & 4) << 1) | ((k & 8) >> 1); return ((kk >> 3) * 2 + (c >> 5)) * 512 + ((kk & 7) * 32 + (c & 31)) * 2; }
__device__ __forceinline__ int att_v_rd_base(int lane) { return ((lane & 3) << 3) | (((lane >> 2) & 3) << 6) | (((lane >> 4) & 1) << 5) | (((lane >> 5) & 1) << 8); }
constexpr int att_v_rd_off(int d0, int ks, int half) { return d0 * 512 + ks * 2048 + half * 1024; }
template <int OFF> __device__ __forceinline__ s16x4 att_tr_read(int vb) {
  s16x4 r; asm volatile("ds_read_b64_tr_b16 %0, %1 offset:%2" : "=&v"(r) : "v"(vb), "i"(OFF) : "memory"); return r;
}
template <int D0> __device__ __forceinline__ void att_pv_one(f32x16& od, int vb, bf16x8 pa0, bf16x8 pa1, bf16x8 pa2, bf16x8 pa3) {
  const s16x4 l0 = att_tr_read<att_v_rd_off(D0, 0, 0)>(vb), h0 = att_tr_read<att_v_rd_off(D0, 0, 1)>(vb), l1 = att_tr_read<att_v_rd_off(D0, 1, 0)>(vb), h1 = att_tr_read<att_v_rd_off(D0, 1, 1)>(vb);
  const s16x4 l2 = att_tr_read<att_v_rd_off(D0, 2, 0)>(vb), h2 = att_tr_read<att_v_rd_off(D0, 2, 1)>(vb), l3 = att_tr_read<att_v_rd_off(D0, 3, 0)>(vb), h3 = att_tr_read<att_v_rd_off(D0, 3, 1)>(vb);
  asm volatile("s_waitcnt lgkmcnt(0)" ::: "memory"); SBAR();
#define PK(L, H) (bf16x8){L[0], L[1], L[2], L[3], H[0], H[1], H[2], H[3]}
  od = __builtin_amdgcn_mfma_f32_32x32x16_bf16(pa0, PK(l0, h0), od, 0, 0, 0);
  od = __builtin_amdgcn_mfma_f32_32x32x16_bf16(pa1, PK(l1, h1), od, 0, 0, 0);
  od = __builtin_amdgcn_mfma_f32_32x32x16_bf16(pa2, PK(l2, h2), od, 0, 0, 0);
  od = __builtin_amdgcn_mfma_f32_32x32x16_bf16(pa3, PK(l3, h3), od, 0, 0, 0);
#undef PK
}
__device__ __forceinline__ void attn_item(const P& p, char* lds, int seq, int h, int qb) {
  const int tid = tidx(), wid = tid >> 6, lane = tid & 63, r32 = lane & 31, hi = lane >> 5;
  char* V_lds = lds; char* K_lds = lds + 2 * ATT_SHM_V;
  float* wsl = (float*)(lds + 2 * ATT_SHM_V + 2 * ATT_SHM_K) + wid * 64; float* li_l = wsl; float* al_l = wsl + 32;
  const size_t tb = (size_t)seq * SEQ;
  const bfu* QF = (const bfu*)(p.ws + OFF_QF); const bfu* KVg = (const bfu*)(p.ws + OFF_KV) + ((size_t)seq * 8 + h) * 4 * 2048 * 32; const bfu* KRg = (const bfu*)(p.ws + OFF_KR) + tb * 32;
  float m_run = 0.f, l_reg = 0; f32x16 o[2] = {}; bf16x8 qr[6];
  const bfu* Qw = QF + (tb + qb * 256 + wid * 32 + r32) * 32 + hi * 8;
#pragma unroll
  for (int d0 = 0; d0 < 6; ++d0) qr[d0] = *reinterpret_cast<const bf16x8*>(Qw + (size_t)(h * 3 + (d0 >> 1)) * T * 32 + (d0 & 1) * 16);
  const int sk = tid >> 3, sch = tid & 7, rk = (tid >> 2) & 63, rch = tid & 3;
  const int vst = att_v_st(sk, sch * 8), kst = KSWZ(sk, sch * 16), rst = KSWZ(rk, 128 + rch * 16);
  const int vb0 = (int)(uintptr_t)V_lds + att_v_rd_base(lane);
  struct { bf16x8 v, k, r; } sr_[2];
#define SLOAD(i, k0) do { sr_[i].v = *reinterpret_cast<const bf16x8*>(KVg + ((size_t)(2 + (sch >> 2)) * 2048 + (k0) + sk) * 32 + (sch & 3) * 8); \
    sr_[i].k = *reinterpret_cast<const bf16x8*>(KVg + ((size_t)(sch >> 2) * 2048 + (k0) + sk) * 32 + (sch & 3) * 8);                              \
    if (tid < 256) sr_[i].r = *reinterpret_cast<const bf16x8*>(KRg + (size_t)((k0) + rk) * 32 + rch * 8); } while (0)
#define SWRITE(b, i) do { *(bf16x8*)(V_lds + (b) * ATT_SHM_V + vst) = sr_[i].v; *(bf16x8*)(K_lds + (b) * ATT_SHM_K + kst) = sr_[i].k; \
    if (tid < 256) *(bf16x8*)(K_lds + (b) * ATT_SHM_K + rst) = sr_[i].r; } while (0)
#define RESC(a) do { if (__any((a) < 1.f)) { if (hi == 0) al_l[r32] = (a); asm volatile("s_waitcnt lgkmcnt(0)" ::: "memory"); \
    for (int d = 0; d < 2; ++d) for (int r = 0; r < 16; ++r) o[d][r] *= al_l[crow(r, hi)]; } } while (0)
  f32x16 pA0, pA1, pB0, pB1; float alA, alB; bf16x8 pa0, pa1, pa2, pa3; constexpr int NT = SEQ / 64;
  constexpr int SE = 0, SO = 1;
  __syncthreads();
  SLOAD(SE, 0); asm volatile("s_waitcnt vmcnt(0)" ::: "memory"); SWRITE(0, SE); __syncthreads();
  att_qkt(pA0, pA1, K_lds, qr, r32, hi, 0.f); att_partialSM(pA0, pA1, m_run, alA, true);
  SLOAD(SO, 64); SLOAD(SE, 128);
  asm volatile("s_waitcnt vmcnt(3)" ::: "memory"); SWRITE(1, SO); __syncthreads();
  for (int j = 1; j + 1 < NT; j += 2) {
    SBAR(); att_qkt(pB0, pB1, K_lds + ATT_SHM_K, qr, r32, hi, -m_run);
    att_finishSM(pA0, pA1, alA, l_reg, pa0, pa1, pa2, pa3); SBAR();
    SLOAD(SO, (j + 2) * 64); SBAR();
    att_pv_one<0>(o[0], vb0, pa0, pa1, pa2, pa3); att_pv_one<1>(o[1], vb0, pa0, pa1, pa2, pa3); att_partialSM(pB0, pB1, m_run, alB, false);
    __syncthreads(); asm volatile("s_waitcnt vmcnt(3)" ::: "memory"); SWRITE(0, SE);
    RESC(alB); __syncthreads();
    SBAR(); att_qkt(pA0, pA1, K_lds, qr, r32, hi, -m_run);
    att_finishSM(pB0, pB1, alB, l_reg, pa0, pa1, pa2, pa3); SBAR();
    if (j + 3 < NT) SLOAD(SE, (j + 3) * 64); SBAR();
    att_pv_one<0>(o[0], vb0 + ATT_SHM_V, pa0, pa1, pa2, pa3); att_pv_one<1>(o[1], vb0 + ATT_SHM_V, pa0, pa1, pa2, pa3); att_partialSM(pA0, pA1, m_run, alA, false);
    __syncthreads(); asm volatile("s_waitcnt vmcnt(3)" ::: "memory"); SWRITE(1, SO);
    RESC(alA); __syncthreads();
  }
  SBAR(); att_qkt(pB0, pB1, K_lds + ATT_SHM_K, qr, r32, hi, -m_run);
  att_finishSM(pA0, pA1, alA, l_reg, pa0, pa1, pa2, pa3); SBAR();
  att_pv_one<0>(o[0], vb0, pa0, pa1, pa2, pa3); att_pv_one<1>(o[1], vb0, pa0, pa1, pa2, pa3); att_partialSM(pB0, pB1, m_run, alB, false);
  __syncthreads(); RESC(alB);
  att_finishSM(pB0, pB1, alB, l_reg, pa0, pa1, pa2, pa3); SBAR();
  att_pv_one<0>(o[0], vb0 + ATT_SHM_V, pa0, pa1, pa2, pa3); att_pv_one<1>(o[1], vb0 + ATT_SHM_V, pa0, pa1, pa2, pa3);
  if (hi == 0) li_l[r32] = l_reg; asm volatile("s_waitcnt lgkmcnt(0)" ::: "memory");
  float rli[16];
#pragma unroll
  for (int r = 0; r < 16; ++r) rli[r] = __builtin_amdgcn_rcpf(li_l[crow(r, hi)]);
  bfu* Ow = (bfu*)(p.ws + OFF_MIX) + (tb + qb * 256 + wid * 32) * 1024 + h * 64;
#pragma unroll
  for (int r = 0; r < 16; ++r) { int orow = crow(r, hi);
#pragma unroll
    for (int d0 = 0; d0 < 2; ++d0) Ow[(size_t)orow * 1024 + d0 * 32 + r32] = f2bf(o[d0][r] * rli[r]); }
#undef SLOAD
#undef SWRITE
#undef RESC
}
constexpr int ATT_S0 = 6;
__device__ __forceinline__ void attn_phase(const P& p, char* lds, int bid, int nb) {
  const int x = bid & 7, i = bid >> 3, per = nb >> 3;
  if (per == 32) {
    const bool glab = i < 20;
    for (int sl = glab ? ATT_S0 : 0; ; ++sl) {
      const int k = sl < ATT_S0 ? sl * 12 + (i - 20) : ATT_S0 * 12 + (sl - ATT_S0) * 32 + (i + 12) % 32;
      if (k >= 320) break;
      const int pair = (k >> 3) * 8 + x;
      attn_item(p, lds, pair >> 3, pair & 7, k & 7);
    }
  } else {
    for (int j = i; j < 320; j += per) {
      const int pair = (j >> 3) * 8 + x, qb = j & 7;
      attn_item(p, lds, pair >> 3, pair & 7, qb);
    }
  }
}

constexpr int GL_QD = 0, GL_KI = 8192, GL_KDT = 16384, GL_QR = 24576, GL_KR = 32768, GL_VI = 40960, GL_GLR = 57344  , GL_SEG = 65536, GL_BL = 66560, GL_RSS = 66816, GL_DIR = 67840;
constexpr int GL_OLS = 132;
constexpr int GLA_LDS = 2 * GL_DIR;
static_assert(64 * GL_OLS * 4 <= GL_VI, "output tile must fit over the operand images (not over the V image: the next chunk's V lands there during the output stage)");
__device__ __forceinline__ int gl_sw(int row, int col) { return row * 128 + ((((col >> 3) ^ (row & 7))) << 4) + (col & 7) * 2; }
__device__ __forceinline__ int gl_v_st(int k, int c) { const int kk = (k & ~0xC) | ((k & 4) << 1) | ((k & 8) >> 1); return ((kk >> 3) * 4 + (c >> 5)) * 512 + ((kk & 7) * 32 + (c & 31)) * 2; }
template <int KS, int HALF> __device__ __forceinline__ s16x4 gl_tr(int vb) { return att_tr_read<KS * 4096 + HALF * 2048>(vb); }
#define GL_PK(L, H) (bf16x8){L[0], L[1], L[2], L[3], H[0], H[1], H[2], H[3]}
__device__ __forceinline__ void gl_pk4(const f32x16& P, int BASE_is8, bf16x8& OUT) {
  unsigned a0, a1, b0, b1;
  if (BASE_is8 == 0) { a0 = cvtpk(P[0], P[1]); a1 = cvtpk(P[2], P[3]); b0 = cvtpk(P[4], P[5]); b1 = cvtpk(P[6], P[7]); }
  else { a0 = cvtpk(P[8], P[9]); a1 = cvtpk(P[10], P[11]); b0 = cvtpk(P[12], P[13]); b1 = cvtpk(P[14], P[15]); }
  auto r0 = __builtin_amdgcn_permlane32_swap(a0, b0, false, false); auto r1 = __builtin_amdgcn_permlane32_swap(a1, b1, false, false);
  u32x4 w = {r0[0], r1[0], r0[1], r1[1]}; OUT = *reinterpret_cast<bf16x8*>(&w);
}
__device__ __forceinline__ float half32_sum(float v) {
  v = row16_sum(v);
  auto rr = __builtin_amdgcn_permlane16_swap(__float_as_uint(v), __float_as_uint(v), false, false);
  return __uint_as_float(rr[0]) + __uint_as_float(rr[1]);
}
__device__ __forceinline__ void gla_item(const P& p, char* lds, int seq, int h) {
  const int tid = tidx(), wid = tid >> 6, lane = tid & 63, r32 = lane & 31, hi = lane >> 5;
  const int dir = wid >> 2, wv = wid & 3, td_ = tid & 255;
  char* L = lds + dir * GL_DIR;
  float* GLRS = (float*)(L + GL_GLR); float* SEG = (float*)(L + GL_SEG); float* BL = (float*)(L + GL_BL); float* RSS = (float*)(L + GL_RSS);
  const unsigned tb = (unsigned)seq * SEQ;
  const bfu* GQ = (const bfu*)(p.ws + OFF_GQ); const bfu* GK = (const bfu*)(p.ws + OFF_GK); const bfu* GV = (const bfu*)(p.ws + OFF_GV);
  const float* GLR = (const float*)(p.ws + OFF_GLR); const bfu* GOUT = (const bfu*)(p.ws + OFF_GOUT);
  bfu* OTMP = (bfu*)(p.ws + OFF_OTMP); bfu* MIX = (bfu*)(p.ws + OFF_MIX);
  const int d_ = td_ & 63, seg_ = td_ >> 6;
  float gwr[16]; float gbias;
  { const int d = d_;
  {
    const float* gw = dir ? p.gbw : p.gfw;
#pragma unroll
    for (int q = 0; q < 16; ++q) gwr[q] = gw[q * 256 + h * 64 + d];
  }
  gbias = (dir ? p.gbb : p.gfb)[h * 64 + d]; }
  f32x16 S0 = {}, S1 = {};
  const int vb = (int)(uintptr_t)(L + GL_VI) + att_v_rd_base(lane) + wv * 512;
  u32x4 pq0, pq1, pk0, pk1;
#define GL_PREFETCH(CCN, TD) do { const unsigned t0n = tb + (unsigned)(CCN) * 64u; \
    { const int sp = (TD) >> 2, q4 = (TD) & 3; const unsigned t = t0n + (unsigned)(dir ? 63 - sp : sp); \
      const u32x4* qs = (const u32x4*)(GQ + (t * 256u + (unsigned)(h * 64 + q4 * 16))); pq0 = qs[0]; pq1 = qs[1]; \
      const u32x4* ks = (const u32x4*)(GK + (t * 256u + (unsigned)(h * 64 + q4 * 16))); pk0 = ks[0]; pk1 = ks[1]; } } while (0)
#define GL_VDMA(CCN, LANE) do { const unsigned t0n = tb + (unsigned)(CCN) * 64u; \
    _Pragma("unroll") for (int i = 0; i < 4; ++i) { const int off = (i * 4 + wv) * 1024 + (LANE) * 16, blk = off >> 9, in = off & 511; \
      const int kk = (blk >> 2) * 8 + (in >> 6), k = (kk & ~0xC) | ((kk & 4) << 1) | ((kk & 8) >> 1), cv = (blk & 3) * 32 + ((in & 63) >> 1); \
      const unsigned t = t0n + (unsigned)(dir ? 63 - k : k); \
      __builtin_amdgcn_global_load_lds((const unsigned*)(GV + (t * 512u + (unsigned)(h * 128 + cv))), (unsigned*)(L + GL_VI + (i * 4 + wv) * 1024), 16, 0, 0); } } while (0)
#define GL_GDMA(CCN, TD, BUF) do { const unsigned t0n = tb + (unsigned)(CCN) * 64u; const int sp = (TD) >> 2, q4 = (TD) & 3; const unsigned t = t0n + (unsigned)(dir ? 63 - sp : sp); \
    __builtin_amdgcn_global_load_lds((const unsigned*)(GLR + (t * 32u + (unsigned)(dir * 16 + q4 * 4))), (unsigned*)(GLRS + (BUF) * 1024 + wv * 256), 16, 0, 0); } while (0)
  GL_GDMA(dir ? 31 : 0, td_, 0);
  GL_PREFETCH(dir ? 31 : 0, td_);
  GL_VDMA(dir ? 31 : 0, lane);
  if (td_ < 128) RSS[td_] = p.gla_g[td_];
  u32x4 ogv[4], ggv[4];
  for (int c = 0; c < 32; ++c) {
    const int cc = dir ? 31 - c : c;
    const unsigned t0 = tb + (unsigned)cc * 64u;
#define GL_TOK(sp) (t0 + (unsigned)(dir ? 63 - (sp) : (sp)))
    asm volatile("s_waitcnt vmcnt(3)" ::: "memory");
    __syncthreads();
    int d = d_, seg = seg_, td = td_;
    asm volatile("" : "+v"(d), "+v"(seg), "+v"(td));
    { const int sp = td >> 2, q4 = td & 3;
      u32x4* qd = (u32x4*)(L + GL_QR + sp * 128 + q4 * 32); qd[0] = pq0; qd[1] = pq1;
      u32x4* kd2 = (u32x4*)(L + GL_KR + sp * 128 + q4 * 32); kd2[0] = pk0; kd2[1] = pk1; }
    const float* GLC = GLRS + (c & 1) * 1024;
    float bcum[16]; float run = 0.f;
#pragma unroll
    for (int rb = 0; rb < 8; ++rb) {
      float4 g[2][4];
#pragma unroll
      for (int r = 0; r < 2; ++r)
#pragma unroll
        for (int q = 0; q < 4; ++q) g[r][q] = *(const float4*)(GLC + (seg * 16 + rb * 2 + r) * 16 + q * 4);
      __builtin_amdgcn_sched_barrier(0);
#pragma unroll
      for (int r = 0; r < 2; ++r) {
        typedef float f2v_t __attribute__((ext_vector_type(2)));
        f2v_t z2 = {gbias, 0.f};
#pragma unroll
        for (int q = 0; q < 4; ++q) { const float4 v = g[r][q]; z2 += (f2v_t){v.x, v.y} * (f2v_t){gwr[4 * q], gwr[4 * q + 1]}; z2 += (f2v_t){v.z, v.w} * (f2v_t){gwr[4 * q + 2], gwr[4 * q + 3]}; }
        const float z = z2.x + z2.y;
        const float ls = fminf(z, 0.f) - 0.6931471805599453f * __builtin_amdgcn_logf(1.f + __expf(-fabsf(z)));
        run += ls * (1.f / 16.f); bcum[rb * 2 + r] = run;
      }
      __builtin_amdgcn_sched_barrier(0);
    }
    SEG[seg * 64 + d] = run;
    __syncthreads();
    {
      float qv[16], kv[16];
#pragma unroll
      for (int r = 0; r < 16; ++r) { qv[r] = bf2f(*(const bfu*)(L + GL_QR + (seg * 16 + r) * 128 + d * 2)); kv[r] = bf2f(*(const bfu*)(L + GL_KR + (seg * 16 + r) * 128 + d * 2)); }
      const float s0 = SEG[d], s1 = SEG[64 + d], s2 = SEG[128 + d], s3 = SEG[192 + d];
      const float off = (seg > 0 ? s0 : 0.f) + (seg > 1 ? s1 : 0.f) + (seg > 2 ? s2 : 0.f);
      const float total = s0 + s1 + s2 + s3;
      const float etot = __expf(total);
      unsigned kd[8];
#pragma unroll
      for (int r = 0; r < 16; ++r) {
        const float b = bcum[r] + off;
        const float e1 = __expf(b), e2 = __expf(-b), e3 = etot * e2;
        const int sp = seg * 16 + r;
        *(bfu*)(L + GL_QD + gl_sw(sp, d)) = (bfu)cvtpk(qv[r] * e1, 0.f);
        *(bfu*)(L + GL_KI + gl_sw(sp, d)) = (bfu)cvtpk(kv[r] * e2, 0.f);
        const float kdv = kv[r] * e3;
        if (r & 1) kd[r >> 1] = cvtpk(__uint_as_float(kd[r >> 1]), kdv); else kd[r >> 1] = __float_as_uint(kdv);
      }
      *(uint4*)(L + GL_KDT + gl_sw(d, seg * 16)) = make_uint4(kd[0], kd[1], kd[2], kd[3]);
      *(uint4*)(L + GL_KDT + gl_sw(d, seg * 16 + 8)) = make_uint4(kd[4], kd[5], kd[6], kd[7]);
      if (seg == 0) BL[d] = etot;
    }
    asm volatile("s_waitcnt vmcnt(0)" ::: "memory");
    __syncthreads();
    f32x16 X00 = {}, X01 = {}, X11 = {};
    {
      const char* KI = L + GL_KI; const char* QD = L + GL_QD;
#pragma unroll
      for (int ks = 0; ks < 4; ++ks) {
        const int col = ks * 16 + hi * 8;
        const bf16x8 a0 = *(const bf16x8*)(KI + gl_sw(r32, col)), a1 = *(const bf16x8*)(KI + gl_sw(32 + r32, col));
        const bf16x8 b0 = *(const bf16x8*)(QD + gl_sw(r32, col)), b1 = *(const bf16x8*)(QD + gl_sw(32 + r32, col));
        X00 = __builtin_amdgcn_mfma_f32_32x32x16_bf16(a0, b0, X00, 0, 0, 0);
        X01 = __builtin_amdgcn_mfma_f32_32x32x16_bf16(a0, b1, X01, 0, 0, 0);
        X11 = __builtin_amdgcn_mfma_f32_32x32x16_bf16(a1, b1, X11, 0, 0, 0);
      }
    }
#pragma unroll
    for (int r = 0; r < 16; ++r) { const bool keep = crow(r, hi) <= r32; X00[r] = keep ? X00[r] : 0.f; X11[r] = keep ? X11[r] : 0.f; }
    const s16x4 l0 = gl_tr<0, 0>(vb), h0 = gl_tr<0, 1>(vb), l1 = gl_tr<1, 0>(vb), h1 = gl_tr<1, 1>(vb);
    const s16x4 l2 = gl_tr<2, 0>(vb), h2 = gl_tr<2, 1>(vb), l3 = gl_tr<3, 0>(vb), h3 = gl_tr<3, 1>(vb);
    asm volatile("s_waitcnt lgkmcnt(0)" ::: "memory"); SBAR();
    const bf16x8 V0 = GL_PK(l0, h0), V1 = GL_PK(l1, h1), V2 = GL_PK(l2, h2), V3 = GL_PK(l3, h3);
    f32x16 o0 = {}, o1 = {};
    { bf16x8 pa0, pa1, pa2, pa3;
      gl_pk4(X00, 0, pa0); gl_pk4(X00, 1, pa1);
      o0 = __builtin_amdgcn_mfma_f32_32x32x16_bf16(pa0, V0, o0, 0, 0, 0);
      o0 = __builtin_amdgcn_mfma_f32_32x32x16_bf16(pa1, V1, o0, 0, 0, 0);
      gl_pk4(X01, 0, pa0); gl_pk4(X01, 1, pa1); gl_pk4(X11, 0, pa2); gl_pk4(X11, 1, pa3);
      o1 = __builtin_amdgcn_mfma_f32_32x32x16_bf16(pa0, V0, o1, 0, 0, 0);
      o1 = __builtin_amdgcn_mfma_f32_32x32x16_bf16(pa1, V1, o1, 0, 0, 0);
      o1 = __builtin_amdgcn_mfma_f32_32x32x16_bf16(pa2, V2, o1, 0, 0, 0);
      o1 = __builtin_amdgcn_mfma_f32_32x32x16_bf16(pa3, V3, o1, 0, 0, 0);
    }
    {
      const char* QD = L + GL_QD;
#pragma unroll
      for (int dt = 0; dt < 2; ++dt) {
        const f32x16& Sx = dt ? S1 : S0;
#pragma unroll
        for (int ks = 0; ks < 2; ++ks) {
          u32x4 sb = {cvtpk(Sx[8 * ks + 0], Sx[8 * ks + 1]), cvtpk(Sx[8 * ks + 2], Sx[8 * ks + 3]), cvtpk(Sx[8 * ks + 4], Sx[8 * ks + 5]), cvtpk(Sx[8 * ks + 6], Sx[8 * ks + 7])};
          const bf16x8 sbf = *reinterpret_cast<bf16x8*>(&sb);
          const int dcol = dt * 32 + ks * 16 + hi * 4;
          const uint2 a0l = *(const uint2*)(QD + gl_sw(r32, dcol)), a0h = *(const uint2*)(QD + gl_sw(r32, dcol + 8));
          const uint2 a1l = *(const uint2*)(QD + gl_sw(32 + r32, dcol)), a1h = *(const uint2*)(QD + gl_sw(32 + r32, dcol + 8));
          u32x4 A0 = {a0l.x, a0l.y, a0h.x, a0h.y}, A1 = {a1l.x, a1l.y, a1h.x, a1h.y};
          o0 = __builtin_amdgcn_mfma_f32_32x32x16_bf16(*reinterpret_cast<bf16x8*>(&A0), sbf, o0, 0, 0, 0);
          o1 = __builtin_amdgcn_mfma_f32_32x32x16_bf16(*reinterpret_cast<bf16x8*>(&A1), sbf, o1, 0, 0, 0);
        }
      }
    }
    {
      const char* KDT = L + GL_KDT;
#pragma unroll
      for (int g4 = 0; g4 < 4; ++g4) {
        const float4 b0 = *(const float4*)(BL + 8 * g4 + 4 * hi), b1 = *(const float4*)(BL + 32 + 8 * g4 + 4 * hi);
        S0[4 * g4] *= b0.x; S0[4 * g4 + 1] *= b0.y; S0[4 * g4 + 2] *= b0.z; S0[4 * g4 + 3] *= b0.w;
        S1[4 * g4] *= b1.x; S1[4 * g4 + 1] *= b1.y; S1[4 * g4 + 2] *= b1.z; S1[4 * g4 + 3] *= b1.w;
      }
#pragma unroll
      for (int s = 0; s < 4; ++s) {
        const bf16x8 Vs = s == 0 ? V0 : s == 1 ? V1 : s == 2 ? V2 : V3;
        const bf16x8 a0 = *(const bf16x8*)(KDT + gl_sw(r32, s * 16 + hi * 8)), a1 = *(const bf16x8*)(KDT + gl_sw(32 + r32, s * 16 + hi * 8));
        S0 = __builtin_amdgcn_mfma_f32_32x32x16_bf16(a0, Vs, S0, 0, 0, 0);
        S1 = __builtin_amdgcn_mfma_f32_32x32x16_bf16(a1, Vs, S1, 0, 0, 0);
      }
    }
    __syncthreads();
    if (c < 31) { int tdp = td; asm volatile("" : "+v"(tdp)); GL_PREFETCH(dir ? 30 - c : c + 1, tdp); int lp = tdp & 63; GL_VDMA(dir ? 30 - c : c + 1, lp); GL_GDMA(dir ? 30 - c : c + 1, tdp, (c + 1) & 1); }
    if (c >= 16) { int tdq = td; asm volatile("" : "+v"(tdq)); const int row = tdq >> 2, sg = tdq & 3; const unsigned t = GL_TOK(row);
      const u32x4* og = (const u32x4*)(OTMP + (t * 512u + (unsigned)(h * 128 + sg * 8))); const u32x4* gg = (const u32x4*)(GOUT + (t * 512u + (unsigned)(h * 128 + sg * 8)));
#pragma unroll
      for (int q = 0; q < 4; ++q) { ogv[q] = og[q * 4]; ggv[q] = gg[q * 4]; } }
    {
      float* OL = (float*)L;
#pragma unroll
      for (int r = 0; r < 16; ++r) {
        OL[crow(r, hi) * GL_OLS + wv * 32 + r32] = o0[r];
        OL[(32 + crow(r, hi)) * GL_OLS + wv * 32 + r32] = o1[r];
      }
    }
    __syncthreads();
    {
      const float* OL = (const float*)L;
      const int row = td >> 2, sg = td & 3;
      const unsigned t = GL_TOK(row);
      float4 v[8];
#pragma unroll
      for (int q = 0; q < 8; ++q) v[q] = *(const float4*)(OL + row * GL_OLS + (q >> 1) * 32 + sg * 8 + (q & 1) * 4);
      uint4* og = (uint4*)(OTMP + (t * 512u + (unsigned)(h * 128 + sg * 8)));
      if (c < 16) {
#pragma unroll
        for (int q = 0; q < 4; ++q) og[q * 4] = make_uint4(cvtpk(v[2 * q].x, v[2 * q].y), cvtpk(v[2 * q].z, v[2 * q].w), cvtpk(v[2 * q + 1].x, v[2 * q + 1].y), cvtpk(v[2 * q + 1].z, v[2 * q + 1].w));
      } else {
        float ss = 0.f;
#pragma unroll
        for (int q = 0; q < 4; ++q) { const uint4 w = make_uint4(ogv[q][0], ogv[q][1], ogv[q][2], ogv[q][3]);
          v[2 * q].x += __uint_as_float(w.x << 16); v[2 * q].y += __uint_as_float(w.x & 0xffff0000u); v[2 * q].z += __uint_as_float(w.y << 16); v[2 * q].w += __uint_as_float(w.y & 0xffff0000u);
          v[2 * q + 1].x += __uint_as_float(w.z << 16); v[2 * q + 1].y += __uint_as_float(w.z & 0xffff0000u); v[2 * q + 1].z += __uint_as_float(w.w << 16); v[2 * q + 1].w += __uint_as_float(w.w & 0xffff0000u); }
#pragma unroll
        for (int q = 0; q < 8; ++q) ss += v[q].x * v[q].x + v[q].y * v[q].y + v[q].z * v[q].z + v[q].w * v[q].w;
        ss += dpp_f<0xB1>(ss); ss += dpp_f<0x4E>(ss);
        const float rstd = rsqrtf(ss * (1.f / 128.f) + EPS);
        const float4* gn = (const float4*)(RSS + sg * 8);
        uint4* mo = (uint4*)(MIX + (t * 1024u + 512u + (unsigned)(h * 128 + sg * 8)));
#pragma unroll
        for (int q = 0; q < 4; ++q) {
          const float4 n0 = gn[q * 8], n1 = gn[q * 8 + 1];
          const unsigned gws[4] = {ggv[q][0], ggv[q][1], ggv[q][2], ggv[q][3]};
          const float ov[8] = {v[2 * q].x, v[2 * q].y, v[2 * q].z, v[2 * q].w, v[2 * q + 1].x, v[2 * q + 1].y, v[2 * q + 1].z, v[2 * q + 1].w};
          const float nn[8] = {n0.x, n0.y, n0.z, n0.w, n1.x, n1.y, n1.z, n1.w};
          unsigned ow[4];
#pragma unroll
          for (int e = 0; e < 4; ++e) {
            const float g0 = __uint_as_float(gws[e] << 16), g1 = __uint_as_float(gws[e] & 0xffff0000u);
            const float r0 = ov[2 * e] * rstd * nn[2 * e] * (g0 / (1.f + __expf(-g0)));
            const float r1 = ov[2 * e + 1] * rstd * nn[2 * e + 1] * (g1 / (1.f + __expf(-g1)));
            ow[e] = cvtpk(r0, r1);
          }
          mo[q * 4] = make_uint4(ow[0], ow[1], ow[2], ow[3]);
        }
      }
    }
#undef GL_TOK
  }
#undef GL_PREFETCH
#undef GL_GDMA
#undef GL_VDMA
}
__device__ __forceinline__ void gla_phase(const P& p, char* lds, int bid, int nb) {
  for (int item = bid; item < NSEQ * 4; item += nb) gla_item(p, lds, item >> 2, item & 3);
}

typedef _Float16 h2_t __attribute__((ext_vector_type(2)));
__device__ __forceinline__ unsigned enc_key(float f, unsigned idx, unsigned lowmask) {
  unsigned u = __float_as_uint(f);
  unsigned k = u ^ ((unsigned)((int)u >> 31) | 0x80000000u);
  return (k & ~lowmask) | idx;
}
__device__ __forceinline__ float dec_key(unsigned k, unsigned lowmask) {
  k &= ~lowmask;
  unsigned u = (k & 0x80000000u) ? (k & 0x7fffffffu) : ~k;
  return __uint_as_float(u);
}
typedef short s16x2_t __attribute__((ext_vector_type(2)));
__device__ __forceinline__ void enc_key2_f16(unsigned w, unsigned idx, unsigned& klo, unsigned& khi) {
  const s16x2_t sg = __builtin_bit_cast(s16x2_t, w) >> 15;
  const unsigned t = w ^ (__builtin_bit_cast(unsigned, sg) | 0x80008000u);
  klo = (t << 16) | idx; khi = (t & 0xffff0000u) | (idx + 1u);
}
__device__ __forceinline__ float dec_key_f16(unsigned k) {
  const unsigned t = k >> 16; const unsigned u = (t & 0x8000u) ? (t ^ 0x8000u) : (~t & 0xffffu);
  return (float)__builtin_bit_cast(_Float16, (unsigned short)u);
}
__device__ __forceinline__ void ce_desc(unsigned& a, unsigned& b) { unsigned mx = a > b ? a : b, mn = a > b ? b : a; a = mx; b = mn; }
__device__ __forceinline__ void sort16_desc(unsigned (&k)[16]) {
  ce_desc(k[0], k[1]); ce_desc(k[2], k[3]); ce_desc(k[0], k[2]); ce_desc(k[1], k[3]); ce_desc(k[1], k[2]); ce_desc(k[4], k[5]); ce_desc(k[6], k[7]); ce_desc(k[4], k[6]); ce_desc(k[5], k[7]); ce_desc(k[5], k[6]); ce_desc(k[0], k[4]); ce_desc(k[2], k[6]); ce_desc(k[2], k[4]); ce_desc(k[1], k[5]); ce_desc(k[3], k[7]); ce_desc(k[3], k[5]); ce_desc(k[1], k[2]); ce_desc(k[3], k[4]); ce_desc(k[5], k[6]); ce_desc(k[8], k[9]); ce_desc(k[10], k[11]); ce_desc(k[8], k[10]); ce_desc(k[9], k[11]); ce_desc(k[9], k[10]); ce_desc(k[12], k[13]); ce_desc(k[14], k[15]); ce_desc(k[12], k[14]); ce_desc(k[13], k[15]); ce_desc(k[13], k[14]); ce_desc(k[8], k[12]); ce_desc(k[10], k[14]); ce_desc(k[10], k[12]); ce_desc(k[9], k[13]); ce_desc(k[11], k[15]); ce_desc(k[11], k[13]); ce_desc(k[9], k[10]); ce_desc(k[11], k[12]); ce_desc(k[13], k[14]); ce_desc(k[0], k[8]); ce_desc(k[4], k[12]); ce_desc(k[4], k[8]); ce_desc(k[2], k[10]); ce_desc(k[6], k[14]); ce_desc(k[6], k[10]); ce_desc(k[2], k[4]); ce_desc(k[6], k[8]); ce_desc(k[10], k[12]); ce_desc(k[1], k[9]); ce_desc(k[5], k[13]); ce_desc(k[5], k[9]); ce_desc(k[3], k[11]); ce_desc(k[7], k[15]); ce_desc(k[7], k[11]); ce_desc(k[3], k[5]); ce_desc(k[7], k[9]); ce_desc(k[11], k[13]); ce_desc(k[1], k[2]); ce_desc(k[3], k[4]); ce_desc(k[5], k[6]); ce_desc(k[7], k[8]); ce_desc(k[9], k[10]); ce_desc(k[11], k[12]); ce_desc(k[13], k[14]);
}
__device__ __forceinline__ void bmerge16_desc(unsigned (&k)[16]) {
#pragma unroll
  for (int stride = 8; stride > 0; stride >>= 1)
#pragma unroll
    for (int i = 0; i < 16; ++i) { const int l = i ^ stride; if (l > i) ce_desc(k[i], k[l]); }
}
__device__ __forceinline__ void merge_top16(unsigned (&top)[16], const unsigned (&nw)[16]) {
#pragma unroll
  for (int i = 0; i < 16; ++i) top[i] = top[i] > nw[15 - i] ? top[i] : nw[15 - i];
  bmerge16_desc(top);
}
constexpr int cand_a(int c) { return c < 16 ? 0 : c < 24 ? 1 : c < 29 ? 2 : c < 33 ? 3 : c < 36 ? 4 : c < 38 ? 5 : c < 40 ? 6 : c < 42 ? 7 : c < 50 ? c - 34 : -1; }
constexpr int cand_b(int c) { return c < 16 ? c : c < 24 ? c - 16 : c < 29 ? c - 24 : c < 33 ? c - 29 : c < 36 ? c - 33 : c < 38 ? c - 36 : c < 40 ? c - 38 : c < 42 ? c - 40 : 0; }

constexpr int PE_TOK = 64;
constexpr int PE_T1_STRIDE = 260;
constexpr int PE_STARTS_B = PE_TOK * 20 * 4;
constexpr int PE_RING_B = 8 * 8192;
constexpr int PE_LDS_TOP1 = PE_STARTS_B + PE_RING_B;
static_assert(PE_TOK * PE_T1_STRIDE * 4 <= PE_LDS_TOP1, "top1 image must fit region 0");
constexpr int PE_LDS = PE_LDS_TOP1 + PE_TOK * 128 * 8;

__device__ __forceinline__ void peer_topk1_fin(const unsigned (&top)[16], int tl, int g, int hi, unsigned* top1) {
  unsigned m[16];
#pragma unroll
  for (int i = 0; i < 16; ++i) {
    const unsigned mine = hi ? top[15 - i] : top[i];
    auto rr = __builtin_amdgcn_permlane32_swap(mine, mine, false, false);
    m[i] = rr[0] > rr[1] ? rr[0] : rr[1];
  }
  bmerge16_desc(m);
  if (hi == 0) {
    uint4* dst = (uint4*)(top1 + tl * PE_T1_STRIDE + g * 16);
#pragma unroll
    for (int q = 0; q < 4; ++q) dst[q] = make_uint4(m[4 * q], m[4 * q + 1], m[4 * q + 2], m[4 * q + 3]);
  }
}
__device__ __forceinline__ void peer_topk1(const P& p, int tok0, int g, unsigned* top1) {
  const int lane = lanex(), r32 = lane & 31, hi = lane >> 5;
  const uint4* S0 = (const uint4*)((const _Float16*)(p.ws + OFF_PQ) + (size_t)((tok0 >> 6) * 16 + g) * 8192 + r32 * 32) + hi * 512;
  const uint4* S1 = S0 + 32 * 32 * 2 / 16;
  uint4 sa[8], sb[8];
#pragma unroll
  for (int q = 0; q < 8; ++q) { sa[q] = S0[(q >> 2) * 256 + (q & 3)]; sb[q] = S1[(q >> 2) * 256 + (q & 3)]; }
  unsigned top0[16], top1r[16];
#pragma unroll
  for (int kt = 0; kt < 4; ++kt) {
    unsigned key0[16], key1[16];
#pragma unroll
    for (int q = 0; q < 2; ++q) {
      const unsigned wa[4] = {sa[2 * kt + q].x, sa[2 * kt + q].y, sa[2 * kt + q].z, sa[2 * kt + q].w};
      const unsigned wb[4] = {sb[2 * kt + q].x, sb[2 * kt + q].y, sb[2 * kt + q].z, sb[2 * kt + q].w};
#pragma unroll
      for (int e = 0; e < 4; ++e) {
        const unsigned idx = (unsigned)(hi * 64 + kt * 16 + q * 8 + 2 * e);
        enc_key2_f16(wa[e], idx, key0[q * 8 + 2 * e], key0[q * 8 + 2 * e + 1]);
        enc_key2_f16(wb[e], idx, key1[q * 8 + 2 * e], key1[q * 8 + 2 * e + 1]);
      }
    }
    sort16_desc(key0); sort16_desc(key1);
    if (kt == 0) {
#pragma unroll
      for (int r = 0; r < 16; ++r) { top0[r] = key0[r]; top1r[r] = key1[r]; }
    } else { merge_top16(top0, key0); merge_top16(top1r, key1); }
  }
  peer_topk1_fin(top0, r32, g, hi, top1);
  peer_topk1_fin(top1r, 32 + r32, g, hi, top1);
}
__device__ __forceinline__ void peer_topk2(const P& p, int tok0, int wid, const unsigned* top1, int* pidx, float* pgate) {
  const int tid = wid * 64 + lanex(), tl = tid >> 3, hh = tid & 7;
  float rs2;
  { const float4* s4 = (const float4*)(p.ws + OFF_SS2) + (size_t)(tok0 + tl) * 4; float sq = 0.f;
#pragma unroll
    for (int q = 0; q < 4; ++q) { const float4 t = s4[q]; sq += t.x + t.y + t.z + t.w; }
    rs2 = rsqrtf(sq * (1.f / 1024.f) + EPS); }
  const unsigned* l1 = top1 + tl * PE_T1_STRIDE + hh * 32;
  unsigned k1[16], k2[16];
#pragma unroll
  for (int q = 0; q < 4; ++q) {
    uint4 a = ((const uint4*)l1)[q], b = ((const uint4*)l1)[4 + q];
    k1[4 * q] = a.x; k1[4 * q + 1] = a.y; k1[4 * q + 2] = a.z; k1[4 * q + 3] = a.w;
    k2[4 * q] = b.x; k2[4 * q + 1] = b.y; k2[4 * q + 2] = b.z; k2[4 * q + 3] = b.w;
  }
  float f1[16], f2[16];
#pragma unroll
  for (int i = 0; i < 16; ++i) { f1[i] = dec_key_f16(k1[i]) * rs2; f2[i] = dec_key_f16(k2[i]) * rs2; }
  unsigned top[16];
#pragma unroll
  for (int bt = 0; bt < 4; ++bt) {
    unsigned key[16];
#pragma unroll
    for (int c = 0; c < 16; ++c) {
      const int cc = bt * 16 + c;
      const int a = cand_a(cc), b = cand_b(cc);
      key[c] = (a >= 0) ? enc_key(f1[a >= 0 ? a : 0] + f2[b], (unsigned)((a >= 0 ? a : 0) * 16 + b), 255u) : 0u;
    }
    sort16_desc(key);
    if (bt == 0) {
#pragma unroll
      for (int r = 0; r < 16; ++r) top[r] = key[r];
    } else merge_top16(top, key);
  }
  float s[16]; float sum = 0;
  const float m0 = dec_key(top[0], 255u);
#pragma unroll
  for (int r = 0; r < 16; ++r) { s[r] = __expf(dec_key(top[r], 255u) - m0); sum += s[r]; }
  const float inv = 1.f / sum;
#pragma unroll
  for (int r = 0; r < 16; ++r) {
    const unsigned ab = top[r] & 255u;
    const int i1 = (int)(l1[ab >> 4] & 127u), i2 = (int)(l1[16 + (ab & 15u)] & 127u);
    pidx[tl * 128 + hh * 16 + r] = i1 * 128 + i2;
    pgate[tl * 128 + hh * 16 + r] = s[r] * inv;
  }
}
__device__ __forceinline__ float gelu_tanh_f(float x) {
  float u = 0.7978845608028654f * (x + 0.044715f * x * x * x);
  float th = 1.f - 2.f / (1.f + __expf(2.f * u));
  return 0.5f * x * (1.f + th);
}
__device__ __forceinline__ unsigned pk_h2(float a, float b) { h2_t h = {(_Float16)a, (_Float16)b}; return __builtin_bit_cast(unsigned, h); }
constexpr int PE_NR = 16;
__device__ __forceinline__ void peer_sort_picks(int* pidx_t, float* pgate_t, int* starts_t) {
  const int lane = lanex();
  const int i0 = pidx_t[lane], i1 = pidx_t[64 + lane];
  const float g0 = pgate_t[lane], g1 = pgate_t[64 + lane];
  const int r0 = i0 >> 10, r1 = i1 >> 10;
  int pos0 = 0, pos1 = 0, base = 0, sv = 128;
#pragma unroll
  for (int r = 0; r < PE_NR; ++r) {
    const unsigned long long m0 = __ballot(r0 == r), m1 = __ballot(r1 == r);
    const int c0 = __popcll(m0), c1 = __popcll(m1);
    const int b0 = (int)__builtin_amdgcn_mbcnt_hi((unsigned)(m0 >> 32), __builtin_amdgcn_mbcnt_lo((unsigned)m0, 0u));
    const int b1 = (int)__builtin_amdgcn_mbcnt_hi((unsigned)(m1 >> 32), __builtin_amdgcn_mbcnt_lo((unsigned)m1, 0u));
    pos0 = (r0 == r) ? base + b0 : pos0;
    pos1 = (r1 == r) ? base + c0 + b1 : pos1;
    sv = (lane == r) ? base : sv;
    base += c0 + c1;
  }
  pidx_t[pos0] = i0; pgate_t[pos0] = g0; pidx_t[pos1] = i1; pgate_t[pos1] = g1;
  if (lane <= PE_NR) starts_t[lane] = sv;
}
__device__ __forceinline__ int peer_idx4(const int* pidx_t, int k, int e, int lane) { return pidx_t[min(k + (lane & 3), e - 1)]; }
template <int NP>
__device__ __forceinline__ void peer_issue(const char* UTb, const char* VTb, int ev, char* ring, int lane) {
  const unsigned l16 = (unsigned)lane * 16u;
#pragma unroll
  for (int q = 0; q < NP; ++q) {
    const size_t rowoff = (size_t)(unsigned)__builtin_amdgcn_readlane(ev, q) << 11;
    const char* rp = UTb + rowoff + l16;
    __builtin_amdgcn_global_load_lds((const unsigned*)rp, (unsigned*)(ring + q * 2048), 16, 0, 0);
    __builtin_amdgcn_global_load_lds((const unsigned*)rp, (unsigned*)(ring + q * 2048), 16, 1024, 0);
  }
}
__device__ __forceinline__ float gelu_tanh_fast(float x) {
  const float t = x * x;
  const float pl = __builtin_fmaf(t, -0.10294323959f, -2.30220819814f);
  return x * __builtin_amdgcn_rcpf(1.f + __builtin_amdgcn_exp2f(x * pl));
}
template <int NP>
__device__ __forceinline__ void peer_compute(const uint4 (&U)[4], const uint4 (&V)[4], float gl, const int (&xq)[4], float xscale, h2_t (&acc)[8], int lane) {
  int d[4];
#pragma unroll
  for (int q = 0; q < 4; ++q) {
    if (q < NP) {
      int s = __builtin_amdgcn_sdot4((int)U[q].x, xq[0], 0, false);
      s = __builtin_amdgcn_sdot4((int)U[q].y, xq[1], s, false);
      s = __builtin_amdgcn_sdot4((int)U[q].z, xq[2], s, false);
      s = __builtin_amdgcn_sdot4((int)U[q].w, xq[3], s, false);
      d[q] = s;
    } else d[q] = 0;
  }
  int acti;
  if (NP == 4) {
    int s2[2];
#pragma unroll
    for (int q = 0; q < 2; ++q) { auto rr = __builtin_amdgcn_permlane32_swap((unsigned)d[q], (unsigned)d[q + 2], false, false); s2[q] = (int)(rr[0] + rr[1]); }
    auto rr = __builtin_amdgcn_permlane16_swap((unsigned)s2[0], (unsigned)s2[1], false, false); acti = (int)(rr[0] + rr[1]);
  } else {
    auto r1 = __builtin_amdgcn_permlane32_swap((unsigned)d[0], (unsigned)d[1], false, false);
    const int t = (int)(r1[0] + r1[1]);
    auto r2 = __builtin_amdgcn_permlane16_swap((unsigned)t, (unsigned)t, false, false); acti = (int)(r2[0] + r2[1]);
  }
  const float act = (float)row16_sum_i(acti) * xscale;
  const float wl = gl * gelu_tanh_fast(act);
  const unsigned whl = pk_h2(wl, wl);
#pragma unroll
  for (int q = 0; q < NP; ++q) {
    const h2_t wq = __builtin_bit_cast(h2_t, (unsigned)__builtin_amdgcn_readlane((int)whl, NP == 4 ? q * 16 : q * 32));
    const unsigned vw[4] = {V[q].x, V[q].y, V[q].z, V[q].w};
#pragma unroll
    for (int j = 0; j < 4; ++j) {
      acc[2 * j] = __builtin_amdgcn_cvt_scalef32_pk_f16_fp8((int)vw[j], 0.015625f, false) * wq + acc[2 * j];
      acc[2 * j + 1] = __builtin_amdgcn_cvt_scalef32_pk_f16_fp8((int)vw[j], 0.015625f, true) * wq + acc[2 * j + 1];
    }
  }
}
__device__ __forceinline__ void peer_load_hraw(const P& p, int t, int lane, uint4 (&raw)[2]) {
  const bfu* hr = (const bfu*)(p.ws + OFF_HB) + (size_t)t * 1024 + lane * 4;
  const uint2 a = *(const uint2*)(hr), b = *(const uint2*)(hr + 256), c = *(const uint2*)(hr + 512), d = *(const uint2*)(hr + 768);
  raw[0] = make_uint4(a.x, a.y, b.x, b.y); raw[1] = make_uint4(c.x, c.y, d.x, d.y);
}
__device__ __forceinline__ void peer_dec_h(const uint4 (&raw)[2], float (&hv)[16]) {
#pragma unroll
  for (int q = 0; q < 2; ++q) { const unsigned w[4] = {raw[q].x, raw[q].y, raw[q].z, raw[q].w};
#pragma unroll
    for (int e = 0; e < 4; ++e) { hv[8 * q + 2 * e] = __uint_as_float(w[e] << 16); hv[8 * q + 2 * e + 1] = __uint_as_float(w[e] & 0xffff0000u); } }
}
__device__ __forceinline__ void peer_gather_wave8(const P& p, int t0, int* pidx_w, float* pgate_w, int* starts_w, char* ring) {
  const int lane = lanex();
  t0 = __builtin_amdgcn_readfirstlane(t0);
  const char* UTb = p.ws + OFF_UT; const char* VTb = p.ws + OFF_VT;
  int xq[8][4]; float xsc[8]; h2_t acc[8][8];
  uint4 hraw[2][2];
  peer_load_hraw(p, t0, lane, hraw[0]);
#pragma unroll
  for (int i = 0; i < 8; ++i) {
    if (i < 7) peer_load_hraw(p, t0 + i + 1, lane, hraw[(i + 1) & 1]);
    peer_sort_picks(pidx_w + i * 128, pgate_w + i * 128, starts_w + i * 20);
    float hv[16]; peer_dec_h(hraw[i & 1], hv);
    float ss = 0, am = 0;
#pragma unroll
    for (int e = 0; e < 16; ++e) { ss += hv[e] * hv[e]; am = fmaxf(am, fabsf(hv[e])); }
    ss = wave_sum(ss); am = wave_max(am);
    const float rstd = rsqrtf(ss * (1.f / 1024.f) + EPS);
    const float inv = am > 0.f ? 127.f / am : 0.f;
    xsc[i] = am * rstd * (1.f / (127.f * PE_SU));
#pragma unroll
    for (int q = 0; q < 4; ++q) {
      const int q0 = (int)rintf(hv[4 * q] * inv), q1 = (int)rintf(hv[4 * q + 1] * inv), q2 = (int)rintf(hv[4 * q + 2] * inv), q3 = (int)rintf(hv[4 * q + 3] * inv);
      xq[i][q] = (int)((unsigned)(q0 & 255) | ((unsigned)(q1 & 255) << 8) | ((unsigned)(q2 & 255) << 16) | ((unsigned)(q3 & 255) << 24));
    }
#pragma unroll
    for (int j = 0; j < 8; ++j) acc[i][j] = h2_t{(_Float16)0.f, (_Float16)0.f};
    __builtin_amdgcn_sched_barrier(0);
  }
  bool pf = false;
  for (int r = 0; r < PE_NR; ++r) {
    const int l8 = lane & 7;
    const int sv = starts_w[l8 * 20 + r], ev = starts_w[l8 * 20 + r + 1], evn = starts_w[l8 * 20 + min(r + 2, PE_NR)];
#pragma unroll
    for (int i = 0; i < 8; ++i) {
      const int s = __builtin_amdgcn_readlane(sv, i), e = __builtin_amdgcn_readlane(ev, i);
      const int ni = (i + 1) & 7, nr = (i == 7) ? r + 1 : r;
      const int ns = (i < 7) ? __builtin_amdgcn_readlane(sv, (i + 1) & 7) : ((nr < PE_NR) ? __builtin_amdgcn_readlane(ev, 0) : 0);
      const int ne = (i < 7) ? __builtin_amdgcn_readlane(ev, (i + 1) & 7) : ((nr < PE_NR) ? __builtin_amdgcn_readlane(evn, 0) : 0);
      for (int k = s; k < e;) {
        const bool four = (e - k) > 2;
        const int k2 = k + (four ? 4 : 2);
        const bool same = k2 < e, hasn = same || (ns < ne);
        const int* nlist = pidx_w + (same ? i : ni) * 128; const int nk = same ? k2 : ns, nend = same ? e : ne;
        if (!pf) { const int ev = peer_idx4(pidx_w + i * 128, k, e, lane); if (four) peer_issue<4>(UTb, VTb, ev, ring, lane); else peer_issue<2>(UTb, VTb, ev, ring, lane); }
        asm volatile("s_waitcnt vmcnt(0)" ::: "memory");
        uint4 U[4], V[4];
#pragma unroll
        for (int q = 0; q < 4; ++q) if (q < 2 || four) { U[q] = *(const uint4*)(ring + q * 2048 + lane * 16); V[q] = *(const uint4*)(ring + q * 2048 + 1024 + lane * 16); }
        const int kg = k + (four ? (lane >> 4) : (lane >> 5));
        const float gl = (kg < e) ? pgate_w[i * 128 + min(kg, e - 1)] : 0.f;
        const int evn = hasn ? peer_idx4(nlist, nk, nend, lane) : 0;
        asm volatile("s_waitcnt lgkmcnt(0)" ::: "memory");
        if (hasn) { if (nend - nk > 2) peer_issue<4>(UTb, VTb, evn, ring, lane); else peer_issue<2>(UTb, VTb, evn, ring, lane); }
        pf = hasn;
        if (four) peer_compute<4>(U, V, gl, xq[i], xsc[i], acc[i], lane); else peer_compute<2>(U, V, gl, xq[i], xsc[i], acc[i], lane);
        k = k2;
      }
    }
  }
  { int te0 = t0; asm volatile("" : "+s"(te0)); peer_load_hraw(p, te0, lane, hraw[0]); }
#pragma unroll
  for (int i = 0; i < 8; ++i) {
    int te = t0 + i; asm volatile("" : "+s"(te));
    if (i < 7) peer_load_hraw(p, te + 1, lane, hraw[(i + 1) & 1]);
    float hv[16]; peer_dec_h(hraw[i & 1], hv);
    float y[16]; float ss = 0;
#pragma unroll
    for (int j = 0; j < 8; ++j) { y[2 * j] = hv[2 * j] + (float)acc[i][j][0]; y[2 * j + 1] = hv[2 * j + 1] + (float)acc[i][j][1]; }
#pragma unroll
    for (int e = 0; e < 16; ++e) ss += y[e] * y[e];
    ss = wave_sum(ss);
    const float rf = rsqrtf(ss * (1.f / 1024.f) + EPS);
    const float4* gr = (const float4*)p.fin_g + lane;
    float4* o4 = (float4*)(p.out + (size_t)te * 1024) + lane;
#pragma unroll
    for (int q = 0; q < 4; ++q) { const float4 g = gr[q * 64]; o4[q * 64] = make_float4(y[4 * q] * rf * g.x, y[4 * q + 1] * rf * g.y, y[4 * q + 2] * rf * g.z, y[4 * q + 3] * rf * g.w); }
    __builtin_amdgcn_sched_barrier(0);
  }
}
__device__ __forceinline__ void peer_phase(const P& p, char* lds, int bid, int nb) {
  unsigned* top1 = (unsigned*)lds; int* pidx = (int*)(lds + PE_LDS_TOP1); float* pgate = (float*)(lds + PE_LDS_TOP1 + PE_TOK * 128 * 4);
  int* starts = (int*)lds;
  const int wid = __builtin_amdgcn_readfirstlane(tidx() >> 6);
  for (int tile = bid; tile < T / PE_TOK; tile += nb) {
    const int tok0 = tile * PE_TOK;
    __syncthreads();
    for (int g = wid; g < 16; g += 8) peer_topk1(p, tok0, g, top1);
    __syncthreads();
    peer_topk2(p, tok0, wid, top1, pidx, pgate);
    __syncthreads();
    peer_gather_wave8(p, tok0 + wid * 8, pidx + wid * 8 * 128, pgate + wid * 8 * 128, starts + wid * 8 * 20, lds + PE_STARTS_B + wid * 8192);
  }
}

#define XB_TMO      128
#define XB_XCNT(j)  (256  + 64 * (j))
#define XB_XSUB(j)  (1280 + 64 * (j))
#define XB_XGEN(j)  (2304 + 64 * (j))
#define XB_TOP      3328
#define XB_TOPGEN   3392
#define XCD_BAR_WORDS 3456
#define XB_SPIN_CAP (1u << 18)
#define LAS __attribute__((address_space(3)))

__device__ __forceinline__ unsigned xb_ld(unsigned* p)              { return __hip_atomic_load(p, __ATOMIC_RELAXED, __HIP_MEMORY_SCOPE_AGENT); }
__device__ __forceinline__ unsigned xb_add(unsigned* p, unsigned v) { return __hip_atomic_fetch_add(p, v, __ATOMIC_RELAXED, __HIP_MEMORY_SCOPE_AGENT); }
__device__ __forceinline__ unsigned xb_xcc_id() { return (unsigned)__builtin_amdgcn_s_getreg((3 << 11) | 20) & 0xFu; }
#define XB_SPIN(cond, bar) do { unsigned _sp = 0; while (cond) { __builtin_amdgcn_s_sleep(1); \
    if ((++_sp & 255u) == 0u) { if (xb_ld(&(bar)[XB_TMO])) break; if (_sp > XB_SPIN_CAP) { atomicAdd(&(bar)[XB_TMO], 1u); break; } } } } while (0)

struct XcdBarrier {
    unsigned* bar; unsigned x;
    volatile LAS unsigned* st;
};

__device__ __forceinline__ XcdBarrier xcd_barrier_post(unsigned* bar, volatile LAS unsigned* st) {
    XcdBarrier b; b.bar = bar; b.x = xb_xcc_id(); b.st = st;
    if (tidx() == 0) (void)xb_add(&bar[XB_XCNT(b.x)], 1u);
    return b;
}
__device__ __forceinline__ void xcd_barrier_complete(unsigned* bar, unsigned x, unsigned& nloc, unsigned& nx) {
    const unsigned G = gridDim.x * gridDim.y * gridDim.z;
    unsigned sum, cnt, mine, sp = 0u;
    for (;;) {
        sum = 0u; cnt = 0u; mine = 0u;
#pragma unroll
        for (unsigned j = 0; j < 16; ++j) { const unsigned c = xb_ld(&bar[XB_XCNT(j)]); sum += c; cnt += (c > 0u) ? 1u : 0u; mine = (j == x) ? c : mine; }
        if (sum == G) break;
        __builtin_amdgcn_s_sleep(1);
        if ((++sp & 255u) == 0u) { if (xb_ld(&bar[XB_TMO])) break; if (sp > XB_SPIN_CAP) { atomicAdd(&bar[XB_TMO], 1u); break; } }
    }
    nloc = mine > 0u ? mine : 1u; nx = cnt > 0u ? cnt : 1u;
}

__device__ __forceinline__ void xcd_barrier(const XcdBarrier& b) {
    asm volatile("s_waitcnt vmcnt(0)" ::: "memory");
    __syncthreads();
    if (tidx() == 0) {
        unsigned* bar = b.bar;
        __builtin_amdgcn_s_waitcnt(0);
        unsigned nloc = b.st[0], nx = b.st[1];
        if (nloc == 0u) { xcd_barrier_complete(bar, b.x, nloc, nx); b.st[0] = nloc; b.st[1] = nx; }
        const unsigned old = xb_add(&bar[XB_XSUB(b.x)], 1u);
        const unsigned gen = old / nloc;
        if (old + 1u == (gen + 1u) * nloc) {
            __builtin_amdgcn_fence(__ATOMIC_RELEASE, "agent");
            asm volatile("s_waitcnt vmcnt(0)" ::: "memory");
            const unsigned og = xb_add(&bar[XB_TOP], 1u);
            const unsigned tg = og / nx;
            if (og + 1u == (tg + 1u) * nx) xb_add(&bar[XB_TOPGEN], 1u);
            else XB_SPIN(xb_ld(&bar[XB_TOPGEN]) == tg, bar);
            __builtin_amdgcn_fence(__ATOMIC_ACQUIRE, "agent");
            xb_add(&bar[XB_XGEN(b.x)], 1u);
            asm volatile("s_waitcnt vmcnt(0)" ::: "memory");
        } else {
            XB_SPIN(xb_ld(&bar[XB_XGEN(b.x)]) == gen, bar);
            __builtin_amdgcn_fence(__ATOMIC_ACQUIRE, "agent");
            asm volatile("s_waitcnt vmcnt(0)" ::: "memory");
        }
    }
    __syncthreads();
}

constexpr int cmax(int a, int b) { return a > b ? a : b; }
constexpr int MEGA_LDS = cmax(cmax(pg8::STAGE_BYTES, ATT_LDS), cmax(PE_LDS, cmax(GLA_LDS, FOLD_LDS)));
static_assert(MEGA_LDS + 16 <= WIDTAB_OFF, "the wave-index table must sit behind every phase's LDS image and the barrier words");
__global__ __launch_bounds__(512) void mega(P p) {
  char* lds = (char*)lds_u;
  tidx_init();
  cg::grid_group grid = cg::this_grid();
  const int bid = blockIdx.x, nb = gridDim.x;
  volatile LAS unsigned* xst = (volatile LAS unsigned*)(lds_u + MEGA_LDS);
  { const int t0 = tidx(); if (t0 < 4) xst[t0] = 0u; prep_phase(p, (long)bid * 512 + t0, (long)nb * 512); }
  prep_foldkeys(p, lds, bid, nb);
  grid.sync();
  (void)xcd_barrier_post((unsigned*)(p.ws + OFF_XBAR), xst);
#define GRID_BARRIER() do { XcdBarrier _b; _b.bar = (unsigned*)(p.ws + OFF_XBAR); _b.x = xb_xcc_id(); _b.st = (volatile LAS unsigned*)(lds_u + MEGA_LDS); xcd_barrier(_b); } while (0)
  PG8_LAS unsigned char* glds = (PG8_LAS unsigned char*)lds;
  { EpiG1 e; e.ws = p.ws; run_gemm(glds, (const bfu*)(p.ws + OFF_XB), (const bfu*)(p.ws + OFF_WIN), T, 2048, 1024, e, bid, nb); }
  GRID_BARRIER();
  { EpiG2 e; e.ws = p.ws; run_gemm(glds, (const bfu*)(p.ws + OFF_CQKV), (const bfu*)(p.ws + OFF_WQKV), T, 1792, 384, e, bid, nb); }
  GRID_BARRIER();
#if PROBE == 6
  for (int rep = 0; rep < 3; ++rep) { gla_phase(p, lds, bid, nb); attn_phase(p, lds, bid, nb); GRID_BARRIER(); }
#elif PROBE == 7
  for (int rep = 0; rep < 3; ++rep) { attn_phase(p, lds, bid, nb); GRID_BARRIER(); }
#elif PROBE == 8
  for (int rep = 0; rep < 3; ++rep) { gla_phase(p, lds, bid, nb); GRID_BARRIER(); }
#endif
  gla_phase(p, lds, bid, nb);
  attn_phase(p, lds, bid, nb);
  GRID_BARRIER();
  { EpiG4 e; e.pp = &p; run_gemm(glds, (const bfu*)(p.ws + OFF_MIX), (const bfu*)(p.ws + OFF_WO), T, 1024, 1024, e, bid, nb); }
  GRID_BARRIER();
  { EpiG5 e; e.ws = p.ws; run_gemm(glds, (const bfu*)(p.ws + OFF_HB), (const bfu*)(p.ws + OFF_WPQ), T, 2048, 1024, e, bid, nb); }
  GRID_BARRIER();
#if PROBE == 5
  peer_phase(p, lds, bid, nb);
  GRID_BARRIER();
#endif
  peer_phase(p, lds, bid, nb);
}

extern "C" void kernel_launch(void* const* d_in, const int* in_sizes, int n_in, void* d_out, int out_size, void* d_ws, size_t ws_size,
                              hipStream_t stream) {
  if (ws_size < WS_NEED) { fprintf(stderr, "kernel_launch: ws too small: %zu < %zu\n", ws_size, WS_NEED); return; }
  P p{};
  p.xp = (const float*)d_in[0]; p.xs = (const float*)d_in[1]; p.norm1_g = (const float*)d_in[2]; p.w_in = (const float*)d_in[3];
  p.q_norm_g = (const float*)d_in[4]; p.w_uq = (const float*)d_in[5]; p.kv_norm_g = (const float*)d_in[6]; p.w_ukv = (const float*)d_in[7];
  p.gfw = (const float*)d_in[8]; p.gfb = (const float*)d_in[9]; p.gbw = (const float*)d_in[10]; p.gbb = (const float*)d_in[11];
  p.gla_g = (const float*)d_in[12]; p.w_o = (const float*)d_in[13]; p.norm2_g = (const float*)d_in[14]; p.wq = (const float*)d_in[15];
  p.subk = (const float*)d_in[16]; p.ut = (const float*)d_in[17]; p.vt = (const float*)d_in[18]; p.fin_g = (const float*)d_in[19];
  p.out = (float*)d_out; p.ws = (char*)d_ws;
  for (int i = 0; i < 16; ++i) p.freq[i] = (float)pow(10000.0, -(double)i * 2.0 / 32.0);
  static int grid_blocks = 0;
  if (!grid_blocks) {
    (void)hipFuncSetAttribute((const void*)mega, hipFuncAttributeMaxDynamicSharedMemorySize, LDS_TOTAL);
    int dev = 0, cus = 0, per_cu = 0;
    (void)hipGetDevice(&dev);
    (void)hipDeviceGetAttribute(&cus, hipDeviceAttributeMultiprocessorCount, dev);
    (void)hipOccupancyMaxActiveBlocksPerMultiprocessor(&per_cu, mega, 512, LDS_TOTAL);
    if (per_cu > 1) per_cu = 1;
    grid_blocks = cus * per_cu;
    if (grid_blocks <= 0) { fprintf(stderr, "kernel_launch: occupancy query gave %d x %d\n", cus, per_cu); grid_blocks = 0; return; }
  }
  void* args[] = {&p};
  hipError_t e = hipLaunchCooperativeKernel((void*)mega, dim3(grid_blocks), dim3(512), args, LDS_TOTAL, stream);
  if (e != hipSuccess) fprintf(stderr, "cooperative launch failed: %s (grid %d)\n", hipGetErrorString(e), grid_blocks);
}
```
